# Optimizing an MI355X kernel written in HIP

```python
import jax, jax.numpy as jnp
from jax import lax
import numpy as np

D_MODEL = 1024
BATCH = 8
SEQ = 8192
DEPTH = 1

EPS = 1e-6
ROPE_THETA = 500000.0
Q_BLOCK = 128
MLA_HEADS = 8
MLA_Q_LORA = 256
MLA_KV_LORA = 128
MLA_NOPE = 64
MLA_ROPE = 32
MLA_V = 64
DSA_HEADS = 8
DSA_HEAD_DIM = 64
DSA_ROT = DSA_HEAD_DIM // 4
IDX_HEADS = 8
IDX_DIM = 64
IDX_ROT = IDX_DIM // 4
TOPK_MAX = 256
N_EXPERTS = 32
TOP_K = 4
D_FF = 1024
SWIGLU_LIMIT = 7.0
SWIGLU_ALPHA = 1.702
EXPERT_BLOCK = 256
IN_SPLITS = (MLA_Q_LORA, MLA_KV_LORA, MLA_ROPE,
             DSA_HEADS * DSA_HEAD_DIM, DSA_HEAD_DIM, DSA_HEAD_DIM,
             IDX_HEADS * IDX_DIM, IDX_DIM, IDX_HEADS,
             D_MODEL, D_MODEL)
D_IN = 256 + 128 + 32 + 512 + 64 + 64 + 512 + 64 + 8 + D_MODEL + D_MODEL

kernel_name = 'hybrid_mla_dsa_gated_moe_block'


def rms_norm(x, g):
    xf = x.astype(jnp.float32)
    y = xf * lax.rsqrt(jnp.mean(xf * xf, axis=-1, keepdims=True) + EPS)
    return (y * g.astype(jnp.float32)).astype(x.dtype)


def rope_partial(x, pos, rot_dim):
    half = rot_dim // 2
    inv_freq = ROPE_THETA ** (-jnp.arange(half, dtype=jnp.float32) / half)
    ang = pos.astype(jnp.float32)[:, :, None, None] * inv_freq
    cos, sin = jnp.cos(ang), jnp.sin(ang)
    x1 = x[..., :half].astype(jnp.float32)
    x2 = x[..., half:rot_dim].astype(jnp.float32)
    rot = jnp.concatenate([x1 * cos - x2 * sin, x2 * cos + x1 * sin], axis=-1).astype(x.dtype)
    return jnp.concatenate([rot, x[..., rot_dim:]], axis=-1)


def split_cols(z, sizes):
    outs, off = [], 0
    for s in sizes:
        outs.append(z[..., off:off + s])
        off += s
    return outs


def to_blocks(a, nb):
    return a.reshape(a.shape[0], nb, Q_BLOCK, *a.shape[2:]).swapaxes(0, 1)


def from_blocks(o):
    nb, b = o.shape[0], o.shape[1]
    return o.swapaxes(0, 1).reshape(b, nb * Q_BLOCK, -1)


def mla_branch(c_q, c_kv, k_pe, pos, q_norm_g, w_uq, kv_norm_g, w_ukv):
    B, S, _ = c_q.shape
    nb = S // Q_BLOCK
    q = (rms_norm(c_q, q_norm_g) @ w_uq).reshape(B, S, MLA_HEADS, MLA_NOPE + MLA_ROPE)
    q_nope = q[..., :MLA_NOPE]
    q_pe = rope_partial(q[..., MLA_NOPE:], pos, MLA_ROPE)
    kv = (rms_norm(c_kv, kv_norm_g) @ w_ukv).reshape(B, S, MLA_HEADS, MLA_NOPE + MLA_V)
    k_nope, v = kv[..., :MLA_NOPE], kv[..., MLA_NOPE:]
    k_rot = rope_partial(k_pe[:, :, None, :], pos, MLA_ROPE)[:, :, 0]
    key_pos = jnp.arange(S)
    scale = (MLA_NOPE + MLA_ROPE) ** -0.5

    def attend_block(args):
        i, qn, qp = args
        s = (jnp.einsum('bqhd,bkhd->bhqk', qn, k_nope)
             + jnp.einsum('bqhr,bkr->bhqk', qp, k_rot)).astype(jnp.float32) * scale
        q_pos = i * Q_BLOCK + jnp.arange(Q_BLOCK)
        s = jnp.where(key_pos[None, :] <= q_pos[:, None], s, -jnp.inf)
        p = jax.nn.softmax(s, axis=-1).astype(v.dtype)
        return jnp.einsum('bhqk,bkhd->bqhd', p, v)

    out = lax.map(attend_block, (jnp.arange(nb), to_blocks(q_nope, nb), to_blocks(q_pe, nb)))
    return from_blocks(out)


def dsa_branch(q, k, v, q_idx, k_idx, w_idx, pos):
    B, S, _ = q.shape
    nb = S // Q_BLOCK
    topk = min(TOPK_MAX, S // 4)
    q = rope_partial(q.reshape(B, S, DSA_HEADS, DSA_HEAD_DIM), pos, DSA_ROT)
    k = rope_partial(k[:, :, None, :], pos, DSA_ROT)[:, :, 0]
    q_idx = rope_partial(q_idx.reshape(B, S, IDX_HEADS, IDX_DIM), pos, IDX_ROT)
    k_idx = rope_partial(k_idx[:, :, None, :], pos, IDX_ROT)[:, :, 0]
    w_idx = w_idx.astype(jnp.float32) * IDX_HEADS ** -0.5
    key_pos = jnp.arange(S)
    gather_rows = jax.vmap(lambda table, idx: table[idx])

    def attend_block(args):
        i, qb, qib, wib = args
        q_pos = i * Q_BLOCK + jnp.arange(Q_BLOCK)
        causal = key_pos[None, :] <= q_pos[:, None]
        rel = jax.nn.relu(jnp.einsum('bqhd,bkd->bqhk', qib, k_idx).astype(jnp.float32) * IDX_DIM ** -0.5)
        score = jnp.einsum('bqh,bqhk->bqk', wib, rel)
        score = jnp.where(causal[None], score, -jnp.inf)
        _, sel = lax.top_k(score, topk)
        valid = sel <= q_pos[None, :, None]
        k_sel = gather_rows(k, sel)
        v_sel = gather_rows(v, sel)
        s = jnp.einsum('bqhd,bqkd->bhqk', qb, k_sel).astype(jnp.float32) * DSA_HEAD_DIM ** -0.5
        s = jnp.where(valid[:, None], s, -jnp.inf)
        p = jax.nn.softmax(s, axis=-1).astype(v.dtype)
        return jnp.einsum('bhqk,bqkd->bqhd', p, v_sel)

    out = lax.map(attend_block, (jnp.arange(nb), to_blocks(q, nb), to_blocks(q_idx, nb), to_blocks(w_idx, nb)))
    return from_blocks(out)


def moe_ffn(h, router_w, router_b, w_gu, b_gu, w_d, b_d):
    B, S, D = h.shape
    t = h.reshape(B * S, D)
    n_tok = t.shape[0]
    n_assign = n_tok * TOP_K
    n_blk = -(-n_assign // EXPERT_BLOCK) + N_EXPERTS
    logits = (t @ router_w + router_b).astype(jnp.float32)
    top_logit, top_e = lax.top_k(logits, TOP_K)
    gate = jax.nn.softmax(top_logit, axis=-1)
    flat_e = top_e.reshape(-1)
    order = jnp.argsort(flat_e)
    e_sorted = flat_e[order]
    tok_sorted = order // TOP_K
    gate_sorted = gate.reshape(-1)[order]
    counts = jnp.bincount(flat_e, length=N_EXPERTS)
    padded = (counts + EXPERT_BLOCK - 1) // EXPERT_BLOCK * EXPERT_BLOCK
    pad_end = jnp.cumsum(padded)
    pad_start = pad_end - padded
    sort_start = jnp.cumsum(counts) - counts
    dest = pad_start[e_sorted] + jnp.arange(n_assign) - sort_start[e_sorted]
    xbuf = jnp.zeros((n_blk * EXPERT_BLOCK, D), t.dtype).at[dest].set(t[tok_sorted])
    blk_e = jnp.minimum(jnp.searchsorted(pad_end, jnp.arange(n_blk) * EXPERT_BLOCK, side='right'), N_EXPERTS - 1)

    def expert_block(args):
        xb, e = args
        gu = xb @ w_gu[e] + b_gu[e]
        glu = jnp.minimum(gu[:, :D_FF], SWIGLU_LIMIT)
        lin = jnp.clip(gu[:, D_FF:], -SWIGLU_LIMIT, SWIGLU_LIMIT)
        act = glu * jax.nn.sigmoid(SWIGLU_ALPHA * glu) * (lin + 1.0)
        return act @ w_d[e] + b_d[e]

    ybuf = lax.map(expert_block, (xbuf.reshape(n_blk, EXPERT_BLOCK, D), blk_e))
    y = ybuf.reshape(-1, D)[dest] * gate_sorted[:, None].astype(t.dtype)
    out = jax.ops.segment_sum(y, tok_sorted, num_segments=n_tok)
    return out.reshape(B, S, D)


def setup_inputs(seed: int = 0) -> dict:
    key = jax.random.key(seed)
    ks = jax.random.split(key, 20)
    f32 = jnp.float32
    L = DEPTH

    def nrm(k, shape, scale):
        return jax.random.normal(k, shape, f32) * scale

    def gain(k, shape):
        return 1.0 + 0.1 * jax.random.normal(k, shape, f32)

    return {
        'x': nrm(ks[0], (BATCH, SEQ, D_MODEL), 1.0),
        'positions': jnp.tile(jnp.arange(SEQ, dtype=jnp.int32)[None, :], (BATCH, 1)),
        'attn_norm_g': gain(ks[1], (L, D_MODEL)),
        'w_in': nrm(ks[2], (L, D_MODEL, D_IN), D_MODEL ** -0.5),
        'mla_q_norm_g': gain(ks[3], (L, MLA_Q_LORA)),
        'mla_w_uq': nrm(ks[4], (L, MLA_Q_LORA, MLA_HEADS * (MLA_NOPE + MLA_ROPE)), MLA_Q_LORA ** -0.5),
        'mla_kv_norm_g': gain(ks[5], (L, MLA_KV_LORA)),
        'mla_w_ukv': nrm(ks[6], (L, MLA_KV_LORA, MLA_HEADS * (MLA_NOPE + MLA_V)), MLA_KV_LORA ** -0.5),
        'w_branch_mla': nrm(ks[7], (L, MLA_HEADS * MLA_V, D_MODEL), (MLA_HEADS * MLA_V) ** -0.5),
        'w_branch_dsa': nrm(ks[8], (L, DSA_HEADS * DSA_HEAD_DIM, D_MODEL), (DSA_HEADS * DSA_HEAD_DIM) ** -0.5),
        'w_out': nrm(ks[9], (L, D_MODEL, D_MODEL), D_MODEL ** -0.5),
        'ffn_norm_g': gain(ks[10], (L, D_MODEL)),
        'router_w': nrm(ks[11], (L, D_MODEL, N_EXPERTS), D_MODEL ** -0.5),
        'router_b': nrm(ks[12], (L, N_EXPERTS), 0.01),
        'w_gate_up': nrm(ks[13], (L, N_EXPERTS, D_MODEL, 2 * D_FF), D_MODEL ** -0.5),
        'b_gate_up': nrm(ks[14], (L, N_EXPERTS, 2 * D_FF), 0.02),
        'w_down': nrm(ks[15], (L, N_EXPERTS, D_FF, D_MODEL), D_FF ** -0.5),
        'b_down': nrm(ks[16], (L, N_EXPERTS, D_MODEL), 0.02),
        'final_norm_g': gain(ks[17], (D_MODEL,)),
    }


def reference(x, positions, attn_norm_g, w_in, mla_q_norm_g, mla_w_uq, mla_kv_norm_g, mla_w_ukv,
              w_branch_mla, w_branch_dsa, w_out, ffn_norm_g, router_w, router_b,
              w_gate_up, b_gate_up, w_down, b_down, final_norm_g):
    for l in range(DEPTH):
        h = rms_norm(x, attn_norm_g[l])
        z = h @ w_in[l]
        (c_q, c_kv, k_pe, q_b, k_b, v_b, q_idx, k_idx, w_idx, gate_a, gate_b) = split_cols(z, IN_SPLITS)
        y_a = mla_branch(c_q, c_kv, k_pe, positions, mla_q_norm_g[l], mla_w_uq[l], mla_kv_norm_g[l], mla_w_ukv[l])
        y_b = dsa_branch(q_b, k_b, v_b, q_idx, k_idx, w_idx, positions)
        merged = (jax.nn.sigmoid(gate_a) * (y_a @ w_branch_mla[l])
                  + jax.nn.sigmoid(gate_b) * (y_b @ w_branch_dsa[l]))
        x = x + merged @ w_out[l]
        x = x + moe_ffn(rms_norm(x, ffn_norm_g[l]), router_w[l], router_b[l],
                        w_gate_up[l], b_gate_up[l], w_down[l], b_down[l])
    return rms_norm(x, final_norm_g)
```

```cpp
#define MK_N_LAUNCHES 1
#define SPLIT_MIXERS 0
#define MLA_PRIO_E 2
#define P4_ALT 1
#include <hip/hip_runtime.h>
#include <cstdio>
#include <cstdint>

extern __shared__ __attribute__((aligned(16))) unsigned char g_lds[];
#if defined(SELFCHK2) || defined(CHKW_MASK)
#ifndef CHKW_MASK
#define CHKW_MASK 0xFF
#endif
#define CHKW_S(site, v) do { if (((CHKW_MASK) >> (site)) & 1) { int ln_; asm volatile("v_mbcnt_lo_u32_b32 %0, -1, 0\n\tv_mbcnt_hi_u32_b32 %0, -1, %0" : "=v"(ln_)); __hip_atomic_fetch_add((__attribute__((address_space(3))) unsigned*)(g_lds + 163072) + ln_, (unsigned)(v), __ATOMIC_RELAXED, __HIP_MEMORY_SCOPE_WORKGROUP); } } while (0)
#else
#define CHKW_S(site, v) do {} while (0)
#endif
namespace pg8 {
#define PG8_LAS __attribute__((address_space(3)))
typedef unsigned short bf16_t;
typedef short bf16x8 __attribute__((ext_vector_type(8)));
typedef float f32x4 __attribute__((ext_vector_type(4)));
typedef unsigned u32x4 __attribute__((ext_vector_type(4)));
constexpr int BM = 256, BK = 64, HALF = 128, HTB = HALF * BK * 2  , STAGE_BYTES = 8 * HTB, NXCD = 8, WGM = 8;

__host__ __device__ __forceinline__ int lds_byte(int r, int c) { const int st = (r >> 4) * 2 + (c >> 5), rr = r & 15, cc = c & 31, ob = rr * 64 + cc * 2; return st * 1024 + (ob ^ (((ob >> 9) & 1) << 5)); }
__host__ __device__ __forceinline__ void stage_rc(int b, int& R, int& C) { const int st = b / 1024, sb = b % 1024, swz = sb ^ (((sb >> 9) & 1) << 5); R = (st >> 1) * 16 + swz / 64; C = (st & 1) * 32 + (swz % 64) / 2; }
__host__ __device__ __forceinline__ int perm32(int rho) { const int n = rho >> 4, i = rho & 15; return 8 * (i >> 2) + 4 * n + (i & 3); }

struct Unit { int pm, pn; };
struct Gemm { const bf16_t* A; const bf16_t* Bt; int M, N, K; };

struct StaticOrder {
    static constexpr bool GATHER = false; const int* rows = nullptr;
    int nM, nN, nwg, G, c, z = 0;
    __host__ __device__ void init(int M, int N, int G_, int c_) { nM = M / BM; nN = N / BM; nwg = nM * nN; G = G_; c = c_; }
    __host__ __device__ bool next(int i, Unit& u) const {
        const long L = (long)i * G + c; if (L >= nwg) return false;
        int wgid = (int)L; { const int q = nwg / NXCD, r = nwg % NXCD, xcd = wgid % NXCD, off = wgid / NXCD; wgid = (xcd < r ? xcd * (q + 1) : r * (q + 1) + (xcd - r) * q) + off; }
        const int nig = WGM * nN, gid = wgid / nig, fm = gid * WGM, gsz = (nM - fm) < WGM ? (nM - fm) : WGM;
        u.pm = fm + ((wgid % nig) % gsz); u.pn = (wgid % nig) / gsz; return true;
    }
    __device__ __forceinline__ void a_ready(const Unit&) const {}
    __device__ __forceinline__ void done(const Unit&) const {}
    __device__ __forceinline__ int tid_bias() const { return z; }
};

__device__ __forceinline__ unsigned cvt_pk_bf16(float lo, float hi) { unsigned r; asm volatile("s_nop 1\n\tv_cvt_pk_bf16_f32 %0, %1, %2" : "=v"(r) : "v"(lo), "v"(hi)); return r; }
typedef float f32x2 __attribute__((ext_vector_type(2)));
template <class Epi, class Sched, bool ALIGN_EPI = false, bool SP2 = false>
__device__ __forceinline__ void gemm_phase(PG8_LAS unsigned char* lds, const Gemm g, const Sched& S, const Epi& E) {
    const int tid = S.tid_bias(), wid = __builtin_amdgcn_readfirstlane(tid >> 6), lane = tid & 63, wr = wid >> 2, wc = wid & 3, fr = lane & 15, fq = lane >> 4;
    const int K = g.K, nt = K / BK;
    unsigned voffA[2], voffB[2];
#pragma unroll
    for (int i = 0; i < 2; ++i) { int R, C; stage_rc(tid * 16 + i * 8192, R, C); const int Rb = Epi::PERM ? ((R & ~31) + perm32(R & 31)) : R;
        voffA[i] = (unsigned)(R * K + C) * 2u; voffB[i] = (unsigned)(Rb * K + C) * 2u; }
    unsigned voffA1[2]; voffA1[0] = voffA[0]; voffA1[1] = voffA[1];
    if constexpr (Sched::GATHER) {
#pragma unroll
        for (int i = 0; i < 2; ++i) { int R, C; stage_rc(tid * 16 + i * 8192, R, C);
            voffA[i] = (unsigned)(S.rows[R] * K + C) * 2u; voffA1[i] = (unsigned)(S.rows[HALF + R] * K + C) * 2u; } }
    const size_t kstep = (size_t)(BK * 2);
    const size_t hstep = (size_t)HALF * K * 2;
    const size_t tstep = 2 * hstep;
    const size_t hstepA = Sched::GATHER ? 0 : hstep;
    const unsigned ldsw = (unsigned)wid * 1024u;
    const int aoff = lds_byte(wr * 64 + fr, fq * 8), boff = lds_byte(wc * 32 + fr, fq * 8);
#define PG8_SA(b, h) (((b) * 2 + (h)) * HTB)
#define PG8_SB(b, h) ((4 + (b) * 2 + (h)) * HTB)
#define PG8_STAGE(bufoff, gbase, voff) do { _Pragma("unroll") for (int _i = 0; _i < 2; ++_i) \
        __builtin_amdgcn_global_load_lds((const unsigned*)((const char*)(gbase) + (voff)[_i]), (PG8_LAS unsigned*)(lds + (bufoff) + ldsw + _i * 8192), 16, 0, 0); } while (0)
#define PG8_LDA(dst, b, h) do { _Pragma("unroll") for (int m = 0; m < 4; ++m) _Pragma("unroll") for (int k = 0; k < 2; ++k) dst[m][k] = *(const PG8_LAS bf16x8*)(lds + PG8_SA(b, h) + aoff + m * 2048 + k * 1024); } while (0)
#define PG8_LDB(dst, b, h) do { _Pragma("unroll") for (int n = 0; n < 2; ++n) _Pragma("unroll") for (int k = 0; k < 2; ++k) dst[n][k] = *(const PG8_LAS bf16x8*)(lds + PG8_SB(b, h) + boff + n * 2048 + k * 1024); } while (0)
#define PG8_MMA(ai, bj, At, Bt) do { __builtin_amdgcn_s_setprio(1); _Pragma("unroll") for (int m = 0; m < 4; ++m) _Pragma("unroll") for (int n = 0; n < 2; ++n) _Pragma("unroll") for (int k = 0; k < 2; ++k) \
        acc[ai][bj][m][n] = __builtin_amdgcn_mfma_f32_16x16x32_bf16(Bt[n][k], At[m][k], acc[ai][bj][m][n], 0, 0, 0); __builtin_amdgcn_s_setprio(0); } while (0)
#define PG8_WAIT_V(n) asm volatile("s_waitcnt vmcnt(" #n ")" ::: "memory")
#define PG8_WAIT_L(n) asm volatile("s_waitcnt lgkmcnt(" #n ")" ::: "memory")
#define PG8_BAR __builtin_amdgcn_s_barrier()
#define PG8_SCHED __builtin_amdgcn_sched_barrier(0)
    Unit cur, nxt; int ui = 0;
    if (!S.next(0, cur)) return;
    f32x4 acc[2][2][4][2];
#pragma unroll
    for (int a = 0; a < 2; ++a)
#pragma unroll
        for (int b = 0; b < 2; ++b)
#pragma unroll
            for (int m = 0; m < 4; ++m)
#pragma unroll
                for (int n = 0; n < 2; ++n) acc[a][b][m][n] = (f32x4){0.f, 0.f, 0.f, 0.f};
    bf16x8 At[4][2], B0[2][2], B1[2][2];
    const char* cA = (const char*)g.A + (size_t)cur.pm * tstep; const char* cB = (const char*)g.Bt + (size_t)cur.pn * tstep;
    S.a_ready(cur);
    if constexpr (SP2) {
        PG8_STAGE(PG8_SB(0, 0), cB, voffB); PG8_STAGE(PG8_SB(0, 1), cB + hstep, voffB); PG8_STAGE(PG8_SA(0, 0), cA, voffA); PG8_STAGE(PG8_SA(0, 1), cA + hstepA, voffA1);
        if (wr == 1) PG8_BAR;
        PG8_WAIT_V(2); PG8_BAR;
        PG8_STAGE(PG8_SB(1, 0), cB + kstep, voffB); PG8_STAGE(PG8_SA(1, 0), cA + kstep, voffA); PG8_STAGE(PG8_SB(1, 1), cB + hstep + kstep, voffB);
        PG8_WAIT_V(6); PG8_BAR;
    } else {
        PG8_STAGE(PG8_SB(0, 0), cB, voffB); PG8_STAGE(PG8_SA(0, 0), cA, voffA); PG8_STAGE(PG8_SB(0, 1), cB + hstep, voffB); PG8_STAGE(PG8_SA(0, 1), cA + hstepA, voffA1);
        if (wr == 1) PG8_BAR;
        PG8_WAIT_V(4); PG8_BAR;
        PG8_STAGE(PG8_SB(1, 0), cB + kstep, voffB); PG8_STAGE(PG8_SA(1, 0), cA + kstep, voffA); PG8_STAGE(PG8_SB(1, 1), cB + hstep + kstep, voffB);
        PG8_WAIT_V(6); PG8_BAR;
    }
    for (;;) {
        const bool has_next = S.next(ui + 1, nxt);
        const char* nA = has_next ? (const char*)g.A + (size_t)nxt.pm * tstep : cA; const char* nB = has_next ? (const char*)g.Bt + (size_t)nxt.pn * tstep : cB;
        for (int t = 0; t < nt; t += 2) {
            const bool last = (t == nt - 2);
            const char* a1 = cA + (size_t)(t + 1) * kstep;
            const char* a2 = last ? nA : cA + (size_t)(t + 2) * kstep; const char* b2 = last ? nB : cB + (size_t)(t + 2) * kstep;
            const char* a3 = a2 + kstep; const char* b3 = b2 + kstep;
            if (last && has_next) S.a_ready(nxt);
            if constexpr (SP2) {
            PG8_LDB(B0, 0, 0); PG8_LDB(B1, 0, 1); PG8_SCHED; PG8_LDA(At, 0, 0); PG8_STAGE(PG8_SA(1, 1), a1 + hstepA, voffA1);
            PG8_WAIT_V(8); PG8_WAIT_L(0); PG8_BAR; PG8_MMA(0, 0, At, B0); PG8_MMA(0, 1, At, B1); PG8_BAR; PG8_SCHED;
            PG8_LDA(At, 0, 1); PG8_STAGE(PG8_SB(0, 0), b2, voffB); PG8_STAGE(PG8_SB(0, 1), b2 + hstep, voffB); PG8_STAGE(PG8_SA(0, 0), a2, voffA);
            PG8_WAIT_V(8); PG8_WAIT_L(0); PG8_BAR; PG8_MMA(1, 0, At, B0); PG8_MMA(1, 1, At, B1); PG8_BAR; PG8_SCHED;
            PG8_LDB(B0, 1, 0); PG8_LDB(B1, 1, 1); PG8_SCHED; PG8_LDA(At, 1, 0); PG8_STAGE(PG8_SA(0, 1), a2 + hstepA, voffA1);
            PG8_WAIT_V(8); PG8_WAIT_L(0); PG8_BAR; PG8_MMA(0, 0, At, B0); PG8_MMA(0, 1, At, B1); PG8_BAR; PG8_SCHED;
            PG8_LDA(At, 1, 1); PG8_STAGE(PG8_SB(1, 0), b3, voffB); PG8_STAGE(PG8_SB(1, 1), b3 + hstep, voffB); PG8_STAGE(PG8_SA(1, 0), a3, voffA);
            PG8_WAIT_V(8); PG8_WAIT_L(0); PG8_BAR; PG8_MMA(1, 0, At, B0); PG8_MMA(1, 1, At, B1); PG8_BAR; PG8_SCHED;
            } else {
            PG8_LDB(B0, 0, 0); PG8_SCHED; PG8_LDA(At, 0, 0); PG8_STAGE(PG8_SA(1, 1), a1 + hstepA, voffA1);
            PG8_WAIT_L(8); PG8_BAR; PG8_WAIT_L(0); PG8_MMA(0, 0, At, B0); PG8_BAR; PG8_SCHED;
            PG8_LDB(B1, 0, 1); PG8_STAGE(PG8_SB(0, 0), b2, voffB);
            PG8_BAR; PG8_WAIT_L(0); PG8_MMA(0, 1, At, B1); PG8_BAR;
            PG8_LDA(At, 0, 1); PG8_STAGE(PG8_SA(0, 0), a2, voffA);
            PG8_BAR; PG8_WAIT_L(0); PG8_MMA(1, 0, At, B0); PG8_BAR; PG8_SCHED;
            PG8_STAGE(PG8_SB(0, 1), b2 + hstep, voffB);
            PG8_WAIT_V(6); PG8_BAR; PG8_MMA(1, 1, At, B1); PG8_BAR;
            PG8_LDB(B0, 1, 0); PG8_SCHED; PG8_LDA(At, 1, 0); PG8_STAGE(PG8_SA(0, 1), a2 + hstepA, voffA1);
            PG8_WAIT_L(8); PG8_BAR; PG8_WAIT_L(0); PG8_MMA(0, 0, At, B0); PG8_BAR; PG8_SCHED;
            PG8_LDB(B1, 1, 1); PG8_STAGE(PG8_SB(1, 0), b3, voffB);
            PG8_BAR; PG8_WAIT_L(0); PG8_MMA(0, 1, At, B1); PG8_BAR;
            PG8_LDA(At, 1, 1); PG8_STAGE(PG8_SA(1, 0), a3, voffA);
            PG8_BAR; PG8_WAIT_L(0); PG8_MMA(1, 0, At, B0); PG8_BAR; PG8_SCHED;
            PG8_STAGE(PG8_SB(1, 1), b3 + hstep, voffB);
            PG8_WAIT_V(6); PG8_BAR; PG8_MMA(1, 1, At, B1); PG8_BAR;
            }
        }
        if constexpr (ALIGN_EPI) { if (wr == 0) PG8_BAR; }
        if constexpr (!Epi::AFTER_DRAIN) { E(acc, cur, wr, wc, fr, fq); S.done(cur); }
        if (!has_next) break;
#pragma unroll
        for (int a = 0; a < 2; ++a)
#pragma unroll
            for (int b = 0; b < 2; ++b)
#pragma unroll
                for (int m = 0; m < 4; ++m)
#pragma unroll
                    for (int n = 0; n < 2; ++n) acc[a][b][m][n] = (f32x4){0.f, 0.f, 0.f, 0.f};
        cur = nxt; cA = nA; cB = nB; ++ui;
        if constexpr (ALIGN_EPI) { if (wr == 1) PG8_BAR; }
    }
    PG8_WAIT_V(0);
    if constexpr (!ALIGN_EPI) { if (wr == 0) PG8_BAR; }
    PG8_BAR;
    if constexpr (Epi::AFTER_DRAIN) { E.fused(acc, cur, wr, wc, fr, fq, lds, wid, lane); S.done(cur); }
#undef PG8_SA
#undef PG8_SB
#undef PG8_STAGE
#undef PG8_LDA
#undef PG8_LDB
#undef PG8_MMA
#undef PG8_WAIT_V
#undef PG8_WAIT_L
#undef PG8_BAR
#undef PG8_SCHED
}
}

constexpr int NWAVES = 8;
#ifndef MK_N_LAUNCHES
#define MK_N_LAUNCHES 1
#endif
#ifndef SPLIT_MIXERS
#define SPLIT_MIXERS 0
#endif
#ifndef PG_SP2
#define PG_SP2 true
#endif
constexpr int NPHASE = 12;
constexpr int N_LAUNCHES = MK_N_LAUNCHES;
constexpr int BATCH = 8, SEQ = 8192, D = 1024, T = BATCH * SEQ;
constexpr int D_IN = 3688;
constexpr float EPS = 1e-6f;
constexpr int NEXP = 32, DFF = 1024;
constexpr int NTASK = T / 32;
constexpr int MAXBLK = 1056;

constexpr size_t MiB = 1u << 20;
constexpr size_t WS_CTL = 0, CTL_ZERO_BYTES = 64 * 1024;
constexpr int CW_BAR = 1024;
constexpr size_t WS_WIN = 1 * MiB;
constexpr size_t WS_WG = 5 * MiB;
constexpr size_t WS_WUQ = 9 * MiB;
constexpr size_t WS_WUKV = 10 * MiB;
constexpr size_t WS_WBA = 11 * MiB;
constexpr size_t WS_WBB = 12 * MiB;
constexpr size_t WS_WOUT = 13 * MiB;
constexpr size_t WS_TOKE = 15 * MiB;
constexpr size_t WS_TOKG = 16 * MiB;
constexpr size_t WS_TOKR = 17 * MiB;
constexpr size_t WS_CNT = 18 * MiB;
constexpr size_t WS_ROWTOK = 19 * MiB;
constexpr size_t WS_BLKE = 21 * MiB;
constexpr size_t WS_WGU = 24 * MiB;
constexpr size_t WS_WD = 152 * MiB;
constexpr size_t WS_H = 216 * MiB;
constexpr size_t WS_CQ = 344 * MiB;
constexpr size_t WS_CKV = 376 * MiB;
constexpr size_t WS_KPE = 392 * MiB;
constexpr size_t WS_KB = 396 * MiB;
constexpr size_t WS_VB = 404 * MiB;
constexpr size_t WS_KIDX = 412 * MiB;
constexpr size_t WS_WIDX = 420 * MiB;
constexpr size_t WS_QB = 424 * MiB;
constexpr size_t WS_QIDX = 488 * MiB;
constexpr size_t WS_QMLA = 552 * MiB;
constexpr size_t WS_KV = 648 * MiB;
constexpr size_t WS_YA = 776 * MiB;
constexpr size_t WS_YB = 840 * MiB;
constexpr size_t WS_G = 344 * MiB;
constexpr size_t WS_M = 600 * MiB;
constexpr size_t WS_YBUF = 216 * MiB;
constexpr size_t WS_SCR = 728 * MiB;
constexpr size_t WS_XN2 = 856 * MiB;
constexpr size_t WS_ROWSRC = 22 * MiB;
constexpr size_t WS_CS16 = 984 * MiB;
constexpr size_t WS_CS32 = 988 * MiB;
constexpr size_t WS_TAILACT = 990 * MiB;
constexpr size_t WS_RSTOK = 1006 * MiB;
constexpr size_t WS_ROWRS = 1007 * MiB;
constexpr size_t WS_END = 1009 * MiB;

constexpr int RING_BYTES = 131072;
constexpr int LDS_BYTES = 163840;
constexpr int MISC_OFF = LDS_BYTES - 64;

#define GAS __attribute__((address_space(1)))
#define LAS __attribute__((address_space(3)))
typedef unsigned short bf16;
typedef unsigned v4u __attribute__((ext_vector_type(4)));
typedef unsigned v2u __attribute__((ext_vector_type(2)));
typedef float f32x4 __attribute__((ext_vector_type(4)));
typedef float f32x2 __attribute__((ext_vector_type(2)));
typedef float f32x16 __attribute__((ext_vector_type(16)));
typedef short bf16x8 __attribute__((ext_vector_type(8)));
typedef short s16x4 __attribute__((ext_vector_type(4)));
typedef GAS unsigned gu32;
#define RLX_AGENT __ATOMIC_RELAXED, __HIP_MEMORY_SCOPE_AGENT
#define LDS_WAIT() asm volatile("s_waitcnt lgkmcnt(0)" ::: "memory")
#define VM_WAIT() asm volatile("s_waitcnt vmcnt(0)" ::: "memory")
__device__ __forceinline__ unsigned f2bf(float f) { unsigned u = __builtin_bit_cast(unsigned, f); return (u + 0x7fffu + ((u >> 16) & 1u)) >> 16; }
__device__ __forceinline__ unsigned pk2(float lo, float hi) { return f2bf(lo) | (f2bf(hi) << 16); }
__device__ __forceinline__ float bf2f(unsigned short b) { return __builtin_bit_cast(float, (unsigned)b << 16); }
__device__ __forceinline__ float bflo(unsigned w) { return __builtin_bit_cast(float, w << 16); }
__device__ __forceinline__ float bfhi(unsigned w) { return __builtin_bit_cast(float, w & 0xffff0000u); }
__device__ __forceinline__ float wave_sum(float v) {
#pragma unroll
    for (int o = 1; o < 64; o <<= 1) v += __shfl_xor(v, o);
    return v;
}

namespace pg8 {
typedef unsigned u32x4 __attribute__((ext_vector_type(4)));
__device__ __forceinline__ u32x4 pack8(const f32x4 a, const f32x4 b) { u32x4 w; w.x = cvt_pk_bf16(a[0], a[1]); w.y = cvt_pk_bf16(a[2], a[3]); w.z = cvt_pk_bf16(b[0], b[1]); w.w = cvt_pk_bf16(b[2], b[3]); return w; }
__device__ __forceinline__ void unpack8(const u32x4 w, f32x4& a, f32x4& b) {
    a[0] = __builtin_bit_cast(float, w.x << 16); a[1] = __builtin_bit_cast(float, w.x & 0xffff0000u); a[2] = __builtin_bit_cast(float, w.y << 16); a[3] = __builtin_bit_cast(float, w.y & 0xffff0000u);
    b[0] = __builtin_bit_cast(float, w.z << 16); b[1] = __builtin_bit_cast(float, w.z & 0xffff0000u); b[2] = __builtin_bit_cast(float, w.w << 16); b[3] = __builtin_bit_cast(float, w.w & 0xffff0000u); }
__device__ __forceinline__ float sigmoidf_(float v) { return __builtin_amdgcn_rcpf(1.f + __builtin_amdgcn_exp2f(-1.4426950408889634f * v)); }

#define EPI_LOOP_BEGIN const int row0 = u.pm * BM + wr * 64 + fr; \
    _Pragma("unroll") for (int ai = 0; ai < 2; ++ai) _Pragma("unroll") for (int m = 0; m < 4; ++m) { const int row = row0 + ai * HALF + m * 16; \
    _Pragma("unroll") for (int bj = 0; bj < 2; ++bj) { const int cg = bj * HALF + wc * 32 + 8 * fq; const f32x4 v0 = acc[ai][bj][m][0], v1 = acc[ai][bj][m][1];
#define EPI_LOOP_END } }

struct EpiStore {
    static constexpr bool PERM = true, AFTER_DRAIN = false;
    bf16_t* O; int ldc;
    __device__ __forceinline__ void operator()(const f32x4 (&acc)[2][2][4][2], const Unit& u, int wr, int wc, int fr, int fq) const {
        EPI_LOOP_BEGIN
            { const u32x4 w_ = pack8(v0, v1); CHKW_S(8, w_.x + w_.y + w_.z + w_.w); *(u32x4*)(O + (size_t)row * ldc + u.pn * BM + cg) = w_; }
        EPI_LOOP_END
    }
};
struct EpiZ {
    static constexpr bool PERM = true, AFTER_DRAIN = false;
    bf16_t *cq, *ckv, *kpe, *kb, *vb, *kidx, *qb, *qidx; float* widx;
    __device__ __forceinline__ void operator()(const f32x4 (&acc)[2][2][4][2], const Unit& u, int wr, int wc, int fr, int fq) const {
        const int pn = u.pn;
        EPI_LOOP_BEGIN
            const u32x4 w = pack8(v0, v1); CHKW_S(9, w.x + w.y + w.z + w.w);
            if (pn == 0) *(u32x4*)(cq + (size_t)row * 256 + cg) = w;
            else if (pn == 1) {
                if (cg < 128) *(u32x4*)(ckv + (size_t)row * 128 + cg) = w;
                else if (cg < 160) *(u32x4*)(kpe + (size_t)row * 32 + (cg - 128)) = w;
                else if (cg < 224) *(u32x4*)(kb + (size_t)row * 64 + (cg - 160)) = w;
            } else if (pn == 2) {
                if (cg < 64) *(u32x4*)(vb + (size_t)row * 64 + cg) = w;
                else if (cg < 128) { const int d_ = cg - 64;
                    *(u32x4*)(kidx + ((size_t)((row >> 13) * 4 + (d_ >> 4)) * 8192 + (row & 8191)) * 16 + ((d_ >> 3) & 1) * 8) = w; }
                else if (cg < 136) { *(f32x4*)(widx + (size_t)row * 8) = v0; *(f32x4*)(widx + (size_t)row * 8 + 4) = v1; }
            } else if (pn < 5) *(u32x4*)(qb + (size_t)row * 512 + (pn - 3) * 256 + cg) = w;
            else *(u32x4*)(qidx + (size_t)row * 512 + (pn - 5) * 256 + cg) = w;
        EPI_LOOP_END
    }
};
struct EpiGate {
    static constexpr bool PERM = true, AFTER_DRAIN = false;
    bf16_t* G;
    __device__ __forceinline__ void operator()(const f32x4 (&acc)[2][2][4][2], const Unit& u, int wr, int wc, int fr, int fq) const {
        EPI_LOOP_BEGIN
            f32x4 a, b;
#pragma unroll
            for (int i = 0; i < 4; ++i) { a[i] = sigmoidf_(v0[i]); b[i] = sigmoidf_(v1[i]); }
            { const u32x4 w_ = pack8(a, b); CHKW_S(10, w_.x + w_.y + w_.z + w_.w); *(u32x4*)(G + (size_t)row * 2048 + u.pn * BM + cg) = w_; }
        EPI_LOOP_END
    }
};
template <int SECOND> struct EpiMerge {
    static constexpr bool PERM = true, AFTER_DRAIN = false;
    const bf16_t* G; bf16_t* Mo;
    __device__ __forceinline__ void operator()(const f32x4 (&acc)[2][2][4][2], const Unit& u, int wr, int wc, int fr, int fq) const {
        const int row0 = u.pm * BM + wr * 64 + fr;
#pragma unroll
        for (int ai = 0; ai < 2; ++ai) {
            u32x4 gq[4][2], mq[4][2];
#pragma unroll
            for (int m = 0; m < 4; ++m)
#pragma unroll
                for (int bj = 0; bj < 2; ++bj) { const int row = row0 + ai * HALF + m * 16, col = u.pn * BM + bj * HALF + wc * 32 + 8 * fq;
                    gq[m][bj] = *(const u32x4*)(G + (size_t)row * 2048 + SECOND * 1024 + col);
                    if (SECOND) mq[m][bj] = *(const u32x4*)(Mo + (size_t)row * 1024 + col); }
            asm volatile("" ::: "memory");
#pragma unroll
            for (int m = 0; m < 4; ++m)
#pragma unroll
                for (int bj = 0; bj < 2; ++bj) { const int row = row0 + ai * HALF + m * 16, col = u.pn * BM + bj * HALF + wc * 32 + 8 * fq;
                    f32x4 ga, gb; unpack8(gq[m][bj], ga, gb);
                    f32x4 a = ga * acc[ai][bj][m][0], b = gb * acc[ai][bj][m][1];
                    if (SECOND) { f32x4 pa, pb; unpack8(mq[m][bj], pa, pb); a = a + pa; b = b + pb; }
                    { const u32x4 w_ = pack8(a, b); CHKW_S(11, w_.x + w_.y + w_.z + w_.w); *(u32x4*)(Mo + (size_t)row * 1024 + col) = w_; } }
        }
    }
};
struct EpiX1 {
    static constexpr bool PERM = true, AFTER_DRAIN = false;
    const float* x; float* out; const float* fg; bf16_t* xb;
    __device__ __forceinline__ void operator()(const f32x4 (&acc)[2][2][4][2], const Unit& u, int wr, int wc, int fr, int fq) const {
        const int row0 = u.pm * BM + wr * 64 + fr;
        f32x4 gv[2][2];
#pragma unroll
        for (int bj = 0; bj < 2; ++bj) { const int cgl = u.pn * BM + bj * HALF + wc * 32 + 8 * fq; gv[bj][0] = *(const f32x4*)(fg + cgl); gv[bj][1] = *(const f32x4*)(fg + cgl + 4); }
#pragma unroll
        for (int ai = 0; ai < 2; ++ai) {
            f32x4 xq[4][2][2];
#pragma unroll
            for (int m = 0; m < 4; ++m)
#pragma unroll
                for (int bj = 0; bj < 2; ++bj) { const size_t off = (size_t)(row0 + ai * HALF + m * 16) * 1024 + u.pn * BM + bj * HALF + wc * 32 + 8 * fq;
                    xq[m][bj][0] = *(const f32x4*)(x + off); xq[m][bj][1] = *(const f32x4*)(x + off + 4); }
            asm volatile("" ::: "memory");
#pragma unroll
            for (int m = 0; m < 4; ++m)
#pragma unroll
                for (int bj = 0; bj < 2; ++bj) { const size_t off = (size_t)(row0 + ai * HALF + m * 16) * 1024 + u.pn * BM + bj * HALF + wc * 32 + 8 * fq;
                    const f32x4 r0_ = xq[m][bj][0] + acc[ai][bj][m][0], r1_ = xq[m][bj][1] + acc[ai][bj][m][1];
                    CHKW_S(12, __builtin_bit_cast(unsigned, r0_[0]) + __builtin_bit_cast(unsigned, r0_[1]) + __builtin_bit_cast(unsigned, r0_[2]) + __builtin_bit_cast(unsigned, r0_[3]) + __builtin_bit_cast(unsigned, r1_[0]) + __builtin_bit_cast(unsigned, r1_[1]) + __builtin_bit_cast(unsigned, r1_[2]) + __builtin_bit_cast(unsigned, r1_[3]));
                    *(f32x4*)(out + off) = r0_; *(f32x4*)(out + off + 4) = r1_;
                    *(u32x4*)(xb + off) = pack8(r0_ * gv[bj][0], r1_ * gv[bj][1]); }
        }
    }
};
struct EpiGU {
    static constexpr bool PERM = true, AFTER_DRAIN = false;
    bf16_t* act; const float* bgu; const float* rs;
    __device__ __forceinline__ void operator()(const f32x4 (&acc)[2][2][4][2], const Unit& u, int wr, int wc, int fr, int fq) const {
        typedef unsigned u32x2 __attribute__((ext_vector_type(2)));
        const int pnl = u.pn & 7, col = pnl * 128 + wc * 32 + 8 * fq;
        float rr[2][4]; f32x4 bgv[2], blv[2];
#pragma unroll
        for (int ai = 0; ai < 2; ++ai)
#pragma unroll
            for (int m = 0; m < 4; ++m) rr[ai][m] = rs[ai * HALF + wr * 64 + m * 16 + fr];
#pragma unroll
        for (int n = 0; n < 2; ++n) { bgv[n] = *(const f32x4*)(bgu + col + 4 * n); blv[n] = *(const f32x4*)(bgu + 1024 + col + 4 * n) + 1.f; }
        asm volatile("" ::: "memory");
#pragma unroll
        for (int n = 0; n < 2; ++n) {
            const f32x4 bg = bgv[n], bl = blv[n];
#pragma unroll
            for (int ai = 0; ai < 2; ++ai)
#pragma unroll
                for (int m = 0; m < 4; ++m) { const int row = ai * HALF + wr * 64 + m * 16 + fr; const float rq = rr[ai][m];
                    const f32x4 g = acc[ai][0][m][n] * rq + bg, l1 = acc[ai][1][m][n] * rq + bl; f32x4 o;
#pragma unroll
                    for (int i = 0; i < 4; ++i) { const float gl = fminf(g[i], 7.f), li1 = fminf(fmaxf(l1[i], -6.f), 8.f);
                        o[i] = gl * __builtin_amdgcn_rcpf(1.f + __builtin_amdgcn_exp2f(gl * (-1.702f * 1.4426950408889634f))) * li1; }
                    u32x2 w; w.x = cvt_pk_bf16(o[0], o[1]); w.y = cvt_pk_bf16(o[2], o[3]); CHKW_S(13, w.x + w.y);
                    *(u32x2*)(act + (size_t)row * 1024 + col + 4 * n) = w; }
        }
    }
};
struct EpiDown {
    static constexpr bool PERM = true, AFTER_DRAIN = false;
    bf16_t* ybuf; const float* bd; const int* rowtok;
    __device__ __forceinline__ void operator()(const f32x4 (&acc)[2][2][4][2], const Unit& u, int wr, int wc, int fr, int fq) const {
        const int pnl = u.pn & 3;
        int dstv[2][4]; f32x4 bv[2][2];
#pragma unroll
        for (int ai = 0; ai < 2; ++ai)
#pragma unroll
            for (int m = 0; m < 4; ++m) dstv[ai][m] = rowtok[ai * HALF + wr * 64 + m * 16 + fr];
#pragma unroll
        for (int bj = 0; bj < 2; ++bj) { const int col = pnl * BM + bj * HALF + wc * 32 + 8 * fq; bv[bj][0] = *(const f32x4*)(bd + col); bv[bj][1] = *(const f32x4*)(bd + col + 4); }
        asm volatile("" ::: "memory");
#pragma unroll
        for (int ai = 0; ai < 2; ++ai)
#pragma unroll
            for (int m = 0; m < 4; ++m) { const int dst = dstv[ai][m];
                if (dst >= 0) {
#pragma unroll
                    for (int bj = 0; bj < 2; ++bj) { const int col = pnl * BM + bj * HALF + wc * 32 + 8 * fq;
                        { const u32x4 w_ = pack8(acc[ai][bj][m][0] + bv[bj][0], acc[ai][bj][m][1] + bv[bj][1]); CHKW_S(14, w_.x + w_.y + w_.z + w_.w); __builtin_nontemporal_store(w_, (u32x4*)(ybuf + (size_t)dst * 1024 + col)); } } } }
    }
};
template <bool GATHER_> struct ListOrderT {
    static constexpr bool GATHER = GATHER_;
    int n, pn0, z; const int* rows;
    __device__ __forceinline__ bool next(int i, Unit& u) const { if (i >= n) return false; u.pm = 0; u.pn = pn0 + i; return true; }
    __device__ __forceinline__ int tid_bias() const { return z; }
    __device__ __forceinline__ void a_ready(const Unit&) const {}
    __device__ __forceinline__ void done(const Unit&) const {}
};
}
#define XB_TMO      128
#define XB_XCNT(j)  (256  + 64 * (j))
#define XB_XSUB(j)  (1280 + 64 * (j))
#define XB_XGEN(j)  (2304 + 64 * (j))
#define XB_TOP      3328
#define XB_TOPGEN   3392
#define XCD_BAR_WORDS 3456
#define XB_SPIN_CAP (1u << 18)

__device__ __forceinline__ unsigned xb_ld(unsigned* p)              { return __hip_atomic_load(p, __ATOMIC_RELAXED, __HIP_MEMORY_SCOPE_AGENT); }
__device__ __forceinline__ unsigned xb_add(unsigned* p, unsigned v) { return __hip_atomic_fetch_add(p, v, __ATOMIC_RELAXED, __HIP_MEMORY_SCOPE_AGENT); }
__device__ __forceinline__ unsigned xb_xcc_id() { return (unsigned)__builtin_amdgcn_s_getreg((3 << 11) | 20) & 0xFu; }
#define XB_SPIN(cond, bar) do { unsigned _sp = 0; while (cond) { __builtin_amdgcn_s_sleep(1); \
    if ((++_sp & 255u) == 0u) { if (xb_ld(&(bar)[XB_TMO])) break; if (_sp > XB_SPIN_CAP) { atomicAdd(&(bar)[XB_TMO], 1u); break; } } } } while (0)

struct XcdBarrier {
    unsigned* bar; unsigned x;
    volatile LAS unsigned* st;
};

__device__ __forceinline__ XcdBarrier xcd_barrier_post(unsigned* bar, volatile LAS unsigned* st) {
    XcdBarrier b; b.bar = bar; b.x = xb_xcc_id(); b.st = st;
    if (threadIdx.x == 0) (void)xb_add(&bar[XB_XCNT(b.x)], 1u);
    return b;
}
__device__ __forceinline__ void xcd_barrier_complete(unsigned* bar, unsigned x, unsigned& nloc, unsigned& nx) {
    const unsigned G = gridDim.x * gridDim.y * gridDim.z;
    unsigned sum, cnt, mine, sp = 0u;
    for (;;) {
        sum = 0u; cnt = 0u; mine = 0u;
#pragma unroll
        for (unsigned j = 0; j < 16; ++j) { const unsigned c = xb_ld(&bar[XB_XCNT(j)]); sum += c; cnt += (c > 0u) ? 1u : 0u; mine = (j == x) ? c : mine; }
        if (sum == G) break;
        __builtin_amdgcn_s_sleep(1);
        if ((++sp & 255u) == 0u) { if (xb_ld(&bar[XB_TMO])) break; if (sp > XB_SPIN_CAP) { atomicAdd(&bar[XB_TMO], 1u); break; } }
    }
    nloc = mine > 0u ? mine : 1u; nx = cnt > 0u ? cnt : 1u;
}

__device__ __forceinline__ void xcd_barrier(const XcdBarrier& b) {
    asm volatile("s_waitcnt vmcnt(0)" ::: "memory");
    __syncthreads();
    if (threadIdx.x == 0) {
        unsigned* bar = b.bar;
        __builtin_amdgcn_s_waitcnt(0);
        unsigned nloc = b.st[0], nx = b.st[1];
        if (nloc == 0u) { xcd_barrier_complete(bar, b.x, nloc, nx); b.st[0] = nloc; b.st[1] = nx; }
        const unsigned old = xb_add(&bar[XB_XSUB(b.x)], 1u);
        const unsigned gen = old / nloc;
        if (old + 1u == (gen + 1u) * nloc) {
            __builtin_amdgcn_fence(__ATOMIC_RELEASE, "agent");
            asm volatile("s_waitcnt vmcnt(0)" ::: "memory");
            const unsigned og = xb_add(&bar[XB_TOP], 1u);
            const unsigned tg = og / nx;
            if (og + 1u == (tg + 1u) * nx) xb_add(&bar[XB_TOPGEN], 1u);
            else XB_SPIN(xb_ld(&bar[XB_TOPGEN]) == tg, bar);
            __builtin_amdgcn_fence(__ATOMIC_ACQUIRE, "agent");
            xb_add(&bar[XB_XGEN(b.x)], 1u);
            asm volatile("s_waitcnt vmcnt(0)" ::: "memory");
        } else {
            XB_SPIN(xb_ld(&bar[XB_XGEN(b.x)]) == gen, bar);
            __builtin_amdgcn_fence(__ATOMIC_ACQUIRE, "agent");
            asm volatile("s_waitcnt vmcnt(0)" ::: "memory");
        }
    }
    __syncthreads();
}

struct Frame {
    LAS unsigned char* lds;
    volatile LAS unsigned* MISC;
    gu32* ctl;
    int tid, lane, wave;
    int vcu, G;
    unsigned char* ws;
    const float* x; const int* pos; float* out;
    const float *attn_g, *w_in, *qn_g, *w_uq, *kvn_g, *w_ukv, *w_ba, *w_bb, *w_out, *ffn_g, *r_w, *r_b, *w_gu, *b_gu, *w_d, *b_d, *fin_g;
};
#define WSP(T_, off) ((T_*)(F.ws + (off)))

__constant__ float c_inv16[8] = {1.000000000e+00f, 1.939227432e-01f, 3.760603070e-02f, 7.292664610e-03f, 1.414213562e-03f, 2.742481884e-04f, 5.318295734e-05f, 1.031338525e-05f};
__constant__ float c_inv32[16] = {1.000000000e+00f, 4.403665960e-01f, 1.939227432e-01f, 8.539710194e-02f, 3.760603070e-02f, 1.656044088e-02f, 7.292664610e-03f, 3.211446106e-03f,
                                  1.414213562e-03f, 6.227724371e-04f, 2.742481884e-04f, 1.207697351e-04f, 5.318295734e-05f, 2.341999971e-05f, 1.031338525e-05f, 4.541670478e-06f};

__device__ __forceinline__ int map_win(int n) {
    const int t = n >> 8, j = n & 255;
    if (t == 0) return j;
    if (t == 1) return j < 128 ? 256 + j : j < 160 ? 384 + (j - 128) : j < 224 ? 928 + (j - 160) : -1;
    if (t == 2) return j < 64 ? 992 + j : j < 128 ? 1568 + (j - 64) : j < 136 ? 1632 + (j - 128) : -1;
    if (t < 5) return 416 + (n - 768);
    return 1056 + (n - 1280);
}
__device__ __forceinline__ int map_gu(int n) { const int pn = n >> 8, bj = (n >> 7) & 1, cc = n & 127; return bj * 1024 + pn * 128 + cc; }
template <int MAP>
__device__ __forceinline__ void p0_item(const float* W, int ldw, int K, bf16* WT, int coff, LAS float* scr, int kb, int nb, int lane) {
    const int k0 = 64 * kb, n0 = 32 * nb, nn = n0 + (lane & 31);
    const int col = MAP == 1 ? map_win(nn) : MAP == 2 ? map_gu(nn) : nn + coff;
    float wv[32];
#pragma unroll
    for (int i = 0; i < 32; ++i) { const int kk = 2 * i + (lane >> 5); wv[i] = col >= 0 ? W[(size_t)(k0 + kk) * ldw + col] : 0.f; }
#pragma unroll
    for (int i = 0; i < 32; ++i) { const int kk = 2 * i + (lane >> 5); scr[kk * 33 + (lane & 31)] = wv[i]; }
    LDS_WAIT(); asm volatile("" ::: "memory");
    const int c = lane & 7;
#pragma unroll
    for (int j = 0; j < 4; ++j) { const int n = (lane >> 3) + 8 * j; const LAS float* s = scr + (8 * c) * 33 + n;
        v4u o; o.x = pk2(s[0 * 33], s[1 * 33]); o.y = pk2(s[2 * 33], s[3 * 33]); o.z = pk2(s[4 * 33], s[5 * 33]); o.w = pk2(s[6 * 33], s[7 * 33]);
        CHKW_S(4, o.x + o.y + o.z + o.w); *(GAS v4u*)(WT + (size_t)(n0 + n) * K + k0 + 8 * c) = o; }
    LDS_WAIT(); asm volatile("" ::: "memory");
}
__device__ __forceinline__ void rms_row_to_bf16(const float* xrow, const float* g, bf16* orow, int lane) {
    const GAS f32x4* xr = (const GAS f32x4*)xrow + lane; const GAS f32x4* gr = (const GAS f32x4*)g + lane;
    f32x4 v[4]; float s = 0.f;
#pragma unroll
    for (int j = 0; j < 4; ++j) { v[j] = xr[64 * j]; s += (v[j].x * v[j].x + v[j].y * v[j].y) + (v[j].z * v[j].z + v[j].w * v[j].w); }
    const float rstd = 1.f / sqrtf(wave_sum(s) * (1.f / 1024.f) + EPS);
    GAS unsigned long long* o8 = (GAS unsigned long long*)orow + lane;
#pragma unroll
    for (int j = 0; j < 4; ++j) { const f32x4 gg = gr[64 * j];
        const unsigned long long ov_ = (unsigned long long)pk2(v[j].x * rstd * gg.x, v[j].y * rstd * gg.y) | ((unsigned long long)pk2(v[j].z * rstd * gg.z, v[j].w * rstd * gg.w) << 32); CHKW_S(4, (unsigned)ov_ + (unsigned)(ov_ >> 32)); o8[64 * j] = ov_; }
}
__device__ __forceinline__ void sincos_rev(float ang, float& c, float& s) {
    double r = (double)ang * 0.15915494309189535; r -= __builtin_rint(r); const float rf = (float)r;
    s = __builtin_amdgcn_sinf(rf); c = __builtin_amdgcn_cosf(rf);
}
__device__ __forceinline__ void p0_prologue(Frame& F) {
    LAS float* scr = (LAS float*)(F.lds + F.wave * 16384);
    const int gw = F.vcu * NWAVES + F.wave, NGW = F.G * NWAVES;
    constexpr int I_GU = 32 * 16 * 64, I_D = 32 * 16 * 32, I_IN = 16 * 56, I_G = 16 * 64, I_UQ = 4 * 24, I_UKV = 2 * 32, I_BA = 8 * 32, I_BB = 8 * 32, I_OUT = 16 * 32;
    constexpr int NITEMS = I_GU + I_D + I_IN + I_G + I_UQ + I_UKV + I_BA + I_BB + I_OUT;
    for (int it = gw; it < NITEMS; it += NGW) {
        int r = it;
        if (r < I_GU) { const int e = r >> 10, q = r & 1023; p0_item<2>(F.w_gu + (size_t)e * 1024 * 2048, 2048, 1024, WSP(bf16, WS_WGU) + (size_t)e * 2048 * 1024, 0, scr, q >> 6, q & 63, F.lane); continue; } r -= I_GU;
        if (r < I_D) { const int e = r >> 9, q = r & 511; p0_item<0>(F.w_d + (size_t)e * 1024 * 1024, 1024, 1024, WSP(bf16, WS_WD) + (size_t)e * 1024 * 1024, 0, scr, q >> 5, q & 31, F.lane); continue; } r -= I_D;
        if (r < I_IN) { p0_item<1>(F.w_in, D_IN, 1024, WSP(bf16, WS_WIN), 0, scr, r / 56, r % 56, F.lane); continue; } r -= I_IN;
        if (r < I_G) { p0_item<0>(F.w_in, D_IN, 1024, WSP(bf16, WS_WG), 1640, scr, r >> 6, r & 63, F.lane); continue; } r -= I_G;
        if (r < I_UQ) { p0_item<0>(F.w_uq, 768, 256, WSP(bf16, WS_WUQ), 0, scr, r / 24, r % 24, F.lane); continue; } r -= I_UQ;
        if (r < I_UKV) { p0_item<0>(F.w_ukv, 1024, 128, WSP(bf16, WS_WUKV), 0, scr, r >> 5, r & 31, F.lane); continue; } r -= I_UKV;
        if (r < I_BA) { p0_item<0>(F.w_ba, 1024, 512, WSP(bf16, WS_WBA), 0, scr, r >> 5, r & 31, F.lane); continue; } r -= I_BA;
        if (r < I_BB) { p0_item<0>(F.w_bb, 1024, 512, WSP(bf16, WS_WBB), 0, scr, r >> 5, r & 31, F.lane); continue; } r -= I_BB;
        p0_item<0>(F.w_out, 1024, 1024, WSP(bf16, WS_WOUT), 0, scr, r >> 5, r & 31, F.lane);
    }
    for (int m = gw; m < T; m += NGW) rms_row_to_bf16(F.x + (size_t)m * D, F.attn_g, WSP(bf16, WS_H) + (size_t)m * D, F.lane);
    { const int gt = F.vcu * (NWAVES * 64) + F.tid, NGT = F.G * NWAVES * 64;
      f32x2* cs16 = WSP(f32x2, WS_CS16); f32x2* cs32 = WSP(f32x2, WS_CS32);
      for (int q = gt; q < T * 8; q += NGT) { const int t = q >> 3, i = q & 7; float c, s; sincos_rev((float)F.pos[t] * c_inv16[i], c, s); cs16[q] = (f32x2){c, s}; }
      for (int q = gt; q < T * 16; q += NGT) { const int t = q >> 4, i = q & 15; float c, s; sincos_rev((float)F.pos[t] * c_inv32[i], c, s); cs32[q] = (f32x2){c, s}; } }
}

__device__ __forceinline__ void p2_token_pass(Frame& F) {
    const int gw = F.vcu * NWAVES + F.wave, NGW = F.G * NWAVES, lane = F.lane;
    bf16 *cq = WSP(bf16, WS_CQ), *ckv = WSP(bf16, WS_CKV), *kpe = WSP(bf16, WS_KPE), *kb = WSP(bf16, WS_KB), *kidx = WSP(bf16, WS_KIDX), *qb = WSP(bf16, WS_QB), *qidx = WSP(bf16, WS_QIDX);
    const f32x2* cs16 = WSP(f32x2, WS_CS16); const f32x2* cs32 = WSP(f32x2, WS_CS32);
    const f32x4 gq = *((const GAS f32x4*)F.qn_g + lane); const f32x2 gk = *((const GAS f32x2*)F.kvn_g + lane);
    (void)gw; (void)NGW;
    for (int j = 0; j < 32; ++j) { const int t = (F.vcu >> 5) * SEQ + ((F.vcu & 31) * NWAVES + F.wave) + 256 * j;
        { GAS v2u* p = (GAS v2u*)(cq + (size_t)t * 256) + lane; const v2u w = *p;
          const float a = bflo(w.x), b = bfhi(w.x), c = bflo(w.y), d = bfhi(w.y);
          const float rstd = 1.f / sqrtf(wave_sum(a * a + b * b + c * c + d * d) * (1.f / 256.f) + EPS);
          v2u o; o.x = pk2(a * rstd * gq.x, b * rstd * gq.y); o.y = pk2(c * rstd * gq.z, d * rstd * gq.w); CHKW_S(5, o.x + o.y); *p = o; }
        { GAS unsigned* p = (GAS unsigned*)(ckv + (size_t)t * 128) + lane; const unsigned w = *p;
          const float a = bflo(w), b = bfhi(w);
          const float rstd = 1.f / sqrtf(wave_sum(a * a + b * b) * (1.f / 128.f) + EPS);
          { const unsigned ov_ = pk2(a * rstd * gk.x, b * rstd * gk.y); CHKW_S(5, ov_); *p = ov_; } }
        const f32x2 cs = cs16[(size_t)t * 8 + (lane & 7)];
        { bf16* p = qb + (size_t)t * 512 + (lane >> 3) * 64 + (lane & 7); const float x1 = bf2f(p[0]), x2 = bf2f(p[8]);
          { const unsigned a_ = f2bf(x1 * cs.x - x2 * cs.y), b_ = f2bf(x2 * cs.x + x1 * cs.y); CHKW_S(5, a_ + b_); p[0] = (bf16)a_; p[8] = (bf16)b_; } }
        { bf16* p = qidx + (size_t)t * 512 + (lane >> 3) * 64 + (lane & 7); const float x1 = bf2f(p[0]), x2 = bf2f(p[8]);
          { const unsigned a_ = f2bf(x1 * cs.x - x2 * cs.y), b_ = f2bf(x2 * cs.x + x1 * cs.y); CHKW_S(5, a_ + b_); p[0] = (bf16)a_; p[8] = (bf16)b_; } }
        if (lane < 8) { bf16* p = kb + (size_t)t * 64 + lane; const float x1 = bf2f(p[0]), x2 = bf2f(p[8]);
          { const unsigned a_ = f2bf(x1 * cs.x - x2 * cs.y), b_ = f2bf(x2 * cs.x + x1 * cs.y); CHKW_S(5, a_ + b_); p[0] = (bf16)a_; p[8] = (bf16)b_; } }
        else if (lane < 16) { bf16* p = kidx + ((size_t)((t >> 13) * 4) * 8192 + (t & 8191)) * 16 + (lane - 8); const float x1 = bf2f(p[0]), x2 = bf2f(p[8]);
          { const unsigned a_ = f2bf(x1 * cs.x - x2 * cs.y), b_ = f2bf(x2 * cs.x + x1 * cs.y); CHKW_S(5, a_ + b_); p[0] = (bf16)a_; p[8] = (bf16)b_; } }
        else if (lane < 32) { const int i = lane - 16; const f32x2 c2 = cs32[(size_t)t * 16 + i]; bf16* p = kpe + (size_t)t * 32 + i; const float x1 = bf2f(p[0]), x2 = bf2f(p[16]);
          { const unsigned a_ = f2bf(x1 * c2.x - x2 * c2.y), b_ = f2bf(x2 * c2.x + x1 * c2.y); CHKW_S(5, a_ + b_); p[0] = (bf16)a_; p[16] = (bf16)b_; } }
    }
}

namespace mla {
#ifndef MLA_FASTPATH
#define MLA_FASTPATH 1
#endif
constexpr int KPITCH = 208, KBUF = 64 * KPITCH, VBUF = 8192, BUFB = 2 * (KBUF + VBUF), LDS_WSF = 2 * BUFB, LDS_OST = LDS_WSF + 8 * 256, LDS_BYTES_USED = LDS_OST + 8 * 4096;
constexpr float QSCALE = 0.10206207261596575f * 1.4426950408889634f;
typedef short v4i16_t __attribute__((ext_vector_type(4)));
__device__ __forceinline__ int crow(int r, int hi) { return (r & 3) + 8 * (r >> 2) + 4 * hi; }
__device__ __forceinline__ s16x4 vtr(const LAS unsigned char* p) { return __builtin_bit_cast(s16x4, __builtin_amdgcn_ds_read_tr16_b64_v4i16((LAS v4i16_t*)p)); }
__device__ __forceinline__ unsigned cvtpk(float lo, float hi) { typedef float f2 __attribute__((ext_vector_type(2))); typedef __bf16 b2 __attribute__((ext_vector_type(2)));
    f2 v = {lo, hi}; b2 b = __builtin_convertvector(v, b2); return __builtin_bit_cast(unsigned, b); }

__device__ __forceinline__ float mla_halfmax(float x, float pinf) { const unsigned u = __builtin_bit_cast(unsigned, x); auto r = __builtin_amdgcn_permlane32_swap(u, u, false, false);
    return __builtin_amdgcn_fmed3f(__builtin_bit_cast(float, r[0]), __builtin_bit_cast(float, r[1]), pinf); }
template <int VAR> __device__ __forceinline__ void unit(int zb, int b, int h, int qb, const bf16* qmla, const bf16* kv, const bf16* kpe, const f32x2* cs32, bf16* ya, LAS unsigned char* shm) {
    int tid = zb; asm volatile("" : "+v"(tid));
    float pinf = INFINITY; asm volatile("" : "+s"(pinf));
    const int lane = tid & 63, r32 = lane & 31, hi = lane >> 5; const int wid = __builtin_amdgcn_readfirstlane(tid >> 6);
    const size_t rowbase = (size_t)b * SEQ; const int q0 = qb * 256;
    LAS float* wsf = (LAS float*)(shm + LDS_WSF) + wid * 64;
    bf16x8 qr[6];
    { const size_t tq = rowbase + q0 + wid * 32 + r32; const bf16* Qrow = qmla + tq * 768 + h * 96 + 8 * hi;
      v4u raw[6];
#pragma unroll
      for (int d0 = 0; d0 < 6; ++d0) raw[d0] = *(const GAS v4u*)(Qrow + 16 * d0);
      const GAS f32x4* csp = (const GAS f32x4*)(cs32 + tq * 16 + 8 * hi);
      f32x4 cs[4];
#pragma unroll
      for (int i = 0; i < 4; ++i) cs[i] = csp[i];
#pragma unroll
      for (int d0 = 0; d0 < 4; ++d0) { v4u o;
#pragma unroll
          for (int w = 0; w < 4; ++w) o[w] = cvtpk(bflo(raw[d0][w]) * QSCALE, bfhi(raw[d0][w]) * QSCALE);
          qr[d0] = __builtin_bit_cast(bf16x8, o); }
      v4u o4, o5;
#pragma unroll
      for (int w = 0; w < 4; ++w) {
          const float a0 = bflo(raw[4][w]), a1 = bfhi(raw[4][w]), b0 = bflo(raw[5][w]), b1 = bfhi(raw[5][w]);
          const float c0 = cs[w][0], s0 = cs[w][1], c1 = cs[w][2], s1 = cs[w][3];
          o4[w] = cvtpk((a0 * c0 - b0 * s0) * QSCALE, (a1 * c1 - b1 * s1) * QSCALE);
          o5[w] = cvtpk((b0 * c0 + a0 * s0) * QSCALE, (b1 * c1 + a1 * s1) * QSCALE); }
      qr[4] = __builtin_bit_cast(bf16x8, o4); qr[5] = __builtin_bit_cast(bf16x8, o5); }
    const bf16* kn_src = kv + (rowbase + (tid >> 3)) * 1024 + h * 128 + (tid & 7) * 8;
    const bf16* vv_src = kn_src + 64;
    const bf16* kr_src = kpe + (rowbase + ((tid & 255) >> 2)) * 32 + (tid & 3) * 8;
    const int kn_dst = (tid >> 3) * KPITCH + (tid & 7) * 16, kr_dst = ((tid & 255) >> 2) * KPITCH + 128 + (tid & 3) * 16;
    const int vv_dst = ((tid & 7) >> 2) * 4096 + (tid >> 3) * 64 + (tid & 3) * 16;
    const bool has_kr = tid < 256;
    v4u sk[2], sr[2] = {{0u, 0u, 0u, 0u}, {0u, 0u, 0u, 0u}}, sv[2];
#define MLA_LOAD(st) do { _Pragma("unroll") for (int u_ = 0; u_ < 2; ++u_) { const size_t t_ = (size_t)(2 * (st) + u_); sk[u_] = *(const GAS v4u*)(kn_src + t_ * 64 * 1024); sv[u_] = *(const GAS v4u*)(vv_src + t_ * 64 * 1024); if (has_kr) sr[u_] = *(const GAS v4u*)(kr_src + t_ * 64 * 32); } } while (0)
#define MLA_WRITE(buf) do { LAS unsigned char* B_ = shm + (buf) * BUFB; _Pragma("unroll") for (int u_ = 0; u_ < 2; ++u_) { *(LAS v4u*)(B_ + u_ * KBUF + kn_dst) = sk[u_]; *(LAS v4u*)(B_ + 2 * KBUF + u_ * VBUF + vv_dst) = sv[u_]; if (has_kr) *(LAS v4u*)(B_ + u_ * KBUF + kr_dst) = sr[u_]; } } while (0)
    const int NT = 4 * (qb + 1);
    float m_run = 0.f, l_run = 0.f; f32x16 o[2]; o[0] = f32x16{}; o[1] = f32x16{}; f32x16 minit = f32x16{};
    const int kread = r32 * KPITCH + hi * 16;
    const int vread = ((lane >> 4) & 1) * 32 + (lane & 3) * 8 + (4 * hi + ((lane & 15) >> 2)) * 64;
#define MLA_BAR() do { LDS_WAIT(); __builtin_amdgcn_s_barrier(); asm volatile("" ::: "memory"); } while (0)
#define MLA_QK(cur, u, P0, P1) do { const LAS unsigned char* Kb_ = shm + (cur) * BUFB + (u) * KBUF; P0 = f32x16{}; P1 = f32x16{}; \
            _Pragma("unroll") for (int d0 = 0; d0 < 6; ++d0) { \
                const bf16x8 k0f = *(const LAS bf16x8*)(Kb_ + kread + d0 * 32), k1f = *(const LAS bf16x8*)(Kb_ + kread + 32 * KPITCH + d0 * 32); \
                P0 = __builtin_amdgcn_mfma_f32_32x32x16_bf16(k0f, qr[d0], P0, 0, 0, 0); \
                P1 = __builtin_amdgcn_mfma_f32_32x32x16_bf16(k1f, qr[d0], P1, 0, 0, 0); } } while (0)
#define MLA_MX2(a, b) __builtin_amdgcn_fmed3f((a), (b), pinf)
#define MLA_HALFMAX(X) mla_halfmax(X, pinf)
#define MLA_MAX(P0, P1, MX) do { _Pragma("unroll") for (int r = 0; r < 16; ++r) MX = MLA_MX2(MX, MLA_MX2(P0[r], P1[r])); } while (0)
#define MLA_EXP0(P0, P1, LS) do { _Pragma("unroll") for (int r = 0; r < 16; ++r) { P0[r] = __builtin_amdgcn_exp2f(P0[r]); P1[r] = __builtin_amdgcn_exp2f(P1[r]); LS += P0[r] + P1[r]; } } while (0)
#define MLA_EXP(P0, P1, MN, LS) do { _Pragma("unroll") for (int r = 0; r < 16; ++r) { P0[r] = __builtin_amdgcn_exp2f(P0[r] - MN); P1[r] = __builtin_amdgcn_exp2f(P1[r] - MN); LS += P0[r] + P1[r]; } } while (0)
#define MLA_RESCALE(ALPHA) do { if (__any(ALPHA != 1.f)) { if (hi == 0) wsf[r32] = ALPHA; LDS_WAIT(); \
            _Pragma("unroll") for (int g = 0; g < 4; ++g) { const f32x4 f = *(const LAS f32x4*)(wsf + 8 * g + 4 * hi); \
                _Pragma("unroll") for (int i = 0; i < 4; ++i) { o[0][4 * g + i] *= f[i]; o[1][4 * g + i] *= f[i]; } } } } while (0)
#define MLA_LDV(i) do { vq[i][0] = vtr(Vb_ + vread + ((i) & 1) * 4096 + ((i) >> 1) * 1024); vq[i][1] = vtr(Vb_ + vread + ((i) & 1) * 4096 + ((i) >> 1) * 1024 + 512); } while (0)
#define MLA_PV(cur, u, P0, P1) do { const LAS unsigned char* Vb_ = shm + (cur) * BUFB + 2 * KBUF + (u) * VBUF; v4u pw[4]; s16x4 vq[8][2];        \
            MLA_LDV(0); MLA_LDV(1); MLA_LDV(2); MLA_LDV(3); \
            _Pragma("unroll") for (int w = 0; w < 4; ++w) { pw[0][w] = cvtpk(P0[2 * w], P0[2 * w + 1]); pw[1][w] = cvtpk(P0[8 + 2 * w], P0[9 + 2 * w]); pw[2][w] = cvtpk(P1[2 * w], P1[2 * w + 1]); pw[3][w] = cvtpk(P1[8 + 2 * w], P1[9 + 2 * w]); } \
            _Pragma("unroll") for (int i = 0; i < 8; ++i) { \
                const bf16x8 vf = {vq[i][0][0], vq[i][0][1], vq[i][0][2], vq[i][0][3], vq[i][1][0], vq[i][1][1], vq[i][1][2], vq[i][1][3]}; \
                o[i & 1] = __builtin_amdgcn_mfma_f32_32x32x16_bf16(__builtin_bit_cast(bf16x8, pw[i >> 1]), vf, o[i & 1], 0, 0, 0); \
                if (i + 4 < 8) MLA_LDV(i + 4); } \
            __builtin_amdgcn_sched_group_barrier(0x100, 8, 0); \
            _Pragma("unroll") for (int i_ = 0; i_ < 4; ++i_) { __builtin_amdgcn_sched_group_barrier(0x008, 1, 0); __builtin_amdgcn_sched_group_barrier(0x100, 2, 0); } \
            __builtin_amdgcn_sched_group_barrier(0x008, 4, 0); } while (0)
#define MLA_LDK(d) do { kq[d][0] = *(const LAS bf16x8*)(Kb_ + kread + (d) * 32); kq[d][1] = *(const LAS bf16x8*)(Kb_ + kread + 32 * KPITCH + (d) * 32); \
            kq[d][2] = *(const LAS bf16x8*)(Kb_ + KBUF + kread + (d) * 32); kq[d][3] = *(const LAS bf16x8*)(Kb_ + KBUF + kread + 32 * KPITCH + (d) * 32); } while (0)
#define MLA_QK4(cur) do { const LAS unsigned char* Kb_ = shm + (cur) * BUFB; bf16x8 kq[6][4];        \
            MLA_LDK(0); MLA_LDK(1); \
            _Pragma("unroll") for (int d0 = 0; d0 < 6; ++d0) { \
                a0 = __builtin_amdgcn_mfma_f32_32x32x16_bf16(kq[d0][0], qr[d0], d0 ? a0 : minit, 0, 0, 0); a1 = __builtin_amdgcn_mfma_f32_32x32x16_bf16(kq[d0][1], qr[d0], d0 ? a1 : minit, 0, 0, 0); \
                b0 = __builtin_amdgcn_mfma_f32_32x32x16_bf16(kq[d0][2], qr[d0], d0 ? b0 : minit, 0, 0, 0); b1 = __builtin_amdgcn_mfma_f32_32x32x16_bf16(kq[d0][3], qr[d0], d0 ? b1 : minit, 0, 0, 0); \
                if (d0 + 2 < 6) MLA_LDK(d0 + 2); } \
            __builtin_amdgcn_sched_group_barrier(0x100, 8, 0); \
            _Pragma("unroll") for (int i_ = 0; i_ < 4; ++i_) { __builtin_amdgcn_sched_group_barrier(0x008, 4, 0); __builtin_amdgcn_sched_group_barrier(0x100, 4, 0); } \
            __builtin_amdgcn_sched_group_barrier(0x008, 8, 0); } while (0)
#define MLA_QKPART(P_) do { const int cur_ = (P_) & 1; if (VAR & 1) { a0 = a1 = b0 = b1 = f32x16{}; } else { MLA_QK4(cur_); } \
            if (2 * (P_) + 1 >= NT - 4) { const int qq0 = wid * 32 + r32 - (2 * (P_) - (NT - 4)) * 64, qq1 = qq0 - 64;        \
                _Pragma("unroll") for (int r = 0; r < 16; ++r) { const int kr_ = crow(r, hi); \
                    if (kr_ > qq0) a0[r] = -INFINITY; if (kr_ + 32 > qq0) a1[r] = -INFINITY; if (kr_ > qq1) b0[r] = -INFINITY; if (kr_ + 32 > qq1) b1[r] = -INFINITY; } } \
            float mx = -INFINITY; MLA_MAX(a0, a1, mx); MLA_MAX(b0, b1, mx); mx = MLA_HALFMAX(mx); \
              \
            const bool up_ = ((P_) == 0) || mx > 8.f; alpha = 1.f; \
            if (__any(up_)) { const float d_ = up_ ? mx : 0.f; \
                _Pragma("unroll") for (int r = 0; r < 16; ++r) { a0[r] -= d_; a1[r] -= d_; b0[r] -= d_; b1[r] -= d_; } \
                alpha = ((P_) == 0) ? 1.f : __builtin_amdgcn_exp2f(-d_); m_run += d_; \
                _Pragma("unroll") for (int r = 0; r < 16; ++r) minit[r] = -m_run; } } while (0)
#define MLA_EXPPV(P_) do { const int cur_ = (P_) & 1; float ls = 0.f; if (!(VAR & 2)) { MLA_EXP0(a0, a1, ls); MLA_EXP0(b0, b1, ls); } l_run = l_run * alpha + ls; \
            MLA_RESCALE(alpha); if (!(VAR & 4)) { MLA_PV(cur_, 0, a0, a1); MLA_PV(cur_, 1, b0, b1); } } while (0)
    const int NS = NT / 2; const bool grpB = wid >= 4;
    float alpha = 1.f; f32x16 a0, a1, b0, b1;
    MLA_LOAD(0); MLA_WRITE(0);
    MLA_BAR();
    if (grpB) { if (1 < NS) MLA_LOAD(1); MLA_BAR(); }
#pragma unroll 1
    for (int p = 0; p < NS; ++p) {
        const bool more = p + 1 < NS;
        if (!grpB && more) MLA_LOAD(p + 1);
#ifdef MLA_PRIO
        __builtin_amdgcn_s_setprio(MLA_PRIO);
#endif
        MLA_QKPART(p);
#ifdef MLA_PRIO
        __builtin_amdgcn_s_setprio(0);
#endif
        if (grpB && more) MLA_WRITE((p + 1) & 1);
        MLA_BAR();
        if (grpB && p + 2 < NS) MLA_LOAD(p + 2);
#ifdef MLA_PRIO_E
        __builtin_amdgcn_s_setprio(MLA_PRIO_E);
#endif
        MLA_EXPPV(p);
#ifdef MLA_PRIO_E
        __builtin_amdgcn_s_setprio(0);
#endif
        if (!grpB && more) MLA_WRITE((p + 1) & 1);
        MLA_BAR();
    }
    if (!grpB) MLA_BAR();
#undef MLA_QKPART
#undef MLA_QK4
#undef MLA_LDK
#undef MLA_EXPPV
#undef MLA_BAR
#undef MLA_LOAD
#undef MLA_WRITE
#undef MLA_QK
#undef MLA_MAX
#undef MLA_HALFMAX
#undef MLA_MX2
#undef MLA_EXP
#undef MLA_EXP0
#undef MLA_RESCALE
#undef MLA_PV
#undef MLA_LDV
    l_run += __shfl_xor(l_run, 32);
    if (hi == 0) wsf[32 + r32] = 1.f / l_run;
    LDS_WAIT();
    { LAS unsigned short* stg = (LAS unsigned short*)(shm + LDS_OST) + wid * 2048;
#pragma unroll
      for (int g = 0; g < 4; ++g) { const f32x4 f = *(const LAS f32x4*)(wsf + 32 + 8 * g + 4 * hi);
#pragma unroll
          for (int i = 0; i < 4; ++i) { const int r = 4 * g + i; LAS unsigned short* sp = stg + crow(r, hi) * 64 + r32;
              sp[0] = (unsigned short)f2bf(o[0][r] * f[i]); sp[32] = (unsigned short)f2bf(o[1][r] * f[i]); } }
      LDS_WAIT();
      bf16* Ow = ya + (rowbase + q0 + wid * 32) * 512 + h * 64;
#pragma unroll
      for (int i = 0; i < 4; ++i) { const int row = i * 8 + (lane >> 3), ch = lane & 7;
          { const v4u w_ = *(const LAS v4u*)(stg + row * 64 + ch * 8); CHKW_S(2, w_.x + w_.y + w_.z + w_.w); *(GAS v4u*)(Ow + (size_t)row * 512 + ch * 8) = w_; } } }
    LDS_WAIT();
    __syncthreads();
}
template <int VAR> __device__ __forceinline__ void phase(int zb, int vcu, const bf16* qmla, const bf16* kv, const bf16* kpe, const f32x2* cs32, bf16* ya, LAS unsigned char* shm) {
    const int bh = vcu >> 2, s = vcu & 3;
#pragma unroll 1
    for (int i = 0; i < 8; ++i) { const int qb = (i & 1) ? (8 * (i >> 1) + 7 - s) : (8 * (i >> 1) + s);
        unit<VAR>(zb, bh >> 3, bh & 7, qb, qmla, kv, kpe, cs32, ya, shm); }
}
}

namespace dsa {
#ifndef DSA_CAP
#define DSA_CAP 512
#endif
constexpr int CAP = DSA_CAP;
constexpr int L_SC = 0, L_HIST = 131072, L_MM = L_HIST + 4096, L_BITMAP = L_MM + 256, L_SEL = L_BITMAP + 4096, L_CAND = L_SEL + 2048, LDS_BYTES_USED = L_CAND + 4 * CAP * 8;
constexpr int L_BIG = 0, VW_BYTES = 10240, L_COMB = 8 * VW_BYTES;
static_assert(L_COMB + 4 * 64 * 20 * 4 <= L_HIST, "attention scratch inside the score region");
typedef short v4i16_t __attribute__((ext_vector_type(4)));
__device__ __forceinline__ s16x4 vtr(const LAS unsigned char* p) { return __builtin_bit_cast(s16x4, __builtin_amdgcn_ds_read_tr16_b64_v4i16((LAS v4i16_t*)p)); }
__device__ __forceinline__ unsigned ordk(float f) { const unsigned u = __builtin_bit_cast(unsigned, f); return u ^ ((u >> 31) ? 0xFFFFFFFFu : 0x80000000u); }
__device__ __forceinline__ float unordk(unsigned k) { return __builtin_bit_cast(float, (k & 0x80000000u) ? (k ^ 0x80000000u) : ~k); }
constexpr unsigned SC_MASKED = 0x7FC00000u;
__device__ __forceinline__ unsigned key_or0(unsigned raw) { return raw == SC_MASKED ? 0u : ordk(__builtin_bit_cast(float, raw)); }
__device__ __forceinline__ unsigned cvtpk(float lo, float hi) { typedef float f2 __attribute__((ext_vector_type(2))); typedef __bf16 b2 __attribute__((ext_vector_type(2)));
    f2 v = {lo, hi}; b2 b = __builtin_convertvector(v, b2); return __builtin_bit_cast(unsigned, b); }
__device__ __forceinline__ unsigned wave_incl_scan(unsigned x) { int v = (int)x;
    v += __builtin_amdgcn_update_dpp(0, v, 0x111, 0xf, 0xf, false); v += __builtin_amdgcn_update_dpp(0, v, 0x112, 0xf, 0xf, false);
    v += __builtin_amdgcn_update_dpp(0, v, 0x114, 0xf, 0xf, false); v += __builtin_amdgcn_update_dpp(0, v, 0x118, 0xf, 0xf, false);
    v += __builtin_amdgcn_update_dpp(0, v, 0x142, 0xa, 0xf, false); v += __builtin_amdgcn_update_dpp(0, v, 0x143, 0xc, 0xf, false);
    return (unsigned)v; }
#define DSA_BAR() do { LDS_WAIT(); __builtin_amdgcn_s_barrier(); asm volatile("" ::: "memory"); } while (0)
#ifndef DSA_REP_D
#define DSA_REP_D 1
#endif

__device__ __forceinline__ void quad(int zb, int b, int p0, int nb, int np0, const bf16* qidx, const bf16* kidx, const float* widx, const bf16* qb, const bf16* kb, const bf16* vb, bf16* yb, LAS unsigned char* shm) {
    int tid = zb; asm volatile("" : "+v"(tid));
    const int lane = tid & 63, c = lane & 31, hi = lane >> 5; const int wid = __builtin_amdgcn_readfirstlane(tid >> 6);
    const size_t tokbase = (size_t)b * SEQ;
    LAS unsigned* sc = (LAS unsigned*)(shm + L_SC); LAS unsigned* hist = (LAS unsigned*)(shm + L_HIST); LAS unsigned* mm = (LAS unsigned*)(shm + L_MM); LAS unsigned* bitmap = (LAS unsigned*)(shm + L_BITMAP);
    LAS unsigned short* sel = (LAS unsigned short*)(shm + L_SEL); LAS v2u* cand = (LAS v2u*)(shm + L_CAND);
    const int ntile = (p0 + 4 + 31) >> 5, nk32 = ntile * 32;
    for (int i = tid; i < 1024; i += 512) { hist[i] = 0u; bitmap[i] = 0u; }
    if (tid < 64) mm[tid] = ((tid >= 4 && tid < 8) || (tid >= 36 && tid < 40)) ? 0xFFFFFFFFu : 0u;
    {
        const int qi_a = 2 * ((c >> 2) & 1) + (c >> 4), head_a = (c & 3) | (((c >> 3) & 1) << 2);
        const bf16* qsrc = qidx + (tokbase + p0 + qi_a) * 512 + head_a * 64 + 8 * hi;
        bf16x8 aq[4];
#pragma unroll
        for (int d0 = 0; d0 < 4; ++d0) aq[d0] = __builtin_bit_cast(bf16x8, *(const GAS v4u*)(qsrc + 16 * d0));
        float wf[16];
#pragma unroll
        for (int j = 0; j < 2; ++j) { const GAS f32x4* wp = (const GAS f32x4*)(widx + (tokbase + p0 + 2 * hi + j) * 8);
            const f32x4 a = wp[0], bb = wp[1];
#pragma unroll
            for (int i = 0; i < 4; ++i) { wf[8 * j + i] = a[i] * (0.35355339059327373f * 0.125f); wf[8 * j + 4 + i] = bb[i] * (0.35355339059327373f * 0.125f); } }
        const GAS unsigned char* kb0 = (const GAS unsigned char*)(kidx + (size_t)b * 4 * 8192 * 16);
        const unsigned hoff = 16u * (unsigned)hi;
        const GAS unsigned char* kb1 = kb0 + 262144, *kb2 = kb0 + 2 * 262144, *kb3 = kb0 + 3 * 262144;
        asm volatile("" : "+s"(kb0), "+s"(kb1), "+s"(kb2), "+s"(kb3));
        float pinf = INFINITY, ninf = -INFINITY; asm volatile("" : "+s"(pinf), "+s"(ninf));
        float mxf0 = -INFINITY, mxf1 = -INFINITY, mnf0 = INFINITY, mnf1 = INFINITY;
        v4u kf[3][4];
#define DSA_KLOAD(S, T) do { int key_ = (T) * 32 + c; key_ = key_ < SEQ ? key_ : SEQ - 1; const unsigned off_ = (unsigned)key_ * 32u + hoff; \
            kf[S][0] = *(const GAS v4u*)(kb0 + off_); kf[S][1] = *(const GAS v4u*)(kb1 + off_); kf[S][2] = *(const GAS v4u*)(kb2 + off_); kf[S][3] = *(const GAS v4u*)(kb3 + off_); } while (0)
#define DSA_RELU(x) __builtin_amdgcn_fmed3f((x), 0.f, pinf)
#define DSA_KCOMP(S, T) do { if ((T) < ntile) { const int key = (T) * 32 + c; f32x16 acc = f32x16{}; \
            _Pragma("unroll") for (int d0 = 0; d0 < 4; ++d0) acc = __builtin_amdgcn_mfma_f32_32x32x16_bf16(aq[d0], __builtin_bit_cast(bf16x8, kf[S][d0]), acc, 0, 0, 0); \
            float s0a = wf[0] * DSA_RELU(acc[0]), s0b = wf[4] * DSA_RELU(acc[4]), s1a = wf[8] * DSA_RELU(acc[8]), s1b = wf[12] * DSA_RELU(acc[12]); \
            _Pragma("unroll") for (int r = 1; r < 4; ++r) { s0a += wf[r] * DSA_RELU(acc[r]); s0b += wf[4 + r] * DSA_RELU(acc[4 + r]); s1a += wf[8 + r] * DSA_RELU(acc[8 + r]); s1b += wf[12 + r] * DSA_RELU(acc[12 + r]); } \
            const float s0 = (s0a + s0b) + 0.f, s1 = (s1a + s1b) + 0.f;        \
            const bool v0_ = key <= p0 + 2 * hi, v1_ = key <= p0 + 2 * hi + 1; \
            sc[(2 * hi) * 8192 + key] = v0_ ? __builtin_bit_cast(unsigned, s0) : SC_MASKED; sc[(2 * hi + 1) * 8192 + key] = v1_ ? __builtin_bit_cast(unsigned, s1) : SC_MASKED; \
            mxf0 = __builtin_amdgcn_fmed3f(mxf0, v0_ ? s0 : -INFINITY, pinf); mnf0 = __builtin_amdgcn_fmed3f(mnf0, v0_ ? s0 : INFINITY, ninf); \
            mxf1 = __builtin_amdgcn_fmed3f(mxf1, v1_ ? s1 : -INFINITY, pinf); mnf1 = __builtin_amdgcn_fmed3f(mnf1, v1_ ? s1 : INFINITY, ninf); } } while (0)
#ifndef DSA_REP_A
#define DSA_REP_A 1
#endif
        _Pragma("unroll") for (int repA = 0; repA < DSA_REP_A; ++repA) {
        DSA_KLOAD(0, wid); DSA_KLOAD(1, wid + 8); DSA_KLOAD(2, wid + 16);
#pragma unroll 1
        for (int t = wid; t < ntile; t += 24) {
            DSA_KCOMP(0, t);      DSA_KLOAD(0, t + 24);
            DSA_KCOMP(1, t + 8);  DSA_KLOAD(1, t + 32);
            DSA_KCOMP(2, t + 16); DSA_KLOAD(2, t + 40);
        }
        }
#undef DSA_KLOAD
#undef DSA_KCOMP
#undef DSA_RELU
        const unsigned mx0 = mxf0 == -INFINITY ? 0u : ordk(mxf0), mx1 = mxf1 == -INFINITY ? 0u : ordk(mxf1), mn0 = mnf0 == INFINITY ? 0xFFFFFFFFu : ordk(mnf0), mn1 = mnf1 == INFINITY ? 0xFFFFFFFFu : ordk(mnf1);
        DSA_BAR();
        if (mx0) { __hip_atomic_fetch_max(&mm[2 * hi], mx0, __ATOMIC_RELAXED, __HIP_MEMORY_SCOPE_WORKGROUP); __hip_atomic_fetch_min(&mm[4 + 2 * hi], mn0, __ATOMIC_RELAXED, __HIP_MEMORY_SCOPE_WORKGROUP); }
        if (mx1) { __hip_atomic_fetch_max(&mm[2 * hi + 1], mx1, __ATOMIC_RELAXED, __HIP_MEMORY_SCOPE_WORKGROUP); __hip_atomic_fetch_min(&mm[5 + 2 * hi], mn1, __ATOMIC_RELAXED, __HIP_MEMORY_SCOPE_WORKGROUP); }
        __hip_atomic_fetch_min(&mm[36 + 2 * hi], mx0, __ATOMIC_RELAXED, __HIP_MEMORY_SCOPE_WORKGROUP); __hip_atomic_fetch_min(&mm[37 + 2 * hi], mx1, __ATOMIC_RELAXED, __HIP_MEMORY_SCOPE_WORKGROUP);
    }
    DSA_BAR();
    v4u pf_ = {0u, 0u, 0u, 0u}, pf2_ = {0u, 0u, 0u, 0u};
    if (nb >= 0) { const size_t ntok = (size_t)nb * SEQ + np0;
        pf_ = *(const GAS v4u*)((tid < 256 ? qidx : qb) + ntok * 512 + (size_t)(tid & 255) * 8);
        if (tid < 8) pf2_ = *(const GAS v4u*)(widx + ntok * 8 + tid * 4); }
    float basef[4], scl[4];
#pragma unroll
    for (int q = 0; q < 4; ++q) { const unsigned mxk = mm[q], lm = mm[36 + q]; unsigned mnk = mm[4 + q]; const unsigned l0 = lm > 1u ? lm : 1u; mnk = mnk > l0 ? mnk : l0;
        const float a = unordk(mxk), bq_ = unordk(mnk);
        basef[q] = (mxk && mnk != 0xFFFFFFFFu) ? bq_ : 0.f; scl[q] = (mxk && a > bq_) ? 255.99f / (a - bq_) : 1.f; }
#ifndef DSA_REP_SEL
#define DSA_REP_SEL 1
#endif
    for (int repS = 0; repS < DSA_REP_SEL; ++repS) {
    if (repS > 0) { DSA_BAR(); for (int i = tid; i < 1024; i += 512) { hist[i] = 0u; bitmap[i] = 0u; } if (tid < 4) mm[8 + tid] = 0u; DSA_BAR(); }
#ifndef DSA_REP_S2
#define DSA_REP_S2 1
#endif
#ifndef DSA_REP_S4
#define DSA_REP_S4 1
#endif
    v4u vva_[4][4];
    _Pragma("unroll") for (int rp2 = DSA_REP_S2 - 1; rp2 >= 0; --rp2) { LAS unsigned* hist_ = rp2 ? (LAS unsigned*)cand : hist;
    LAS unsigned char* hq_[4];
#pragma unroll
    for (int q = 0; q < 4; ++q) { hq_[q] = (LAS unsigned char*)(hist_ + q * 256); asm volatile("" : "+s"(hq_[q])); }
#pragma unroll
    for (int q = 0; q < 4; ++q)
#pragma unroll
        for (int it_ = 0; it_ < 4; ++it_) vva_[q][it_] = *(const LAS v4u*)(sc + q * 8192 + 4 * tid + 2048 * it_);
#pragma unroll
    for (int q = 0; q < 4; ++q) {
#pragma unroll
        for (int it_ = 0; it_ < 4; ++it_) { const int idx = 4 * tid + 2048 * it_; if (idx >= nk32) break; const v4u v = vva_[q][it_];
#pragma unroll
            for (int e = 0; e < 4; ++e) { const unsigned raw = v[e]; const float d = __builtin_bit_cast(float, raw) - basef[q], xb_ = d * scl[q];
                vva_[q][it_][e] = __builtin_bit_cast(unsigned, xb_);
                if (d >= 0.f) { const unsigned bn = (unsigned)(int)xb_;
                    __hip_atomic_fetch_add((LAS unsigned*)(hq_[q] + 4u * bn), 1u, __ATOMIC_RELAXED, __HIP_MEMORY_SCOPE_WORKGROUP); } } } }
    }
    DSA_BAR();
    int bsq[4]; unsigned cgq[4], fbq[4];
#pragma unroll
    for (int q = 0; q < 4; ++q) {
        const v4u h4 = *(const LAS v4u*)(hist + q * 256 + 4 * lane);
        const unsigned t4 = h4.x + h4.y + h4.z + h4.w; const unsigned incl = wave_incl_scan(t4); const unsigned tot = (unsigned)__builtin_amdgcn_readlane((int)incl, 63);
        const unsigned S = tot - incl + t4;
        const unsigned excl = S - t4, s3 = excl + h4.w, s2 = s3 + h4.z, s1 = s2 + h4.y;
        const unsigned long long mask = __ballot(S >= 256u);
        if (mask == 0ull) { bsq[q] = -1; cgq[q] = tot; fbq[q] = 0u; }
        else { const int L = 63 - __builtin_clzll(mask);
            const int bb = s3 >= 256u ? 3 : s2 >= 256u ? 2 : s1 >= 256u ? 1 : 0; const unsigned nc = bb == 3 ? s3 : bb == 2 ? s2 : bb == 1 ? s1 : S;
            const unsigned hb = bb == 3 ? h4.w : bb == 2 ? h4.z : bb == 1 ? h4.y : h4.x;
            bsq[q] = __builtin_amdgcn_readlane(4 * lane + bb, L); cgq[q] = (unsigned)__builtin_amdgcn_readlane((int)(nc - hb), L); fbq[q] = (unsigned)__builtin_amdgcn_readlane(hb > (unsigned)CAP ? 1 : 0, L); }
    }
    const unsigned fb_any = fbq[0] | fbq[1] | fbq[2] | fbq[3];
    _Pragma("unroll") for (int rp4 = DSA_REP_S4 - 1; rp4 >= 0; --rp4) { LAS unsigned* cnt_ = mm + (rp4 ? 44 : 8);
#pragma unroll
    for (int q = 0; q < 4; ++q) { const int bs = bsq[q];
        if (!fbq[q]) { const float tlo = bs < 0 ? 0.f : (float)bs, thi = bs < 0 ? 0.f : bs >= 255 ? INFINITY : (float)(bs + 1);
          {
#pragma unroll
            for (int it_ = 0; it_ < 4; ++it_) { const int idx = 4 * tid + 2048 * it_; if (idx >= nk32) break; const v4u v = vva_[q][it_];
#pragma unroll
                for (int e = 0; e < 4; ++e) { const unsigned raw = v[e]; const float xb = __builtin_bit_cast(float, raw);
                    if (xb >= tlo) { const unsigned ix = (unsigned)(idx + e);
                        if (xb >= thi) __hip_atomic_fetch_or(&bitmap[q * 256 + (ix >> 5)], 1u << (ix & 31), __ATOMIC_RELAXED, __HIP_MEMORY_SCOPE_WORKGROUP);
                        else { const unsigned pos = __hip_atomic_fetch_add(&cnt_[q], 1u, __ATOMIC_RELAXED, __HIP_MEMORY_SCOPE_WORKGROUP);
                            if (pos < (unsigned)CAP) cand[q * CAP + pos] = (v2u){ordk(__builtin_bit_cast(float, sc[q * 8192 + ix])), ix}; } } } } } } }
    if (rp4) DSA_BAR(); }
    DSA_BAR();
    const int bs_w = wid == 0 ? bsq[0] : wid == 1 ? bsq[1] : wid == 2 ? bsq[2] : bsq[3]; const unsigned cg_w = wid == 0 ? cgq[0] : wid == 1 ? cgq[1] : wid == 2 ? cgq[2] : cgq[3], fb_w = wid == 0 ? fbq[0] : wid == 1 ? fbq[1] : wid == 2 ? fbq[2] : fbq[3];
    if (wid < 4 && !fb_w && bs_w >= 0) {
        const int n = (int)mm[8 + wid], r = 256 - (int)cg_w;
        const LAS v2u* cl = cand + wid * CAP; LAS unsigned* bm = bitmap + wid * 256;
#ifndef DSA_RANKMAX
#define DSA_RANKMAX 64
#endif
        if (n <= DSA_RANKMAX) {
            const v2u me = cl[lane < n ? lane : 0]; int rank = 0;
            for (int jx = 0; jx < n; ++jx) { const v2u o = cl[jx]; rank += (o.x > me.x || (o.x == me.x && o.y < me.y)) ? 1 : 0; }
            if (lane < n && rank < r) __hip_atomic_fetch_or(&bm[me.y >> 5], 1u << (me.y & 31), __ATOMIC_RELAXED, __HIP_MEMORY_SCOPE_WORKGROUP);
        } else {
            unsigned Tk = 0u;
            for (int bit = 31; bit >= 0; --bit) { const unsigned ct = Tk | (1u << bit); int cnt = 0;
                for (int e0 = 0; e0 < n; e0 += 64) { const int e = e0 + lane; const bool pr = (e < n) && (cl[e < n ? e : 0].x >= ct); cnt += __popcll(__ballot(pr)); }
                if (cnt >= r) Tk = ct; }
            int ngt = 0, neq = 0;
            for (int e0 = 0; e0 < n; e0 += 64) { const int e = e0 + lane; const unsigned x = cl[e < n ? e : 0].x; ngt += __popcll(__ballot(e < n && x > Tk)); neq += __popcll(__ballot(e < n && x == Tk)); }
            const int r2 = r - ngt; unsigned X = 0u;
            if (neq > r2) { for (int bit = 12; bit >= 0; --bit) { const unsigned cx = X | (1u << bit); int cnt = 0;
                    for (int e0 = 0; e0 < n; e0 += 64) { const int e = e0 + lane; const v2u ce = cl[e < n ? e : 0]; cnt += __popcll(__ballot(e < n && ce.x == Tk && (8191u - ce.y) >= cx)); }
                    if (cnt >= r2) X = cx; } }
            for (int e = lane; e < n; e += 64) { const v2u ce = cl[e]; if (ce.x > Tk || (ce.x == Tk && (8191u - ce.y) >= X)) __hip_atomic_fetch_or(&bm[ce.y >> 5], 1u << (ce.y & 31), __ATOMIC_RELAXED, __HIP_MEMORY_SCOPE_WORKGROUP); }
        }
    }
    if (fb_any) {
        int step = 0;
        DSA_BAR();
        for (int q = 0; q < 4; ++q) { if (!(q == 0 ? fbq[0] : q == 1 ? fbq[1] : q == 2 ? fbq[2] : fbq[3])) continue;
            const LAS unsigned* sq = sc + q * 8192;
#define DSA_COUNT(PRED, OUT) do { int loc_ = 0; for (int idx = tid; idx < nk32; idx += 512) { const unsigned k = key_or0(sq[idx]); const unsigned inv = 8191u - (unsigned)idx; (void)inv; loc_ += (k && (PRED)) ? 1 : 0; } \
            if (tid == 0) mm[32 + (step + 1) % 3] = 0u; if (loc_) __hip_atomic_fetch_add(&mm[32 + step % 3], (unsigned)loc_, __ATOMIC_RELAXED, __HIP_MEMORY_SCOPE_WORKGROUP); \
            DSA_BAR(); OUT = (int)mm[32 + step % 3]; ++step; } while (0)
            unsigned Tk = 0u; int cnt;
            for (int bit = 31; bit >= 0; --bit) { const unsigned ct = Tk | (1u << bit); DSA_COUNT(k >= ct, cnt); if (cnt >= 256) Tk = ct; }
            int ngt, neq; DSA_COUNT(k > Tk, ngt); DSA_COUNT(k == Tk, neq);
            const int r = 256 - ngt; unsigned X = 0u;
            if (neq > r) { for (int bit = 12; bit >= 0; --bit) { const unsigned cx = X | (1u << bit); DSA_COUNT(k == Tk && inv >= cx, cnt); if (cnt >= r) X = cx; } }
            for (int idx = tid; idx < nk32; idx += 512) { const unsigned k = key_or0(sq[idx]);
                if (k && (k > Tk || (k == Tk && (8191u - (unsigned)idx) >= X))) __hip_atomic_fetch_or(&bitmap[q * 256 + (idx >> 5)], 1u << (idx & 31), __ATOMIC_RELAXED, __HIP_MEMORY_SCOPE_WORKGROUP); }
#undef DSA_COUNT
        }
        DSA_BAR();
    }
    LDS_WAIT(); asm volatile("" ::: "memory");
    if (wid < 4) {
        const v4u w4 = *(const LAS v4u*)(bitmap + wid * 256 + 4 * lane);
        const int cl_ = __popc(w4.x) + __popc(w4.y) + __popc(w4.z) + __popc(w4.w); const int incl = (int)wave_incl_scan((unsigned)cl_);
        int pos = incl - cl_; LAS unsigned short* sl = sel + wid * 256;
#pragma unroll
        for (int wi = 0; wi < 4; ++wi) { unsigned word = w4[wi]; while (word) { const int bit = __builtin_ctz(word); if (pos < 256) sl[pos] = (unsigned short)((4 * lane + wi) * 32 + bit); ++pos; word &= word - 1u; } }
        const int total = __builtin_amdgcn_readlane(incl, 63); const int ns = total < 256 ? total : 256;
        for (int e = ns + lane; e < 256; e += 64) sl[e] = 0;
        if (lane == 0) mm[24 + wid] = (unsigned)ns;
    }
    }
    DSA_BAR();
    _Pragma("unroll") for (int repD = 0; repD < DSA_REP_D; ++repD) {
        const int q = wid & 3, part = wid >> 2, hc = lane & 15, g = lane >> 4, head = hc & 7; const int nsel = (int)mm[24 + q];
        const size_t tok = tokbase + p0 + q; const LAS unsigned short* sl = sel + q * 256 + 128 * part;
        LAS unsigned char* Vw = shm + L_BIG + wid * VW_BYTES;
        bf16x8 bq[2];
#pragma unroll
        for (int s = 0; s < 2; ++s) bq[s] = __builtin_bit_cast(bf16x8, *(const GAS v4u*)(qb + tok * 512 + head * 64 + 32 * s + 8 * g));
        v4u kf[8][2], vg[2][8];
#pragma unroll
#ifndef DSA_DVAR
#define DSA_DVAR 0
#endif
#define DSA_DV(bit) ((DSA_DVAR & (bit)) && repD + 1 < DSA_REP_D)
        for (int kt = 0; kt < 8; ++kt) { const int key = sl[16 * kt + hc]; const bf16* ksrc = kb + (tokbase + key) * 64 + 8 * g;
            if (DSA_DV(1)) { kf[kt][0] = (v4u){0u, 0u, 0u, 0u}; kf[kt][1] = (v4u){0u, 0u, 0u, 0u}; } else {
            kf[kt][0] = *(const GAS v4u*)(ksrc); kf[kt][1] = *(const GAS v4u*)(ksrc + 32); } }
#define DSA_VLOAD(hf) _Pragma("unroll") for (int it = 0; it < 8; ++it) { const int id = it * 64 + lane, kl = id >> 3, ch = id & 7; const int key = sl[64 * (hf) + kl]; \
                if (DSA_DV(2)) vg[hf][it] = (v4u){0u, 0u, 0u, 0u}; else vg[hf][it] = *(const GAS v4u*)(vb + (tokbase + key) * 64 + ch * 8); }
        DSA_VLOAD(0)
        float st[8][4];
#pragma unroll
        for (int kt = 0; kt < 8; ++kt) {
            f32x4 a4 = {0.f, 0.f, 0.f, 0.f};
            a4 = __builtin_amdgcn_mfma_f32_16x16x32_bf16(__builtin_bit_cast(bf16x8, kf[kt][0]), bq[0], a4, 0, 0, 0);
            a4 = __builtin_amdgcn_mfma_f32_16x16x32_bf16(__builtin_bit_cast(bf16x8, kf[kt][1]), bq[1], a4, 0, 0, 0);
#pragma unroll
            for (int r = 0; r < 4; ++r) st[kt][r] = (128 * part + 16 * kt + 4 * g + r < nsel) ? a4[r] : -INFINITY; }
        DSA_VLOAD(1)
#undef DSA_VLOAD
        constexpr float SC = 0.125f * 1.4426950408889634f;
        float m = -1e30f;
#pragma unroll
        for (int kt = 0; kt < 8; ++kt)
#pragma unroll
            for (int r = 0; r < 4; ++r) m = fmaxf(m, st[kt][r]);
        m = fmaxf(m, __shfl_xor(m, 16)); m = fmaxf(m, __shfl_xor(m, 32));
        float l = 0.f;
#pragma unroll
        for (int kt = 0; kt < 8; ++kt)
#pragma unroll
            for (int r = 0; r < 4; ++r) { st[kt][r] = __builtin_amdgcn_exp2f((st[kt][r] - m) * SC); l += st[kt][r]; }
        l += __shfl_xor(l, 16); l += __shfl_xor(l, 32);
        f32x4 ot[4]; ot[0] = ot[1] = ot[2] = ot[3] = (f32x4){0.f, 0.f, 0.f, 0.f};
        const int vrd = (4 * g + ((lane & 15) >> 2)) * 160 + (lane & 3) * 8;
#pragma unroll
        for (int hf = 0; hf < 2; ++hf) { if (DSA_DV(4)) continue;
            asm volatile("" ::: "memory");
#pragma unroll
            for (int it = 0; it < 8; ++it) { const int id = it * 64 + lane, kl = id >> 3, ch = id & 7;
                *(LAS v4u*)(Vw + kl * 160 + ch * 16) = vg[hf][it]; }
            LDS_WAIT();
#pragma unroll
            for (int s2 = 0; s2 < 2; ++s2) { const int ta = 4 * hf + 2 * s2;
                v4u pw; pw.x = cvtpk(st[ta][0], st[ta][1]); pw.y = cvtpk(st[ta][2], st[ta][3]); pw.z = cvtpk(st[ta + 1][0], st[ta + 1][1]); pw.w = cvtpk(st[ta + 1][2], st[ta + 1][3]);
#pragma unroll
                for (int mt = 0; mt < 4; ++mt) { const LAS unsigned char* vp = Vw + vrd + (32 * s2) * 160 + mt * 32;
                    const s16x4 lo = vtr(vp), hh = vtr(vp + 16 * 160);
                    const bf16x8 vf = {lo[0], lo[1], lo[2], lo[3], hh[0], hh[1], hh[2], hh[3]};
                    ot[mt] = __builtin_amdgcn_mfma_f32_16x16x32_bf16(vf, __builtin_bit_cast(bf16x8, pw), ot[mt], 0, 0, 0); } }
            LDS_WAIT();
        }
        LAS float* cb = (LAS float*)(shm + L_COMB) + (q * 64 + lane) * 20;
        if (part == 1) { cb[0] = m; cb[1] = l;
#pragma unroll
            for (int mt = 0; mt < 4; ++mt) *(LAS f32x4*)(cb + 4 + 4 * mt) = ot[mt]; }
        DSA_BAR();
        if (part == 0) { const float m1 = cb[0], l1 = cb[1]; const float M = fmaxf(m, m1), f0 = __builtin_amdgcn_exp2f((m - M) * SC), f1 = __builtin_amdgcn_exp2f((m1 - M) * SC);
            const float inv = 1.f / (l * f0 + l1 * f1);
            if (hc < 8) {
#pragma unroll
                for (int mt = 0; mt < 4; ++mt) { const f32x4 o1 = *(const LAS f32x4*)(cb + 4 + 4 * mt); const f32x4 o = (ot[mt] * f0 + o1 * f1) * inv;
                    v2u w; w.x = cvtpk(o[0], o[1]); w.y = cvtpk(o[2], o[3]); CHKW_S(3, w.x + w.y); *(GAS v2u*)(yb + tok * 512 + head * 64 + 16 * mt + 4 * g) = w; } } }
    }
    DSA_BAR();
    asm volatile("" :: "v"(pf_), "v"(pf2_));
}
__device__ __forceinline__ void phase(int zb, int vcu, const bf16* qidx, const bf16* kidx, const float* widx, const bf16* qb, const bf16* kb, const bf16* vb, bf16* yb, LAS unsigned char* shm) {
#pragma unroll 1
    for (int j = 0; j < 64; ++j) { const int Qi = ((j & 1) ? 255 - vcu : vcu) + 256 * j, Qn = (((j + 1) & 1) ? 255 - vcu : vcu) + 256 * (j + 1);
        quad(zb, Qi >> 11, 4 * (Qi & 2047), j + 1 < 64 ? (Qn >> 11) : -1, 4 * (Qn & 2047), qidx, kidx, widx, qb, kb, vb, yb, shm); }
}
}

__device__ __forceinline__ void p8_router(Frame& F) {
    { const int gw = F.vcu * NWAVES + F.wave;
      if (gw == 0) { GAS unsigned long long* o8 = (GAS unsigned long long*)(WSP(bf16, WS_XN2) + (size_t)T * D) + F.lane;
#pragma unroll
          for (int j = 0; j < 4; ++j) o8[64 * j] = 0ull; } }
    LAS float* Wl = (LAS float*)F.lds;
    for (int i = F.tid; i < 1024 * 32; i += NWAVES * 64) Wl[i] = F.r_w[i] * F.ffn_g[i >> 5];
    __syncthreads();
    const int lane = F.lane, i32 = lane & 31, kk = lane >> 5;
    int* tok_e = WSP(int, WS_TOKE); float* tok_g = WSP(float, WS_TOKG); int* tok_r = WSP(int, WS_TOKR); unsigned* cnt = WSP(unsigned, WS_CNT);
    for (int task = F.vcu * NWAVES + F.wave; task < NTASK; task += F.G * NWAVES) {
        const int t0 = task * 32;
        f32x16 acc = f32x16{}; float ss = 0.f;
        const float* xr = F.out + (size_t)(t0 + i32) * 1024 + 4 * kk;
#pragma unroll 4
        for (int m = 0; m < 128; ++m) { const f32x4 xv = *(const GAS f32x4*)(xr + 8 * m);
            ss += (xv[0] * xv[0] + xv[1] * xv[1]) + (xv[2] * xv[2] + xv[3] * xv[3]);
            const LAS float* wp = Wl + (8 * m + 4 * kk) * 32 + i32;
#pragma unroll
            for (int j = 0; j < 4; ++j) acc = __builtin_amdgcn_mfma_f32_32x32x2f32(xv[j], wp[32 * j], acc, 0, 0, 0); }
        ss += __shfl_xor(ss, 32);
        const float rstd = 1.f / sqrtf(ss * (1.f / 1024.f) + EPS);
        if (kk == 0) WSP(float, WS_RSTOK)[t0 + i32] = rstd;
        const float bias = F.r_b[i32];
        unsigned pickmask = 0u, kcode = 0u; int cnt_e = 0;
#pragma unroll
        for (int r = 0; r < 16; ++r) {
            const int tl_ = (r & 3) + 8 * (r >> 2) + 4 * kk;
            float v = acc[r] * __shfl(rstd, tl_) + bias;
            float tl[4]; int te[4];
#pragma unroll
            for (int k = 0; k < 4; ++k) { float bv = v; int be = i32;
#pragma unroll
                for (int o = 1; o < 32; o <<= 1) { const float ov = __shfl_xor(bv, o); const int oe = __shfl_xor(be, o); if (ov > bv || (ov == bv && oe < be)) { bv = ov; be = oe; } }
                tl[k] = bv; te[k] = be;
                if (be == i32) { v = -INFINITY; pickmask |= 1u << r; kcode |= (unsigned)k << (2 * r); ++cnt_e; } }
            const float e1 = __expf(tl[1] - tl[0]), e2 = __expf(tl[2] - tl[0]), e3 = __expf(tl[3] - tl[0]); const float inv = 1.f / (1.f + e1 + e2 + e3);
            if (i32 < 4) { const int k = i32; const int ee = k == 0 ? te[0] : k == 1 ? te[1] : k == 2 ? te[2] : te[3]; const float gg = (k == 0 ? 1.f : k == 1 ? e1 : k == 2 ? e2 : e3) * inv;
                CHKW_S(6, (unsigned)ee + __builtin_bit_cast(unsigned, gg)); tok_e[(size_t)(t0 + tl_) * 4 + k] = ee; tok_g[(size_t)(t0 + tl_) * 4 + k] = gg; }
        }
        const int c_other = __shfl_xor(cnt_e, 32);
        const int base = kk ? c_other : 0;
#pragma unroll
        for (int r = 0; r < 16; ++r) if ((pickmask >> r) & 1u) { const int tl_ = (r & 3) + 8 * (r >> 2) + 4 * kk; const int k = (kcode >> (2 * r)) & 3;
            tok_r[(size_t)(t0 + tl_) * 4 + k] = base + __popc(pickmask & ((1u << r) - 1u)); }
        if (kk == 0) cnt[(size_t)task * 32 + i32] = (unsigned)(cnt_e + c_other);
    }
}

__device__ __forceinline__ void p9_slots(Frame& F) {
    const unsigned* cnt = WSP(unsigned, WS_CNT); const int* tok_e = WSP(int, WS_TOKE); const int* tok_r = WSP(int, WS_TOKR); int* rowtok = WSP(int, WS_ROWTOK); int* blke = WSP(int, WS_BLKE); int* rowsrc = WSP(int, WS_ROWSRC); float* rowrs = WSP(float, WS_ROWRS); const float* rs_tok = WSP(float, WS_RSTOK);
    LAS int* sm_tot = (LAS int*)F.lds; LAS int* sm_pre = sm_tot + 512; LAS int* s_total = sm_pre + 512; LAS int* s_pad = s_total + 32; LAS int* s_base = s_pad + 40;
    const int e = F.tid & 31, grp = F.tid >> 5, first = F.vcu * NWAVES;
    { int tot = 0, pre = 0;
      for (int tk = grp * 128; tk < grp * 128 + 128; ++tk) { const int c = (int)cnt[(size_t)tk * 32 + e]; tot += c; pre += (tk < first) ? c : 0; }
      sm_tot[grp * 32 + e] = tot; sm_pre[grp * 32 + e] = pre; }
    __syncthreads();
    if (F.tid < 32) { int tot = 0, pre = 0;
        for (int g = 0; g < 16; ++g) { tot += sm_tot[g * 32 + e]; pre += sm_pre[g * 32 + e]; }
        s_total[e] = tot;
        for (int w = 0; w < 8; ++w) { s_base[w * 32 + e] = pre; pre += (int)cnt[(size_t)(first + w) * 32 + e]; } }
    __syncthreads();
    if (F.tid == 0) { int ps = 0; for (int q = 0; q < 32; ++q) { s_pad[q] = ps; ps += ((s_total[q] + 255) >> 8) << 8; } s_pad[32] = ps; }
    __syncthreads();
    { const int t0 = (first + F.wave) * 32;
#pragma unroll
      for (int u = 0; u < 2; ++u) { const int p = 2 * F.lane + u; const size_t q = (size_t)(t0 + (p >> 2)) * 4 + (p & 3); const int ee = tok_e[q];
          { const int sl_ = s_pad[ee] + s_base[F.wave * 32 + ee] + tok_r[q]; CHKW_S(6, (unsigned)sl_ * 2654435761u + (unsigned)q); rowtok[sl_] = (int)q; rowsrc[sl_] = (int)(q >> 2); rowrs[sl_] = rs_tok[q >> 2]; } } }
    if (F.vcu < 32) { const int q = F.vcu; for (int s = s_pad[q] + s_total[q] + F.tid; s < s_pad[q + 1]; s += NWAVES * 64) { rowtok[s] = -1; rowsrc[s] = T; rowrs[s] = 0.f; } }
    if (F.vcu == 32) { const int nblk = s_pad[32] >> 8;
        for (int bq = F.tid; bq < nblk; bq += NWAVES * 64) { int ee = 0; for (int q = 1; q < 32; ++q) ee += (bq * 256 >= s_pad[q]) ? 1 : 0; blke[bq] = ee; }
        if (F.tid == 0) blke[MAXBLK] = nblk; }
}

__device__ __forceinline__ void p10_moe(Frame& F, int probe_skip) {
    const int* rowtok = WSP(int, WS_ROWTOK); const int* rowsrc = WSP(int, WS_ROWSRC); const int* blke = WSP(int, WS_BLKE);
    bf16* act = WSP(bf16, WS_SCR) + (size_t)F.vcu * (256 * 1024);
    const int nblk = blke[MAXBLK], nfull = (nblk / F.G) * F.G;
#pragma unroll 1
    for (int bq = F.vcu; bq < nfull; bq += F.G) {
        const int e = blke[bq];
        int z1, z2; asm volatile("v_mov_b32 %0, 0" : "=v"(z1)); asm volatile("v_mov_b32 %0, 0" : "=v"(z2));
#ifndef MOE_REP_GU
#define MOE_REP_GU 1
#endif
#ifndef MOE_REP_DN
#define MOE_REP_DN 1
#endif
        int nrg_ = MOE_REP_GU, nrd_ = MOE_REP_DN; if (MOE_REP_GU > 1 || MOE_REP_DN > 1) asm volatile("" : "+s"(nrg_), "+s"(nrd_));
        if (!(probe_skip & 1))
        _Pragma("unroll 1") for (int rg_ = 0; rg_ < nrg_; ++rg_)
        { pg8::Gemm g{WSP(bf16, WS_XN2), WSP(bf16, WS_WGU), 256, 2048 * 32, 1024}; pg8::ListOrderT<true> S{8, e * 8, F.tid + z1, rowsrc + bq * 256}; pg8::EpiGU E{act, F.b_gu + (size_t)e * 2048, WSP(float, WS_ROWRS) + bq * 256};
          pg8::gemm_phase<pg8::EpiGU, pg8::ListOrderT<true>, true, true>(F.lds, g, S, E); if (rg_ + 1 < nrg_) { VM_WAIT(); __syncthreads(); } }
        VM_WAIT(); __syncthreads();
        if (F.tid == 0) __builtin_amdgcn_fence(__ATOMIC_ACQUIRE, "agent");
        VM_WAIT(); __syncthreads();
        if (!(probe_skip & 2))
        _Pragma("unroll 1") for (int rd_ = 0; rd_ < nrd_; ++rd_)
        { pg8::Gemm g{act, WSP(bf16, WS_WD), 256, 1024 * 32, 1024}; pg8::ListOrderT<false> S{4, e * 4, F.tid + z2, nullptr}; pg8::EpiDown E{WSP(bf16, WS_YBUF), F.b_d + (size_t)e * 1024, rowtok + bq * 256};
          pg8::gemm_phase<pg8::EpiDown, pg8::ListOrderT<false>, true, true>(F.lds, g, S, E); if (rd_ + 1 < nrd_) { VM_WAIT(); __syncthreads(); } }
        __syncthreads();
    }
}
#ifndef MOE_PAIR
#define MOE_PAIR 0
#endif
__device__ __forceinline__ void p10_moe_pair(Frame& F) {
    const int* rowtok = WSP(int, WS_ROWTOK); const int* rowsrc = WSP(int, WS_ROWSRC); const int* blke = WSP(int, WS_BLKE);
    const int nblk = blke[MAXBLK], nfull = (nblk / F.G) * F.G, R = nfull / F.G;
    const int j = F.vcu & 31, xg = F.vcu >> 5, half = (j >> 4) & 1, k = j & 15, pr = xg * 16 + k;
    bf16* actb[2] = {WSP(bf16, WS_SCR) + (size_t)(xg * 32 + k) * (256 * 1024), WSP(bf16, WS_SCR) + (size_t)(xg * 32 + 16 + k) * (256 * 1024)};
    gu32* flags = F.ctl + 12288 + pr * 16;
#pragma unroll 1
    for (int st = 0; st < 2 * R; ++st) {
        const int bq = (st >> 1) * F.G + xg * 32 + 16 * (st & 1) + k, e = blke[bq];
        bf16* act = actb[st & 1];
        int z1, z2; asm volatile("v_mov_b32 %0, 0" : "=v"(z1)); asm volatile("v_mov_b32 %0, 0" : "=v"(z2));
        { pg8::Gemm g{WSP(bf16, WS_XN2), WSP(bf16, WS_WGU), 256, 2048 * 32, 1024}; pg8::ListOrderT<true> S{4, e * 8 + 4 * half, F.tid + z1, rowsrc + bq * 256}; pg8::EpiGU E{act, F.b_gu + (size_t)e * 2048, WSP(float, WS_ROWRS) + bq * 256};
          pg8::gemm_phase<pg8::EpiGU, pg8::ListOrderT<true>, true, true>(F.lds, g, S, E); }
        VM_WAIT(); __syncthreads();
        if (F.tid == 0) { __builtin_amdgcn_fence(__ATOMIC_RELEASE, "agent"); __hip_atomic_fetch_add(flags + st, 1u, __ATOMIC_RELAXED, __HIP_MEMORY_SCOPE_AGENT);
            while (__hip_atomic_load(flags + st, __ATOMIC_RELAXED, __HIP_MEMORY_SCOPE_AGENT) < 2u) __builtin_amdgcn_s_sleep(2);
            __builtin_amdgcn_fence(__ATOMIC_ACQUIRE, "agent"); }
        VM_WAIT(); __syncthreads();
        { pg8::Gemm g{act, WSP(bf16, WS_WD), 256, 1024 * 32, 1024}; pg8::ListOrderT<false> S{2, e * 4 + 2 * half, F.tid + z2, nullptr}; pg8::EpiDown E{WSP(bf16, WS_YBUF), F.b_d + (size_t)e * 1024, rowtok + bq * 256};
          pg8::gemm_phase<pg8::EpiDown, pg8::ListOrderT<false>, true, true>(F.lds, g, S, E); }
        __syncthreads();
    }
}
__device__ __forceinline__ void p10b_moe_tail_gu(Frame& F) {
    const int* rowsrc = WSP(int, WS_ROWSRC); const int* blke = WSP(int, WS_BLKE);
    const int nblk = blke[MAXBLK], nfull = (nblk / F.G) * F.G, nu = (nblk - nfull) * 8;
#pragma unroll 1
    for (int u = F.vcu; u < nu; u += F.G) {
        const int bl = u >> 3, bq = nfull + bl, e = blke[bq];
        int z1; asm volatile("v_mov_b32 %0, 0" : "=v"(z1));
        pg8::Gemm g{WSP(bf16, WS_XN2), WSP(bf16, WS_WGU), 256, 2048 * 32, 1024}; pg8::ListOrderT<true> S{1, e * 8 + (u & 7), F.tid + z1, rowsrc + bq * 256}; pg8::EpiGU E{WSP(bf16, WS_TAILACT) + (size_t)bl * (256 * 1024), F.b_gu + (size_t)e * 2048, WSP(float, WS_ROWRS) + bq * 256};
        pg8::gemm_phase<pg8::EpiGU, pg8::ListOrderT<true>, true, true>(F.lds, g, S, E);
        __syncthreads();
    }
}
__device__ __forceinline__ void p10c_moe_tail_down(Frame& F) {
    const int* rowtok = WSP(int, WS_ROWTOK); const int* blke = WSP(int, WS_BLKE);
    const int nblk = blke[MAXBLK], nfull = (nblk / F.G) * F.G, nu = (nblk - nfull) * 4;
#pragma unroll 1
    for (int u = F.vcu; u < nu; u += F.G) {
        const int bl = u >> 2, bq = nfull + bl, e = blke[bq];
        int z1; asm volatile("v_mov_b32 %0, 0" : "=v"(z1));
        pg8::Gemm g{WSP(bf16, WS_TAILACT) + (size_t)bl * (256 * 1024), WSP(bf16, WS_WD), 256, 1024 * 32, 1024}; pg8::ListOrderT<false> S{1, e * 4 + (u & 3), F.tid + z1, nullptr}; pg8::EpiDown E{WSP(bf16, WS_YBUF), F.b_d + (size_t)e * 1024, rowtok + bq * 256};
        pg8::gemm_phase<pg8::EpiDown, pg8::ListOrderT<false>, true, true>(F.lds, g, S, E);
        __syncthreads();
    }
}

__device__ __forceinline__ void p11_final(Frame& F) {
    const int gw = F.vcu * NWAVES + F.wave, NGW = F.G * NWAVES, lane = F.lane;
    const float* tok_g = WSP(float, WS_TOKG); const bf16* ybuf = WSP(bf16, WS_YBUF);
    for (int t = gw; t < T; t += NGW) {
        GAS f32x4* xr = (GAS f32x4*)(F.out + (size_t)t * D) + lane; const GAS f32x4* gr = (const GAS f32x4*)F.fin_g + lane;
        const f32x4 gt = *(const GAS f32x4*)(tok_g + (size_t)t * 4);
        f32x4 v[4];
#pragma unroll
        for (int j = 0; j < 4; ++j) v[j] = __builtin_nontemporal_load(xr + 64 * j);
#pragma unroll
        for (int k = 0; k < 4; ++k) { const GAS v2u* yr = (const GAS v2u*)(ybuf + ((size_t)t * 4 + k) * D) + lane; const float gk = gt[k];
#pragma unroll
            for (int j = 0; j < 4; ++j) { const v2u w = __builtin_nontemporal_load(yr + 64 * j); v[j].x += gk * bflo(w.x); v[j].y += gk * bfhi(w.x); v[j].z += gk * bflo(w.y); v[j].w += gk * bfhi(w.y); } }
        float s = 0.f;
#pragma unroll
        for (int j = 0; j < 4; ++j) s += (v[j].x * v[j].x + v[j].y * v[j].y) + (v[j].z * v[j].z + v[j].w * v[j].w);
        const float rstd = 1.f / sqrtf(wave_sum(s) * (1.f / 1024.f) + EPS);
#pragma unroll
        for (int j = 0; j < 4; ++j) { const f32x4 gg = gr[64 * j]; const f32x4 r_ = v[j] * rstd * gg; CHKW_S(6, __builtin_bit_cast(unsigned, r_[0]) + __builtin_bit_cast(unsigned, r_[1]) + __builtin_bit_cast(unsigned, r_[2]) + __builtin_bit_cast(unsigned, r_[3])); __builtin_nontemporal_store(r_, xr + 64 * j); }
    }
}

struct Args { const void* in[19]; float* out; unsigned char* ws; int ph_lo, ph_hi, li, pad; };
__global__ void __launch_bounds__(NWAVES * 64, 2) mk_fwd(Args args) {
    extern __shared__ __attribute__((aligned(16))) unsigned char lds[];
    Frame F;
    F.lds = (LAS unsigned char*)lds;
    F.MISC = (volatile LAS unsigned*)(F.lds + MISC_OFF);
    F.tid = threadIdx.x; F.lane = F.tid & 63; F.wave = __builtin_amdgcn_readfirstlane(F.tid >> 6);
    F.G = gridDim.x; { const int bx = blockIdx.x; F.vcu = (bx % 8) * (F.G / 8) + bx / 8; }
    F.ws = args.ws; F.ctl = (gu32*)(args.ws + WS_CTL);
    F.x = (const float*)args.in[0]; F.pos = (const int*)args.in[1]; F.out = args.out;
    F.attn_g = (const float*)args.in[2]; F.w_in = (const float*)args.in[3]; F.qn_g = (const float*)args.in[4]; F.w_uq = (const float*)args.in[5]; F.kvn_g = (const float*)args.in[6];
    F.w_ukv = (const float*)args.in[7]; F.w_ba = (const float*)args.in[8]; F.w_bb = (const float*)args.in[9]; F.w_out = (const float*)args.in[10]; F.ffn_g = (const float*)args.in[11];
    F.r_w = (const float*)args.in[12]; F.r_b = (const float*)args.in[13]; F.w_gu = (const float*)args.in[14]; F.b_gu = (const float*)args.in[15]; F.w_d = (const float*)args.in[16];
    F.b_d = (const float*)args.in[17]; F.fin_g = (const float*)args.in[18];
    if (F.tid < 16) F.MISC[F.tid] = 0u;
#if defined(SELFCHK2)
    if (F.tid < 64) ((LAS unsigned*)(F.lds + 163072))[F.tid] = 0u;
#endif
    __syncthreads();
    XcdBarrier bar; bar.bar = (unsigned*)(F.ctl + CW_BAR); bar.x = 0; bar.st = nullptr;
    if (N_LAUNCHES == 1) bar = xcd_barrier_post((unsigned*)(F.ctl + CW_BAR) + args.li * 4096, F.MISC + 0);
#if defined(DBL_BAR)
#define GRID_BAR() do { if (N_LAUNCHES == 1) { xcd_barrier(bar); xcd_barrier(bar); } } while (0)
#elif defined(SYS_ACQ)
#define GRID_BAR() do { if (N_LAUNCHES == 1) { xcd_barrier(bar); if (F.tid == 0) __builtin_amdgcn_fence(__ATOMIC_ACQUIRE, ""); asm volatile("s_waitcnt vmcnt(0)" ::: "memory"); __syncthreads(); } } while (0)
#else
#define GRID_BAR() do { if (N_LAUNCHES == 1) { xcd_barrier(bar); } } while (0)
#endif
    const int lo = args.ph_lo, hi = args.ph_hi;
#ifndef DBG_MASK
#define DBG_MASK 0x1FFF
#endif
#define IN(k) ((((DBG_MASK) >> (k)) & 1) && lo <= (k) && (k) < hi)
#define BOTH(k) (IN(k) && IN((k) + 1))
#ifndef MOE_PROBE
#define MOE_PROBE 0
#endif
#ifndef DBG_DOUBLE
#define DBG_DOUBLE 0
#endif
#define REP(k) _Pragma("unroll") for (int rep_ = 0; rep_ < ((((DBG_DOUBLE) >> (k)) & 1) ? 2 : 1); ++rep_)
#define PHASE_BEGIN() int zz_; asm volatile("v_mbcnt_lo_u32_b32 %0, -1, 0\n\tv_mbcnt_hi_u32_b32 %0, -1, %0" : "=v"(zz_)); F.lane = zz_; F.tid = F.wave * 64 + F.lane; zz_ = F.tid

#if defined(PROBE_L2)
    {
        unsigned* R = (unsigned*)(F.ws + 1000 * MiB); const int G_ = F.G, w = (int)blockIdx.x, nb = (w + 1) % G_;
        unsigned bad = 0u;
        for (int round = 0; round < 3; ++round) {
            const unsigned v1 = 0x1000000u * (unsigned)(round + 1), v2 = v1 + 0x800000u;
            for (int i = F.tid; i < 8192; i += 512) R[(size_t)w * 8192 + i] = v1 + (unsigned)i;
            GRID_BAR();
            { unsigned x = 0; for (int i = F.tid; i < 8192; i += 512) x |= R[(size_t)nb * 8192 + i] ^ (v1 + (unsigned)i); if (x) bad |= 1u; }
            GRID_BAR();
            for (int i = F.tid; i < 8192; i += 512) R[(size_t)w * 8192 + i] = v2 + (unsigned)i;
            GRID_BAR();
            { unsigned x = 0; for (int i = F.tid; i < 8192; i += 512) x |= R[(size_t)nb * 8192 + i] ^ (v2 + (unsigned)i); if (x) bad |= 1u; }
            unsigned* S = R + (size_t)G_ * 8192;
            for (int i = F.tid; i < 256; i += 512) S[(size_t)i * 256 + w] = v1 + (unsigned)(i * 256 + w);
            GRID_BAR();
            { unsigned x = 0; for (int i = F.tid; i < 65536; i += 512) x |= S[i] ^ (v1 + (unsigned)i); if (x) bad |= 2u; }
            GRID_BAR();
        }
        if (bad) __hip_atomic_fetch_or((unsigned*)(F.ctl + 9), bad, RLX_AGENT);
        GRID_BAR();
    }
#endif
#if defined(SELFCHK)
#define CHK(k, off, bytes) do { int ln_; asm volatile("v_mbcnt_lo_u32_b32 %0, -1, 0\n\tv_mbcnt_hi_u32_b32 %0, -1, %0" : "=v"(ln_)); const unsigned* P_ = (const unsigned*)(F.ws + (off)); const size_t n_ = (size_t)(bytes) / 4; unsigned acc_ = 0; \
        for (size_t i_ = (size_t)F.vcu * 512 + F.wave * 64 + ln_; i_ < n_; i_ += (size_t)F.G * 512) acc_ += P_[i_]; \
        for (int o_ = 1; o_ < 64; o_ <<= 1) acc_ += __shfl_xor(acc_, o_); \
        if (ln_ == 0) __hip_atomic_fetch_add((unsigned*)(F.ctl + 64 + 32 * args.pad + (k)), acc_, RLX_AGENT); } while (0)
#define CHKOUT(k) do { int ln_; asm volatile("v_mbcnt_lo_u32_b32 %0, -1, 0\n\tv_mbcnt_hi_u32_b32 %0, -1, %0" : "=v"(ln_)); const unsigned* P_ = (const unsigned*)F.out; const size_t n_ = (size_t)T * D; unsigned acc_ = 0; \
        for (size_t i_ = (size_t)F.vcu * 512 + F.wave * 64 + ln_; i_ < n_; i_ += (size_t)F.G * 512) acc_ += P_[i_]; \
        for (int o_ = 1; o_ < 64; o_ <<= 1) acc_ += __shfl_xor(acc_, o_); \
        if (ln_ == 0) __hip_atomic_fetch_add((unsigned*)(F.ctl + 64 + 32 * args.pad + (k)), acc_, RLX_AGENT); } while (0)
#elif defined(SELFCHK2)
#define FLUSHK(k) do { LDS_WAIT(); __syncthreads(); if (F.wave == 0) { int ln_; asm volatile("v_mbcnt_lo_u32_b32 %0, -1, 0\n\tv_mbcnt_hi_u32_b32 %0, -1, %0" : "=v"(ln_)); LAS unsigned* sl_ = (LAS unsigned*)(F.lds + 163072) + ln_; \
        unsigned acc_ = *sl_; *sl_ = 0u; for (int o_ = 1; o_ < 64; o_ <<= 1) acc_ += __shfl_xor(acc_, o_); \
        if (ln_ == 0) __hip_atomic_fetch_add((unsigned*)(F.ctl + 64 + 32 * args.pad + (k)), acc_, RLX_AGENT); } LDS_WAIT(); __syncthreads(); } while (0)
#define CHK(k, off, bytes) FLUSHK(k)
#define CHKOUT(k) FLUSHK(k)
#else
#define CHK(k, off, bytes) do {} while (0)
#define CHKOUT(k) do {} while (0)
#endif
    if (IN(0)) { PHASE_BEGIN(); REP(0) p0_prologue(F); if (BOTH(0)) GRID_BAR(); CHK(0, WS_WIN, 14 * MiB); CHK(0, WS_WGU, 192 * MiB); CHK(0, WS_H, 128 * MiB); CHK(0, WS_CS16, 12 * MiB); }

    if (IN(1)) {
        PHASE_BEGIN();
        REP(1) {
        pg8::Gemm g{WSP(bf16, WS_H), WSP(bf16, WS_WIN), T, 1792, 1024}; pg8::StaticOrder S; S.init(T, 1792, F.G, (int)blockIdx.x); S.z = zz_;
        pg8::EpiZ E{WSP(bf16, WS_CQ), WSP(bf16, WS_CKV), WSP(bf16, WS_KPE), WSP(bf16, WS_KB), WSP(bf16, WS_VB), WSP(bf16, WS_KIDX), WSP(bf16, WS_QB), WSP(bf16, WS_QIDX), WSP(float, WS_WIDX)};
        pg8::gemm_phase<pg8::EpiZ, pg8::StaticOrder, true, true>(F.lds, g, S, E);
        }
        if (BOTH(1)) GRID_BAR(); CHK(1, WS_CQ, 78 * MiB); CHK(1, WS_QB, 128 * MiB);
    }

    if (IN(2)) { PHASE_BEGIN(); p2_token_pass(F); if (BOTH(2)) GRID_BAR(); CHK(2, WS_CQ, 78 * MiB); CHK(2, WS_QB, 128 * MiB); }

    if (IN(3)) {
        PHASE_BEGIN();
        REP(3) {
        { pg8::Gemm g{WSP(bf16, WS_CQ), WSP(bf16, WS_WUQ), T, 768, 256}; pg8::StaticOrder S; S.init(T, 768, F.G, (int)blockIdx.x); S.z = zz_;
          pg8::EpiStore E{WSP(bf16, WS_QMLA), 768};
          pg8::gemm_phase<pg8::EpiStore, pg8::StaticOrder, true, true>(F.lds, g, S, E); }
        __syncthreads();
        { int z2_; asm volatile("v_mbcnt_lo_u32_b32 %0, -1, 0\n\tv_mbcnt_hi_u32_b32 %0, -1, %0" : "=v"(z2_)); z2_ += F.wave * 64;
          pg8::Gemm g{WSP(bf16, WS_CKV), WSP(bf16, WS_WUKV), T, 1024, 128}; pg8::StaticOrder S; S.init(T, 1024, F.G, (int)blockIdx.x); S.z = z2_;
          pg8::EpiStore E{WSP(bf16, WS_KV), 1024};
          pg8::gemm_phase<pg8::EpiStore, pg8::StaticOrder, true, true>(F.lds, g, S, E); }
        }
        if (BOTH(3)) GRID_BAR(); CHK(3, WS_QMLA, 224 * MiB);
    }

    if (IN(4)) {
        PHASE_BEGIN();
#if defined(PROBE_T5)
        mla::phase<PROBE_T5>(zz_, F.vcu, WSP(bf16, WS_QMLA), WSP(bf16, WS_KV), WSP(bf16, WS_KPE), WSP(f32x2, WS_CS32), WSP(bf16, WS_YB), F.lds);
#endif
#ifndef P4_ALT_SHIFT
#define P4_ALT_SHIFT 0
#endif
#if !SPLIT_MIXERS && defined(P4_ALT)
        _Pragma("unroll 1") for (int ph_ = 0; ph_ < 2; ++ph_) {
            if ((ph_ == 0) != (((F.vcu >> P4_ALT_SHIFT) & 1) != 0)) mla::phase<0>(zz_, F.vcu, WSP(bf16, WS_QMLA), WSP(bf16, WS_KV), WSP(bf16, WS_KPE), WSP(f32x2, WS_CS32), WSP(bf16, WS_YA), F.lds);
            else dsa::phase(zz_, F.vcu, WSP(bf16, WS_QIDX), WSP(bf16, WS_KIDX), WSP(float, WS_WIDX), WSP(bf16, WS_QB), WSP(bf16, WS_KB), WSP(bf16, WS_VB), WSP(bf16, WS_YB), F.lds);
            __syncthreads(); }
#else
        mla::phase<0>(zz_, F.vcu, WSP(bf16, WS_QMLA), WSP(bf16, WS_KV), WSP(bf16, WS_KPE), WSP(f32x2, WS_CS32), WSP(bf16, WS_YA), F.lds);
#endif
#if defined(PROBE_T1)
        VM_WAIT(); __syncthreads();
        mla::phase<0>(zz_, F.vcu, WSP(bf16, WS_QMLA), WSP(bf16, WS_KV), WSP(bf16, WS_KPE), WSP(f32x2, WS_CS32), WSP(bf16, WS_YA), F.lds);
#elif defined(PROBE_T3)
        mla::phase<0>(zz_, F.vcu, WSP(bf16, WS_QMLA), WSP(bf16, WS_KV), WSP(bf16, WS_KPE), WSP(f32x2, WS_CS32), WSP(bf16, WS_YB), F.lds);
#endif
        __syncthreads();
#if SPLIT_MIXERS
        if (BOTH(4)) GRID_BAR(); CHK(4, WS_YA, 64 * MiB);
#if defined(PROBE_T8)
        { const v4u* A = WSP(v4u, WS_YA); const v4u* B = WSP(v4u, WS_YB); unsigned bad = 0;
          for (size_t i = (size_t)F.vcu * 512 + F.tid; i < (size_t)T * 512 * 2 / 16; i += (size_t)F.G * 512) { const v4u a = A[i], b = B[i]; bad |= (a.x ^ b.x) | (a.y ^ b.y) | (a.z ^ b.z) | (a.w ^ b.w); }
          if (bad) __hip_atomic_store(F.ctl + 8, 1u, RLX_AGENT);
          GRID_BAR(); }
#endif
    }
    if (IN(12)) {
        PHASE_BEGIN();
#endif
#if !(!SPLIT_MIXERS && defined(P4_ALT))
        REP(12) dsa::phase(zz_, F.vcu, WSP(bf16, WS_QIDX), WSP(bf16, WS_KIDX), WSP(float, WS_WIDX), WSP(bf16, WS_QB), WSP(bf16, WS_KB), WSP(bf16, WS_VB), WSP(bf16, WS_YB), F.lds);
#endif
        if (BOTH(4)) GRID_BAR(); CHK(12, WS_YB, 64 * MiB);
    }

    if (IN(5)) {
        PHASE_BEGIN();
        REP(5) {
        pg8::Gemm g{WSP(bf16, WS_H), WSP(bf16, WS_WG), T, 2048, 1024}; pg8::StaticOrder S; S.init(T, 2048, F.G, (int)blockIdx.x); S.z = zz_;
        pg8::EpiGate E{WSP(bf16, WS_G)};
        pg8::gemm_phase<pg8::EpiGate, pg8::StaticOrder, true, true>(F.lds, g, S, E);
        }
        if (BOTH(5)) GRID_BAR(); CHK(5, WS_G, 256 * MiB);
    }

    if (IN(6)) {
        PHASE_BEGIN();
        REP(6) {
        { pg8::Gemm g{WSP(bf16, WS_YA), WSP(bf16, WS_WBA), T, 1024, 512}; pg8::StaticOrder S; S.init(T, 1024, F.G, (int)blockIdx.x); S.z = zz_;
          pg8::EpiMerge<0> E{WSP(bf16, WS_G), WSP(bf16, WS_M)};
          pg8::gemm_phase<pg8::EpiMerge<0>, pg8::StaticOrder, true, true>(F.lds, g, S, E); }
        VM_WAIT(); __syncthreads();
        { int z2_; asm volatile("v_mbcnt_lo_u32_b32 %0, -1, 0\n\tv_mbcnt_hi_u32_b32 %0, -1, %0" : "=v"(z2_)); z2_ += F.wave * 64;
          pg8::Gemm g{WSP(bf16, WS_YB), WSP(bf16, WS_WBB), T, 1024, 512}; pg8::StaticOrder S; S.init(T, 1024, F.G, (int)blockIdx.x); S.z = z2_;
          pg8::EpiMerge<1> E{WSP(bf16, WS_G), WSP(bf16, WS_M)};
          pg8::gemm_phase<pg8::EpiMerge<1>, pg8::StaticOrder, true, true>(F.lds, g, S, E); }
        }
        if (BOTH(6)) GRID_BAR(); CHK(6, WS_M, 128 * MiB);
    }

    if (IN(7)) {
        PHASE_BEGIN();
        REP(7) {
        pg8::Gemm g{WSP(bf16, WS_M), WSP(bf16, WS_WOUT), T, 1024, 1024}; pg8::StaticOrder S; S.init(T, 1024, F.G, (int)blockIdx.x); S.z = zz_;
        pg8::EpiX1 E{F.x, F.out, F.ffn_g, WSP(bf16, WS_XN2)};
        pg8::gemm_phase<pg8::EpiX1, pg8::StaticOrder, true, true>(F.lds, g, S, E);
        }
        if (BOTH(7)) GRID_BAR(); CHKOUT(7);
    }

    if (IN(8)) { PHASE_BEGIN(); REP(8) p8_router(F); if (BOTH(8)) GRID_BAR(); CHK(8, WS_TOKE, 3 * MiB + 256 * 1024); }
    if (IN(9)) { PHASE_BEGIN(); p9_slots(F); if (BOTH(9)) GRID_BAR(); CHK(9, WS_ROWTOK, 1024 * 256 * 4); CHK(9, WS_BLKE, 1024 * 4); }
    if (IN(10)) { PHASE_BEGIN(); if (MOE_PAIR && F.G == 256) p10_moe_pair(F); else { REP(10) p10_moe(F, (MOE_PROBE) && rep_ == 0 ? (MOE_PROBE) : 0); } GRID_BAR(); }
    if (IN(10)) { PHASE_BEGIN(); p10b_moe_tail_gu(F); GRID_BAR(); }
    if (IN(10)) { PHASE_BEGIN(); p10c_moe_tail_down(F); if (BOTH(10)) GRID_BAR(); CHK(10, WS_YBUF, 512 * MiB); }
    if (IN(11)) { PHASE_BEGIN(); p11_final(F);
#if defined(SELFCHK) || defined(SELFCHK2)
        GRID_BAR(); CHKOUT(11); GRID_BAR();
        if (args.pad == 1) {
            if (blockIdx.x == 0 && F.tid == 0) { unsigned code = 0u;
                for (int k = 0; k < 16; ++k) { const unsigned a_ = __hip_atomic_load(F.ctl + 64 + k, RLX_AGENT), b_ = __hip_atomic_load(F.ctl + 96 + k, RLX_AGENT); if (a_ != b_ && code == 0u) code = (unsigned)(k + 1); }
                __hip_atomic_store(F.ctl + 10, code, RLX_AGENT); }
            GRID_BAR();
            const unsigned code = __hip_atomic_load(F.ctl + 10, RLX_AGENT);
            if (code) { const float sc = 1.f + 0.02f * (float)code; for (size_t i = (size_t)F.vcu * 512 + F.tid; i < (size_t)T * D; i += (size_t)F.G * 512) F.out[i] *= sc; }
        }
#endif
#if defined(PROBE_T8) || defined(PROBE_L2)
        GRID_BAR();
        { const unsigned c9 = __hip_atomic_load(F.ctl + 9, RLX_AGENT); if (__hip_atomic_load(F.ctl + 8, RLX_AGENT) != 0u) { for (size_t i = (size_t)F.vcu * 512 + F.tid; i < (size_t)T * D; i += (size_t)F.G * 512) F.out[i] = __builtin_nanf(""); }
          else if (c9) { const float sc = 1.f + 0.05f * (float)c9; for (size_t i = (size_t)F.vcu * 512 + F.tid; i < (size_t)T * D; i += (size_t)F.G * 512) F.out[i] *= sc; } }
#endif
    }
#undef IN
#undef BOTH
}

extern "C" void kernel_launch(void* const* d_in, const int* in_sizes, int n_in, void* d_out, int out_size, void* d_ws, size_t ws_size, hipStream_t stream) {
    static int grid = 0;
    if (grid == 0) {
        if (n_in != 19 || in_sizes[0] != T * D || out_size != T * D || ws_size < WS_END) { fprintf(stderr, "kernel_launch: unexpected shapes (n_in %d, in0 %d, out %d, ws %zu)\n", n_in, n_in > 0 ? in_sizes[0] : -1, out_size, ws_size); grid = -1; return; }
        int dev = 0, cus = 0;
        if (hipGetDevice(&dev) != hipSuccess || hipDeviceGetAttribute(&cus, hipDeviceAttributeMultiprocessorCount, dev) != hipSuccess) { grid = -1; return; }
        if (hipFuncSetAttribute((const void*)mk_fwd, hipFuncAttributeMaxDynamicSharedMemorySize, LDS_BYTES) != hipSuccess) { fprintf(stderr, "kernel_launch: hipFuncSetAttribute failed\n"); grid = -1; return; }
        int per_cu = 0;
        if (hipOccupancyMaxActiveBlocksPerMultiprocessor(&per_cu, (const void*)mk_fwd, NWAVES * 64, LDS_BYTES) != hipSuccess || per_cu < 1) fprintf(stderr, "kernel_launch: occupancy query says %d\n", per_cu);
        (void)hipGetLastError();
        if (cus != 256) { fprintf(stderr, "kernel_launch: built for 256 CUs, device has %d\n", cus); grid = -1; return; }
        grid = 256;
    }
    if (grid < 0) return;
#if defined(DIAG_ZERO_WS)
    if (hipMemsetAsync((char*)d_ws, 0, WS_END, stream) != hipSuccess) return;
    (void)hipMemsetAsync(d_out, 0, (size_t)out_size * 4, stream);
#else
    if (hipMemsetAsync((char*)d_ws + WS_CTL, 0, CTL_ZERO_BYTES, stream) != hipSuccess) return;
#endif
    Args a{};
    for (int i = 0; i < 19; ++i) a.in[i] = d_in[i];
    a.out = (float*)d_out; a.ws = (unsigned char*)d_ws;
#if defined(SELFCHK) || defined(SELFCHK2)
    for (int pass = 0; pass < 2; ++pass) { a.ph_lo = 0; a.ph_hi = 13; a.li = pass; a.pad = pass; hipLaunchKernelGGL(mk_fwd, dim3(grid), dim3(NWAVES * 64), LDS_BYTES, stream, a); }
    if (true) return;
#endif
    for (int li = 0; li < N_LAUNCHES; ++li) {
        int ph = li;
#if SPLIT_MIXERS
        ph = li <= 4 ? li : li == 5 ? 12 : li - 1;
#endif
        a.ph_lo = (N_LAUNCHES != 1) ? ph : 0; a.ph_hi = (N_LAUNCHES != 1) ? ph + 1 : 13; a.li = 0;
        hipLaunchKernelGGL(mk_fwd, dim3(grid), dim3(NWAVES * 64), LDS_BYTES, stream, a);
        if (hipPeekAtLastError() != hipSuccess) { fprintf(stderr, "kernel_launch: launch %d failed\n", li); break; }
    }
}
```

```cpp
#define MK_N_LAUNCHES 1
#define SPLIT_MIXERS 0
#define MLA_PRIO_E 3
#define MLA_PRIO 1
#define P4_ALT 1
#include <hip/hip_runtime.h>
#include <cstdio>
#include <cstdint>

extern __shared__ __attribute__((aligned(16))) unsigned char g_lds[];
#if defined(SELFCHK2) || defined(CHKW_MASK)
#ifndef CHKW_MASK
#define CHKW_MASK 0xFF
#endif
#define CHKW_S(site, v) do { if (((CHKW_MASK) >> (site)) & 1) { int ln_; asm volatile("v_mbcnt_lo_u32_b32 %0, -1, 0\n\tv_mbcnt_hi_u32_b32 %0, -1, %0" : "=v"(ln_)); __hip_atomic_fetch_add((__attribute__((address_space(3))) unsigned*)(g_lds + 163072) + ln_, (unsigned)(v), __ATOMIC_RELAXED, __HIP_MEMORY_SCOPE_WORKGROUP); } } while (0)
#else
#define CHKW_S(site, v) do {} while (0)
#endif
namespace pg8 {
#define PG8_LAS __attribute__((address_space(3)))
typedef unsigned short bf16_t;
typedef short bf16x8 __attribute__((ext_vector_type(8)));
typedef float f32x4 __attribute__((ext_vector_type(4)));
typedef unsigned u32x4 __attribute__((ext_vector_type(4)));
constexpr int BM = 256, BK = 64, HALF = 128, HTB = HALF * BK * 2  , STAGE_BYTES = 8 * HTB, NXCD = 8, WGM = 8;

__host__ __device__ __forceinline__ int lds_byte(int r, int c) { const int st = (r >> 4) * 2 + (c >> 5), rr = r & 15, cc = c & 31, ob = rr * 64 + cc * 2; return st * 1024 + (ob ^ (((ob >> 9) & 1) << 5)); }
__host__ __device__ __forceinline__ void stage_rc(int b, int& R, int& C) { const int st = b / 1024, sb = b % 1024, swz = sb ^ (((sb >> 9) & 1) << 5); R = (st >> 1) * 16 + swz / 64; C = (st & 1) * 32 + (swz % 64) / 2; }
__host__ __device__ __forceinline__ int perm32(int rho) { const int n = rho >> 4, i = rho & 15; return 8 * (i >> 2) + 4 * n + (i & 3); }

struct Unit { int pm, pn; };
struct Gemm { const bf16_t* A; const bf16_t* Bt; int M, N, K; };

struct StaticOrder {
    static constexpr bool GATHER = false; const int* rows = nullptr;
    int nM, nN, nwg, G, c, z = 0;
    __host__ __device__ void init(int M, int N, int G_, int c_) { nM = M / BM; nN = N / BM; nwg = nM * nN; G = G_; c = c_; }
    __host__ __device__ bool next(int i, Unit& u) const {
        const long L = (long)i * G + c; if (L >= nwg) return false;
        int wgid = (int)L; { const int q = nwg / NXCD, r = nwg % NXCD, xcd = wgid % NXCD, off = wgid / NXCD; wgid = (xcd < r ? xcd * (q + 1) : r * (q + 1) + (xcd - r) * q) + off; }
        const int nig = WGM * nN, gid = wgid / nig, fm = gid * WGM, gsz = (nM - fm) < WGM ? (nM - fm) : WGM;
        u.pm = fm + ((wgid % nig) % gsz); u.pn = (wgid % nig) / gsz; return true;
    }
    __device__ __forceinline__ void a_ready(const Unit&) const {}
    __device__ __forceinline__ void done(const Unit&) const {}
    __device__ __forceinline__ int tid_bias() const { return z; }
};

__device__ __forceinline__ unsigned cvt_pk_bf16(float lo, float hi) { unsigned r; asm volatile("s_nop 1\n\tv_cvt_pk_bf16_f32 %0, %1, %2" : "=v"(r) : "v"(lo), "v"(hi)); return r; }
typedef float f32x2 __attribute__((ext_vector_type(2)));
template <class Epi, class Sched, bool ALIGN_EPI = false, bool SP2 = false>
__device__ __forceinline__ void gemm_phase(PG8_LAS unsigned char* lds, const Gemm g, const Sched& S, const Epi& E) {
    const int tid = S.tid_bias(), wid = __builtin_amdgcn_readfirstlane(tid >> 6), lane = tid & 63, wr = wid >> 2, wc = wid & 3, fr = lane & 15, fq = lane >> 4;
    const int K = g.K, nt = K / BK;
    unsigned voffA[2], voffB[2];
#pragma unroll
    for (int i = 0; i < 2; ++i) { int R, C; stage_rc(tid * 16 + i * 8192, R, C); const int Rb = Epi::PERM ? ((R & ~31) + perm32(R & 31)) : R;
        voffA[i] = (unsigned)(R * K + C) * 2u; voffB[i] = (unsigned)(Rb * K + C) * 2u; }
    unsigned voffA1[2]; voffA1[0] = voffA[0]; voffA1[1] = voffA[1];
    if constexpr (Sched::GATHER) {
#pragma unroll
        for (int i = 0; i < 2; ++i) { int R, C; stage_rc(tid * 16 + i * 8192, R, C);
            voffA[i] = (unsigned)(S.rows[R] * K + C) * 2u; voffA1[i] = (unsigned)(S.rows[HALF + R] * K + C) * 2u; } }
    const size_t kstep = (size_t)(BK * 2);
    const size_t hstep = (size_t)HALF * K * 2;
    const size_t tstep = 2 * hstep;
    const size_t hstepA = Sched::GATHER ? 0 : hstep;
    const unsigned ldsw = (unsigned)wid * 1024u;
    const int aoff = lds_byte(wr * 64 + fr, fq * 8), boff = lds_byte(wc * 32 + fr, fq * 8);
#define PG8_SA(b, h) (((b) * 2 + (h)) * HTB)
#define PG8_SB(b, h) ((4 + (b) * 2 + (h)) * HTB)
#define PG8_STAGE(bufoff, gbase, voff) do { _Pragma("unroll") for (int _i = 0; _i < 2; ++_i) \
        __builtin_amdgcn_global_load_lds((const unsigned*)((const char*)(gbase) + (voff)[_i]), (PG8_LAS unsigned*)(lds + (bufoff) + ldsw + _i * 8192), 16, 0, 0); } while (0)
#define PG8_LDA(dst, b, h) do { _Pragma("unroll") for (int m = 0; m < 4; ++m) _Pragma("unroll") for (int k = 0; k < 2; ++k) dst[m][k] = *(const PG8_LAS bf16x8*)(lds + PG8_SA(b, h) + aoff + m * 2048 + k * 1024); } while (0)
#define PG8_LDB(dst, b, h) do { _Pragma("unroll") for (int n = 0; n < 2; ++n) _Pragma("unroll") for (int k = 0; k < 2; ++k) dst[n][k] = *(const PG8_LAS bf16x8*)(lds + PG8_SB(b, h) + boff + n * 2048 + k * 1024); } while (0)
#define PG8_MMA(ai, bj, At, Bt) do { __builtin_amdgcn_s_setprio(1); _Pragma("unroll") for (int m = 0; m < 4; ++m) _Pragma("unroll") for (int n = 0; n < 2; ++n) _Pragma("unroll") for (int k = 0; k < 2; ++k) \
        acc[ai][bj][m][n] = __builtin_amdgcn_mfma_f32_16x16x32_bf16(Bt[n][k], At[m][k], acc[ai][bj][m][n], 0, 0, 0); __builtin_amdgcn_s_setprio(0); } while (0)
#define PG8_WAIT_V(n) asm volatile("s_waitcnt vmcnt(" #n ")" ::: "memory")
#define PG8_WAIT_L(n) asm volatile("s_waitcnt lgkmcnt(" #n ")" ::: "memory")
#define PG8_BAR __builtin_amdgcn_s_barrier()
#define PG8_SCHED __builtin_amdgcn_sched_barrier(0)
    Unit cur, nxt; int ui = 0;
    if (!S.next(0, cur)) return;
    f32x4 acc[2][2][4][2];
#pragma unroll
    for (int a = 0; a < 2; ++a)
#pragma unroll
        for (int b = 0; b < 2; ++b)
#pragma unroll
            for (int m = 0; m < 4; ++m)
#pragma unroll
                for (int n = 0; n < 2; ++n) acc[a][b][m][n] = (f32x4){0.f, 0.f, 0.f, 0.f};
    bf16x8 At[4][2], B0[2][2], B1[2][2];
    const char* cA = (const char*)g.A + (size_t)cur.pm * tstep; const char* cB = (const char*)g.Bt + (size_t)cur.pn * tstep;
    S.a_ready(cur);
    if constexpr (SP2) {
        PG8_STAGE(PG8_SB(0, 0), cB, voffB); PG8_STAGE(PG8_SB(0, 1), cB + hstep, voffB); PG8_STAGE(PG8_SA(0, 0), cA, voffA); PG8_STAGE(PG8_SA(0, 1), cA + hstepA, voffA1);
        if (wr == 1) PG8_BAR;
        PG8_WAIT_V(2); PG8_BAR;
        PG8_STAGE(PG8_SB(1, 0), cB + kstep, voffB); PG8_STAGE(PG8_SA(1, 0), cA + kstep, voffA); PG8_STAGE(PG8_SB(1, 1), cB + hstep + kstep, voffB);
        PG8_WAIT_V(6); PG8_BAR;
    } else {
        PG8_STAGE(PG8_SB(0, 0), cB, voffB); PG8_STAGE(PG8_SA(0, 0), cA, voffA); PG8_STAGE(PG8_SB(0, 1), cB + hstep, voffB); PG8_STAGE(PG8_SA(0, 1), cA + hstepA, voffA1);
        if (wr == 1) PG8_BAR;
        PG8_WAIT_V(4); PG8_BAR;
        PG8_STAGE(PG8_SB(1, 0), cB + kstep, voffB); PG8_STAGE(PG8_SA(1, 0), cA + kstep, voffA); PG8_STAGE(PG8_SB(1, 1), cB + hstep + kstep, voffB);
        PG8_WAIT_V(6); PG8_BAR;
    }
    for (;;) {
        const bool has_next = S.next(ui + 1, nxt);
        const char* nA = has_next ? (const char*)g.A + (size_t)nxt.pm * tstep : cA; const char* nB = has_next ? (const char*)g.Bt + (size_t)nxt.pn * tstep : cB;
        for (int t = 0; t < nt; t += 2) {
            const bool last = (t == nt - 2);
            const char* a1 = cA + (size_t)(t + 1) * kstep;
            const char* a2 = last ? nA : cA + (size_t)(t + 2) * kstep; const char* b2 = last ? nB : cB + (size_t)(t + 2) * kstep;
            const char* a3 = a2 + kstep; const char* b3 = b2 + kstep;
            if (last && has_next) S.a_ready(nxt);
            if constexpr (SP2) {
            PG8_LDB(B0, 0, 0); PG8_LDB(B1, 0, 1); PG8_SCHED; PG8_LDA(At, 0, 0); PG8_STAGE(PG8_SA(1, 1), a1 + hstepA, voffA1);
            PG8_WAIT_V(8); PG8_WAIT_L(0); PG8_BAR; PG8_MMA(0, 0, At, B0); PG8_MMA(0, 1, At, B1); PG8_BAR; PG8_SCHED;
            PG8_LDA(At, 0, 1); PG8_STAGE(PG8_SB(0, 0), b2, voffB); PG8_STAGE(PG8_SB(0, 1), b2 + hstep, voffB); PG8_STAGE(PG8_SA(0, 0), a2, voffA);
            PG8_WAIT_V(8); PG8_WAIT_L(0); PG8_BAR; PG8_MMA(1, 0, At, B0); PG8_MMA(1, 1, At, B1); PG8_BAR; PG8_SCHED;
            PG8_LDB(B0, 1, 0); PG8_LDB(B1, 1, 1); PG8_SCHED; PG8_LDA(At, 1, 0); PG8_STAGE(PG8_SA(0, 1), a2 + hstepA, voffA1);
            PG8_WAIT_V(8); PG8_WAIT_L(0); PG8_BAR; PG8_MMA(0, 0, At, B0); PG8_MMA(0, 1, At, B1); PG8_BAR; PG8_SCHED;
            PG8_LDA(At, 1, 1); PG8_STAGE(PG8_SB(1, 0), b3, voffB); PG8_STAGE(PG8_SB(1, 1), b3 + hstep, voffB); PG8_STAGE(PG8_SA(1, 0), a3, voffA);
            PG8_WAIT_V(8); PG8_WAIT_L(0); PG8_BAR; PG8_MMA(1, 0, At, B0); PG8_MMA(1, 1, At, B1); PG8_BAR; PG8_SCHED;
            } else {
            PG8_LDB(B0, 0, 0); PG8_SCHED; PG8_LDA(At, 0, 0); PG8_STAGE(PG8_SA(1, 1), a1 + hstepA, voffA1);
            PG8_WAIT_L(8); PG8_BAR; PG8_WAIT_L(0); PG8_MMA(0, 0, At, B0); PG8_BAR; PG8_SCHED;
            PG8_LDB(B1, 0, 1); PG8_STAGE(PG8_SB(0, 0), b2, voffB);
            PG8_BAR; PG8_WAIT_L(0); PG8_MMA(0, 1, At, B1); PG8_BAR;
            PG8_LDA(At, 0, 1); PG8_STAGE(PG8_SA(0, 0), a2, voffA);
            PG8_BAR; PG8_WAIT_L(0); PG8_MMA(1, 0, At, B0); PG8_BAR; PG8_SCHED;
            PG8_STAGE(PG8_SB(0, 1), b2 + hstep, voffB);
            PG8_WAIT_V(6); PG8_BAR; PG8_MMA(1, 1, At, B1); PG8_BAR;
            PG8_LDB(B0, 1, 0); PG8_SCHED; PG8_LDA(At, 1, 0); PG8_STAGE(PG8_SA(0, 1), a2 + hstepA, voffA1);
            PG8_WAIT_L(8); PG8_BAR; PG8_WAIT_L(0); PG8_MMA(0, 0, At, B0); PG8_BAR; PG8_SCHED;
            PG8_LDB(B1, 1, 1); PG8_STAGE(PG8_SB(1, 0), b3, voffB);
            PG8_BAR; PG8_WAIT_L(0); PG8_MMA(0, 1, At, B1); PG8_BAR;
            PG8_LDA(At, 1, 1); PG8_STAGE(PG8_SA(1, 0), a3, voffA);
            PG8_BAR; PG8_WAIT_L(0); PG8_MMA(1, 0, At, B0); PG8_BAR; PG8_SCHED;
            PG8_STAGE(PG8_SB(1, 1), b3 + hstep, voffB);
            PG8_WAIT_V(6); PG8_BAR; PG8_MMA(1, 1, At, B1); PG8_BAR;
            }
        }
        if constexpr (ALIGN_EPI) { if (wr == 0) PG8_BAR; }
        if constexpr (!Epi::AFTER_DRAIN) { E(acc, cur, wr, wc, fr, fq); S.done(cur); }
        if (!has_next) break;
#pragma unroll
        for (int a = 0; a < 2; ++a)
#pragma unroll
            for (int b = 0; b < 2; ++b)
#pragma unroll
                for (int m = 0; m < 4; ++m)
#pragma unroll
                    for (int n = 0; n < 2; ++n) acc[a][b][m][n] = (f32x4){0.f, 0.f, 0.f, 0.f};
        cur = nxt; cA = nA; cB = nB; ++ui;
        if constexpr (ALIGN_EPI) { if (wr == 1) PG8_BAR; }
    }
    PG8_WAIT_V(0);
    if constexpr (!ALIGN_EPI) { if (wr == 0) PG8_BAR; }
    PG8_BAR;
    if constexpr (Epi::AFTER_DRAIN) { E.fused(acc, cur, wr, wc, fr, fq, lds, wid, lane); S.done(cur); }
#undef PG8_SA
#undef PG8_SB
#undef PG8_STAGE
#undef PG8_LDA
#undef PG8_LDB
#undef PG8_MMA
#undef PG8_WAIT_V
#undef PG8_WAIT_L
#undef PG8_BAR
#undef PG8_SCHED
}
}

constexpr int NWAVES = 8;
#ifndef MK_N_LAUNCHES
#define MK_N_LAUNCHES 1
#endif
#ifndef SPLIT_MIXERS
#define SPLIT_MIXERS 0
#endif
#ifndef PG_SP2
#define PG_SP2 true
#endif
constexpr int NPHASE = 12;
constexpr int N_LAUNCHES = MK_N_LAUNCHES;
constexpr int BATCH = 8, SEQ = 8192, D = 1024, T = BATCH * SEQ;
constexpr int D_IN = 3688;
constexpr float EPS = 1e-6f;
constexpr int NEXP = 32, DFF = 1024;
constexpr int NTASK = T / 32;
constexpr int MAXBLK = 1056;

constexpr size_t MiB = 1u << 20;
constexpr size_t WS_CTL = 0, CTL_ZERO_BYTES = 64 * 1024;
constexpr int CW_BAR = 1024;
constexpr size_t WS_WIN = 1 * MiB;
constexpr size_t WS_WG = 5 * MiB;
constexpr size_t WS_WUQ = 9 * MiB;
constexpr size_t WS_WUKV = 10 * MiB;
constexpr size_t WS_WBA = 11 * MiB;
constexpr size_t WS_WBB = 12 * MiB;
constexpr size_t WS_WOUT = 13 * MiB;
constexpr size_t WS_TOKE = 15 * MiB;
constexpr size_t WS_TOKG = 16 * MiB;
constexpr size_t WS_TOKR = 17 * MiB;
constexpr size_t WS_CNT = 18 * MiB;
constexpr size_t WS_ROWTOK = 19 * MiB;
constexpr size_t WS_BLKE = 21 * MiB;
constexpr size_t WS_WGU = 24 * MiB;
constexpr size_t WS_WD = 152 * MiB;
constexpr size_t WS_H = 216 * MiB;
constexpr size_t WS_CQ = 344 * MiB;
constexpr size_t WS_CKV = 376 * MiB;
constexpr size_t WS_KPE = 392 * MiB;
constexpr size_t WS_KB = 396 * MiB;
constexpr size_t WS_VB = 404 * MiB;
constexpr size_t WS_KIDX = 412 * MiB;
constexpr size_t WS_WIDX = 420 * MiB;
constexpr size_t WS_QB = 424 * MiB;
constexpr size_t WS_QIDX = 488 * MiB;
constexpr size_t WS_QMLA = 552 * MiB;
constexpr size_t WS_KV = 648 * MiB;
constexpr size_t WS_YA = 776 * MiB;
constexpr size_t WS_YB = 840 * MiB;
constexpr size_t WS_G = 344 * MiB;
constexpr size_t WS_M = 600 * MiB;
constexpr size_t WS_YBUF = 216 * MiB;
constexpr size_t WS_SCR = 728 * MiB;
constexpr size_t WS_XN2 = 856 * MiB;
constexpr size_t WS_ROWSRC = 22 * MiB;
constexpr size_t WS_CS16 = 984 * MiB;
constexpr size_t WS_CS32 = 988 * MiB;
constexpr size_t WS_TAILACT = 990 * MiB;
constexpr size_t WS_RSTOK = 1006 * MiB;
constexpr size_t WS_ROWRS = 1007 * MiB;
constexpr size_t WS_END = 1009 * MiB;

constexpr int RING_BYTES = 131072;
constexpr int LDS_BYTES = 163840;
constexpr int MISC_OFF = LDS_BYTES - 64;

#define GAS __attribute__((address_space(1)))
#define LAS __attribute__((address_space(3)))
typedef unsigned short bf16;
typedef unsigned v4u __attribute__((ext_vector_type(4)));
typedef unsigned v2u __attribute__((ext_vector_type(2)));
typedef float f32x4 __attribute__((ext_vector_type(4)));
typedef float f32x2 __attribute__((ext_vector_type(2)));
typedef float f32x16 __attribute__((ext_vector_type(16)));
typedef short bf16x8 __attribute__((ext_vector_type(8)));
typedef short s16x4 __attribute__((ext_vector_type(4)));
typedef GAS unsigned gu32;
#define RLX_AGENT __ATOMIC_RELAXED, __HIP_MEMORY_SCOPE_AGENT
#define LDS_WAIT() asm volatile("s_waitcnt lgkmcnt(0)" ::: "memory")
#define VM_WAIT() asm volatile("s_waitcnt vmcnt(0)" ::: "memory")
__device__ __forceinline__ unsigned f2bf(float f) { unsigned u = __builtin_bit_cast(unsigned, f); return (u + 0x7fffu + ((u >> 16) & 1u)) >> 16; }
__device__ __forceinline__ unsigned pk2(float lo, float hi) { return f2bf(lo) | (f2bf(hi) << 16); }
__device__ __forceinline__ float bf2f(unsigned short b) { return __builtin_bit_cast(float, (unsigned)b << 16); }
__device__ __forceinline__ float bflo(unsigned w) { return __builtin_bit_cast(float, w << 16); }
__device__ __forceinline__ float bfhi(unsigned w) { return __builtin_bit_cast(float, w & 0xffff0000u); }
__device__ __forceinline__ float wave_sum(float v) {
#pragma unroll
    for (int o = 1; o < 64; o <<= 1) v += __shfl_xor(v, o);
    return v;
}

namespace pg8 {
typedef unsigned u32x4 __attribute__((ext_vector_type(4)));
__device__ __forceinline__ u32x4 pack8(const f32x4 a, const f32x4 b) { u32x4 w; w.x = cvt_pk_bf16(a[0], a[1]); w.y = cvt_pk_bf16(a[2], a[3]); w.z = cvt_pk_bf16(b[0], b[1]); w.w = cvt_pk_bf16(b[2], b[3]); return w; }
__device__ __forceinline__ void unpack8(const u32x4 w, f32x4& a, f32x4& b) {
    a[0] = __builtin_bit_cast(float, w.x << 16); a[1] = __builtin_bit_cast(float, w.x & 0xffff0000u); a[2] = __builtin_bit_cast(float, w.y << 16); a[3] = __builtin_bit_cast(float, w.y & 0xffff0000u);
    b[0] = __builtin_bit_cast(float, w.z << 16); b[1] = __builtin_bit_cast(float, w.z & 0xffff0000u); b[2] = __builtin_bit_cast(float, w.w << 16); b[3] = __builtin_bit_cast(float, w.w & 0xffff0000u); }
__device__ __forceinline__ float sigmoidf_(float v) { return __builtin_amdgcn_rcpf(1.f + __builtin_amdgcn_exp2f(-1.4426950408889634f * v)); }

#define EPI_LOOP_BEGIN const int row0 = u.pm * BM + wr * 64 + fr; \
    _Pragma("unroll") for (int ai = 0; ai < 2; ++ai) _Pragma("unroll") for (int m = 0; m < 4; ++m) { const int row = row0 + ai * HALF + m * 16; \
    _Pragma("unroll") for (int bj = 0; bj < 2; ++bj) { const int cg = bj * HALF + wc * 32 + 8 * fq; const f32x4 v0 = acc[ai][bj][m][0], v1 = acc[ai][bj][m][1];
#define EPI_LOOP_END } }

struct EpiStore {
    static constexpr bool PERM = true, AFTER_DRAIN = false;
    bf16_t* O; int ldc;
    __device__ __forceinline__ void operator()(const f32x4 (&acc)[2][2][4][2], const Unit& u, int wr, int wc, int fr, int fq) const {
        EPI_LOOP_BEGIN
            { const u32x4 w_ = pack8(v0, v1); CHKW_S(8, w_.x + w_.y + w_.z + w_.w); *(u32x4*)(O + (size_t)row * ldc + u.pn * BM + cg) = w_; }
        EPI_LOOP_END
    }
};
struct EpiZ {
    static constexpr bool PERM = true, AFTER_DRAIN = false;
    bf16_t *cq, *ckv, *kpe, *kb, *vb, *kidx, *qb, *qidx; float* widx;
    __device__ __forceinline__ void operator()(const f32x4 (&acc)[2][2][4][2], const Unit& u, int wr, int wc, int fr, int fq) const {
        const int pn = u.pn;
        EPI_LOOP_BEGIN
            const u32x4 w = pack8(v0, v1); CHKW_S(9, w.x + w.y + w.z + w.w);
            if (pn == 0) *(u32x4*)(cq + (size_t)row * 256 + cg) = w;
            else if (pn == 1) {
                if (cg < 128) *(u32x4*)(ckv + (size_t)row * 128 + cg) = w;
                else if (cg < 160) *(u32x4*)(kpe + (size_t)row * 32 + (cg - 128)) = w;
                else if (cg < 224) *(u32x4*)(kb + (size_t)row * 64 + (cg - 160)) = w;
            } else if (pn == 2) {
                if (cg < 64) *(u32x4*)(vb + (size_t)row * 64 + cg) = w;
                else if (cg < 128) { const int d_ = cg - 64;
                    *(u32x4*)(kidx + ((size_t)((row >> 13) * 4 + (d_ >> 4)) * 8192 + (row & 8191)) * 16 + ((d_ >> 3) & 1) * 8) = w; }
                else if (cg < 136) { *(f32x4*)(widx + (size_t)row * 8) = v0; *(f32x4*)(widx + (size_t)row * 8 + 4) = v1; }
            } else if (pn < 5) *(u32x4*)(qb + (size_t)row * 512 + (pn - 3) * 256 + cg) = w;
            else *(u32x4*)(qidx + (size_t)row * 512 + (pn - 5) * 256 + cg) = w;
        EPI_LOOP_END
    }
};
struct EpiGate {
    static constexpr bool PERM = true, AFTER_DRAIN = false;
    bf16_t* G;
    __device__ __forceinline__ void operator()(const f32x4 (&acc)[2][2][4][2], const Unit& u, int wr, int wc, int fr, int fq) const {
        EPI_LOOP_BEGIN
            f32x4 a, b;
#pragma unroll
            for (int i = 0; i < 4; ++i) { a[i] = sigmoidf_(v0[i]); b[i] = sigmoidf_(v1[i]); }
            { const u32x4 w_ = pack8(a, b); CHKW_S(10, w_.x + w_.y + w_.z + w_.w); *(u32x4*)(G + (size_t)row * 2048 + u.pn * BM + cg) = w_; }
        EPI_LOOP_END
    }
};
template <int SECOND> struct EpiMerge {
    static constexpr bool PERM = true, AFTER_DRAIN = false;
    const bf16_t* G; bf16_t* Mo;
    __device__ __forceinline__ void operator()(const f32x4 (&acc)[2][2][4][2], const Unit& u, int wr, int wc, int fr, int fq) const {
        const int row0 = u.pm * BM + wr * 64 + fr;
#pragma unroll
        for (int ai = 0; ai < 2; ++ai) {
            u32x4 gq[4][2], mq[4][2];
#pragma unroll
            for (int m = 0; m < 4; ++m)
#pragma unroll
                for (int bj = 0; bj < 2; ++bj) { const int row = row0 + ai * HALF + m * 16, col = u.pn * BM + bj * HALF + wc * 32 + 8 * fq;
                    gq[m][bj] = *(const u32x4*)(G + (size_t)row * 2048 + SECOND * 1024 + col);
                    if (SECOND) mq[m][bj] = *(const u32x4*)(Mo + (size_t)row * 1024 + col); }
            asm volatile("" ::: "memory");
#pragma unroll
            for (int m = 0; m < 4; ++m)
#pragma unroll
                for (int bj = 0; bj < 2; ++bj) { const int row = row0 + ai * HALF + m * 16, col = u.pn * BM + bj * HALF + wc * 32 + 8 * fq;
                    f32x4 ga, gb; unpack8(gq[m][bj], ga, gb);
                    f32x4 a = ga * acc[ai][bj][m][0], b = gb * acc[ai][bj][m][1];
                    if (SECOND) { f32x4 pa, pb; unpack8(mq[m][bj], pa, pb); a = a + pa; b = b + pb; }
                    { const u32x4 w_ = pack8(a, b); CHKW_S(11, w_.x + w_.y + w_.z + w_.w); *(u32x4*)(Mo + (size_t)row * 1024 + col) = w_; } }
        }
    }
};
struct EpiX1 {
    static constexpr bool PERM = true, AFTER_DRAIN = false;
    const float* x; float* out; const float* fg; bf16_t* xb;
    __device__ __forceinline__ void operator()(const f32x4 (&acc)[2][2][4][2], const Unit& u, int wr, int wc, int fr, int fq) const {
        const int row0 = u.pm * BM + wr * 64 + fr;
        f32x4 gv[2][2];
#pragma unroll
        for (int bj = 0; bj < 2; ++bj) { const int cgl = u.pn * BM + bj * HALF + wc * 32 + 8 * fq; gv[bj][0] = *(const f32x4*)(fg + cgl); gv[bj][1] = *(const f32x4*)(fg + cgl + 4); }
#pragma unroll
        for (int ai = 0; ai < 2; ++ai) {
            f32x4 xq[4][2][2];
#pragma unroll
            for (int m = 0; m < 4; ++m)
#pragma unroll
                for (int bj = 0; bj < 2; ++bj) { const size_t off = (size_t)(row0 + ai * HALF + m * 16) * 1024 + u.pn * BM + bj * HALF + wc * 32 + 8 * fq;
                    xq[m][bj][0] = *(const f32x4*)(x + off); xq[m][bj][1] = *(const f32x4*)(x + off + 4); }
            asm volatile("" ::: "memory");
#pragma unroll
            for (int m = 0; m < 4; ++m)
#pragma unroll
                for (int bj = 0; bj < 2; ++bj) { const size_t off = (size_t)(row0 + ai * HALF + m * 16) * 1024 + u.pn * BM + bj * HALF + wc * 32 + 8 * fq;
                    const f32x4 r0_ = xq[m][bj][0] + acc[ai][bj][m][0], r1_ = xq[m][bj][1] + acc[ai][bj][m][1];
                    CHKW_S(12, __builtin_bit_cast(unsigned, r0_[0]) + __builtin_bit_cast(unsigned, r0_[1]) + __builtin_bit_cast(unsigned, r0_[2]) + __builtin_bit_cast(unsigned, r0_[3]) + __builtin_bit_cast(unsigned, r1_[0]) + __builtin_bit_cast(unsigned, r1_[1]) + __builtin_bit_cast(unsigned, r1_[2]) + __builtin_bit_cast(unsigned, r1_[3]));
                    *(f32x4*)(out + off) = r0_; *(f32x4*)(out + off + 4) = r1_;
                    *(u32x4*)(xb + off) = pack8(r0_ * gv[bj][0], r1_ * gv[bj][1]); }
        }
    }
};
struct EpiGU {
    static constexpr bool PERM = true, AFTER_DRAIN = false;
    bf16_t* act; const float* bgu; const float* rs;
    __device__ __forceinline__ void operator()(const f32x4 (&acc)[2][2][4][2], const Unit& u, int wr, int wc, int fr, int fq) const {
        typedef unsigned u32x2 __attribute__((ext_vector_type(2)));
        const int pnl = u.pn & 7, col = pnl * 128 + wc * 32 + 8 * fq;
        float rr[2][4]; f32x4 bgv[2], blv[2];
#pragma unroll
        for (int ai = 0; ai < 2; ++ai)
#pragma unroll
            for (int m = 0; m < 4; ++m) rr[ai][m] = rs[ai * HALF + wr * 64 + m * 16 + fr];
#pragma unroll
        for (int n = 0; n < 2; ++n) { bgv[n] = *(const f32x4*)(bgu + col + 4 * n); blv[n] = *(const f32x4*)(bgu + 1024 + col + 4 * n) + 1.f; }
        asm volatile("" ::: "memory");
#pragma unroll
        for (int n = 0; n < 2; ++n) {
            const f32x4 bg = bgv[n], bl = blv[n];
#pragma unroll
            for (int ai = 0; ai < 2; ++ai)
#pragma unroll
                for (int m = 0; m < 4; ++m) { const int row = ai * HALF + wr * 64 + m * 16 + fr; const float rq = rr[ai][m];
                    const f32x4 g = acc[ai][0][m][n] * rq + bg, l1 = acc[ai][1][m][n] * rq + bl; f32x4 o;
#pragma unroll
                    for (int i = 0; i < 4; ++i) { const float gl = fminf(g[i], 7.f), li1 = fminf(fmaxf(l1[i], -6.f), 8.f);
                        o[i] = gl * __builtin_amdgcn_rcpf(1.f + __builtin_amdgcn_exp2f(gl * (-1.702f * 1.4426950408889634f))) * li1; }
                    u32x2 w; w.x = cvt_pk_bf16(o[0], o[1]); w.y = cvt_pk_bf16(o[2], o[3]); CHKW_S(13, w.x + w.y);
                    *(u32x2*)(act + (size_t)row * 1024 + col + 4 * n) = w; }
        }
    }
};
struct EpiDown {
    static constexpr bool PERM = true, AFTER_DRAIN = false;
    bf16_t* ybuf; const float* bd; const int* rowtok;
    __device__ __forceinline__ void operator()(const f32x4 (&acc)[2][2][4][2], const Unit& u, int wr, int wc, int fr, int fq) const {
        const int pnl = u.pn & 3;
        int dstv[2][4]; f32x4 bv[2][2];
#pragma unroll
        for (int ai = 0; ai < 2; ++ai)
#pragma unroll
            for (int m = 0; m < 4; ++m) dstv[ai][m] = rowtok[ai * HALF + wr * 64 + m * 16 + fr];
#pragma unroll
        for (int bj = 0; bj < 2; ++bj) { const int col = pnl * BM + bj * HALF + wc * 32 + 8 * fq; bv[bj][0] = *(const f32x4*)(bd + col); bv[bj][1] = *(const f32x4*)(bd + col + 4); }
        asm volatile("" ::: "memory");
#pragma unroll
        for (int ai = 0; ai < 2; ++ai)
#pragma unroll
            for (int m = 0; m < 4; ++m) { const int dst = dstv[ai][m];
                if (dst >= 0) {
#pragma unroll
                    for (int bj = 0; bj < 2; ++bj) { const int col = pnl * BM + bj * HALF + wc * 32 + 8 * fq;
                        { const u32x4 w_ = pack8(acc[ai][bj][m][0] + bv[bj][0], acc[ai][bj][m][1] + bv[bj][1]); CHKW_S(14, w_.x + w_.y + w_.z + w_.w); *(u32x4*)(ybuf + (size_t)dst * 1024 + col) = w_; } } } }
    }
};
template <bool GATHER_> struct ListOrderT {
    static constexpr bool GATHER = GATHER_;
    int n, pn0, z; const int* rows;
    __device__ __forceinline__ bool next(int i, Unit& u) const { if (i >= n) return false; u.pm = 0; u.pn = pn0 + i; return true; }
    __device__ __forceinline__ int tid_bias() const { return z; }
    __device__ __forceinline__ void a_ready(const Unit&) const {}
    __device__ __forceinline__ void done(const Unit&) const {}
};
}
#define XB_TMO      128
#define XB_XCNT(j)  (256  + 64 * (j))
#define XB_XSUB(j)  (1280 + 64 * (j))
#define XB_XGEN(j)  (2304 + 64 * (j))
#define XB_TOP      3328
#define XB_TOPGEN   3392
#define XCD_BAR_WORDS 3456
#define XB_SPIN_CAP (1u << 18)

__device__ __forceinline__ unsigned xb_ld(unsigned* p)              { return __hip_atomic_load(p, __ATOMIC_RELAXED, __HIP_MEMORY_SCOPE_AGENT); }
__device__ __forceinline__ unsigned xb_add(unsigned* p, unsigned v) { return __hip_atomic_fetch_add(p, v, __ATOMIC_RELAXED, __HIP_MEMORY_SCOPE_AGENT); }
__device__ __forceinline__ unsigned xb_xcc_id() { return (unsigned)__builtin_amdgcn_s_getreg((3 << 11) | 20) & 0xFu; }
#define XB_SPIN(cond, bar) do { unsigned _sp = 0; while (cond) { __builtin_amdgcn_s_sleep(1); \
    if ((++_sp & 255u) == 0u) { if (xb_ld(&(bar)[XB_TMO])) break; if (_sp > XB_SPIN_CAP) { atomicAdd(&(bar)[XB_TMO], 1u); break; } } } } while (0)

struct XcdBarrier {
    unsigned* bar; unsigned x;
    volatile LAS unsigned* st;
};

__device__ __forceinline__ XcdBarrier xcd_barrier_post(unsigned* bar, volatile LAS unsigned* st) {
    XcdBarrier b; b.bar = bar; b.x = xb_xcc_id(); b.st = st;
    if (threadIdx.x == 0) (void)xb_add(&bar[XB_XCNT(b.x)], 1u);
    return b;
}
__device__ __forceinline__ void xcd_barrier_complete(unsigned* bar, unsigned x, unsigned& nloc, unsigned& nx) {
    const unsigned G = gridDim.x * gridDim.y * gridDim.z;
    unsigned sum, cnt, mine, sp = 0u;
    for (;;) {
        sum = 0u; cnt = 0u; mine = 0u;
#pragma unroll
        for (unsigned j = 0; j < 16; ++j) { const unsigned c = xb_ld(&bar[XB_XCNT(j)]); sum += c; cnt += (c > 0u) ? 1u : 0u; mine = (j == x) ? c : mine; }
        if (sum == G) break;
        __builtin_amdgcn_s_sleep(1);
        if ((++sp & 255u) == 0u) { if (xb_ld(&bar[XB_TMO])) break; if (sp > XB_SPIN_CAP) { atomicAdd(&bar[XB_TMO], 1u); break; } }
    }
    nloc = mine > 0u ? mine : 1u; nx = cnt > 0u ? cnt : 1u;
}

__device__ __forceinline__ void xcd_barrier(const XcdBarrier& b) {
    asm volatile("s_waitcnt vmcnt(0)" ::: "memory");
    __syncthreads();
    if (threadIdx.x == 0) {
        unsigned* bar = b.bar;
        __builtin_amdgcn_s_waitcnt(0);
        unsigned nloc = b.st[0], nx = b.st[1];
        if (nloc == 0u) { xcd_barrier_complete(bar, b.x, nloc, nx); b.st[0] = nloc; b.st[1] = nx; }
        const unsigned old = xb_add(&bar[XB_XSUB(b.x)], 1u);
        const unsigned gen = old / nloc;
        if (old + 1u == (gen + 1u) * nloc) {
            __builtin_amdgcn_fence(__ATOMIC_RELEASE, "agent");
            asm volatile("s_waitcnt vmcnt(0)" ::: "memory");
            const unsigned og = xb_add(&bar[XB_TOP], 1u);
            const unsigned tg = og / nx;
            if (og + 1u == (tg + 1u) * nx) xb_add(&bar[XB_TOPGEN], 1u);
            else XB_SPIN(xb_ld(&bar[XB_TOPGEN]) == tg, bar);
            __builtin_amdgcn_fence(__ATOMIC_ACQUIRE, "agent");
            xb_add(&bar[XB_XGEN(b.x)], 1u);
            asm volatile("s_waitcnt vmcnt(0)" ::: "memory");
        } else {
            XB_SPIN(xb_ld(&bar[XB_XGEN(b.x)]) == gen, bar);
            __builtin_amdgcn_fence(__ATOMIC_ACQUIRE, "agent");
            asm volatile("s_waitcnt vmcnt(0)" ::: "memory");
        }
    }
    __syncthreads();
}

struct Frame {
    LAS unsigned char* lds;
    volatile LAS unsigned* MISC;
    gu32* ctl;
    int tid, lane, wave;
    int vcu, G;
    unsigned char* ws;
    const float* x; const int* pos; float* out;
    const float *attn_g, *w_in, *qn_g, *w_uq, *kvn_g, *w_ukv, *w_ba, *w_bb, *w_out, *ffn_g, *r_w, *r_b, *w_gu, *b_gu, *w_d, *b_d, *fin_g;
};
#define WSP(T_, off) ((T_*)(F.ws + (off)))

__constant__ float c_inv16[8] = {1.000000000e+00f, 1.939227432e-01f, 3.760603070e-02f, 7.292664610e-03f, 1.414213562e-03f, 2.742481884e-04f, 5.318295734e-05f, 1.031338525e-05f};
__constant__ float c_inv32[16] = {1.000000000e+00f, 4.403665960e-01f, 1.939227432e-01f, 8.539710194e-02f, 3.760603070e-02f, 1.656044088e-02f, 7.292664610e-03f, 3.211446106e-03f,
                                  1.414213562e-03f, 6.227724371e-04f, 2.742481884e-04f, 1.207697351e-04f, 5.318295734e-05f, 2.341999971e-05f, 1.031338525e-05f, 4.541670478e-06f};

__device__ __forceinline__ int map_win(int n) {
    const int t = n >> 8, j = n & 255;
    if (t == 0) return j;
    if (t == 1) return j < 128 ? 256 + j : j < 160 ? 384 + (j - 128) : j < 224 ? 928 + (j - 160) : -1;
    if (t == 2) return j < 64 ? 992 + j : j < 128 ? 1568 + (j - 64) : j < 136 ? 1632 + (j - 128) : -1;
    if (t < 5) return 416 + (n - 768);
    return 1056 + (n - 1280);
}
__device__ __forceinline__ int map_gu(int n) { const int pn = n >> 8, bj = (n >> 7) & 1, cc = n & 127; return bj * 1024 + pn * 128 + cc; }
template <int MAP>
__device__ __forceinline__ void p0_item(const float* W, int ldw, int K, bf16* WT, int coff, LAS float* scr, int kb, int nb, int lane) {
    const int k0 = 64 * kb, n0 = 32 * nb, nn = n0 + (lane & 31);
    const int col = MAP == 1 ? map_win(nn) : MAP == 2 ? map_gu(nn) : nn + coff;
    float wv[32];
#pragma unroll
    for (int i = 0; i < 32; ++i) { const int kk = 2 * i + (lane >> 5); wv[i] = col >= 0 ? W[(size_t)(k0 + kk) * ldw + col] : 0.f; }
#pragma unroll
    for (int i = 0; i < 32; ++i) { const int kk = 2 * i + (lane >> 5); scr[kk * 33 + (lane & 31)] = wv[i]; }
    LDS_WAIT(); asm volatile("" ::: "memory");
    const int c = lane & 7;
#pragma unroll
    for (int j = 0; j < 4; ++j) { const int n = (lane >> 3) + 8 * j; const LAS float* s = scr + (8 * c) * 33 + n;
        v4u o; o.x = pk2(s[0 * 33], s[1 * 33]); o.y = pk2(s[2 * 33], s[3 * 33]); o.z = pk2(s[4 * 33], s[5 * 33]); o.w = pk2(s[6 * 33], s[7 * 33]);
        CHKW_S(4, o.x + o.y + o.z + o.w); *(GAS v4u*)(WT + (size_t)(n0 + n) * K + k0 + 8 * c) = o; }
    LDS_WAIT(); asm volatile("" ::: "memory");
}
__device__ __forceinline__ void rms_row_to_bf16(const float* xrow, const float* g, bf16* orow, int lane) {
    const GAS f32x4* xr = (const GAS f32x4*)xrow + lane; const GAS f32x4* gr = (const GAS f32x4*)g + lane;
    f32x4 v[4]; float s = 0.f;
#pragma unroll
    for (int j = 0; j < 4; ++j) { v[j] = xr[64 * j]; s += (v[j].x * v[j].x + v[j].y * v[j].y) + (v[j].z * v[j].z + v[j].w * v[j].w); }
    const float rstd = 1.f / sqrtf(wave_sum(s) * (1.f / 1024.f) + EPS);
    GAS unsigned long long* o8 = (GAS unsigned long long*)orow + lane;
#pragma unroll
    for (int j = 0; j < 4; ++j) { const f32x4 gg = gr[64 * j];
        const unsigned long long ov_ = (unsigned long long)pk2(v[j].x * rstd * gg.x, v[j].y * rstd * gg.y) | ((unsigned long long)pk2(v[j].z * rstd * gg.z, v[j].w * rstd * gg.w) << 32); CHKW_S(4, (unsigned)ov_ + (unsigned)(ov_ >> 32)); o8[64 * j] = ov_; }
}
__device__ __forceinline__ void sincos_rev(float ang, float& c, float& s) {
    double r = (double)ang * 0.15915494309189535; r -= __builtin_rint(r); const float rf = (float)r;
    s = __builtin_amdgcn_sinf(rf); c = __builtin_amdgcn_cosf(rf);
}
__device__ __forceinline__ void p0_prologue(Frame& F) {
    LAS float* scr = (LAS float*)(F.lds + F.wave * 16384);
    const int gw = F.vcu * NWAVES + F.wave, NGW = F.G * NWAVES;
    constexpr int I_GU = 32 * 16 * 64, I_D = 32 * 16 * 32, I_IN = 16 * 56, I_G = 16 * 64, I_UQ = 4 * 24, I_UKV = 2 * 32, I_BA = 8 * 32, I_BB = 8 * 32, I_OUT = 16 * 32;
    constexpr int NITEMS = I_GU + I_D + I_IN + I_G + I_UQ + I_UKV + I_BA + I_BB + I_OUT;
    for (int it = gw; it < NITEMS; it += NGW) {
        int r = it;
        if (r < I_GU) { const int e = r >> 10, q = r & 1023; p0_item<2>(F.w_gu + (size_t)e * 1024 * 2048, 2048, 1024, WSP(bf16, WS_WGU) + (size_t)e * 2048 * 1024, 0, scr, q >> 6, q & 63, F.lane); continue; } r -= I_GU;
        if (r < I_D) { const int e = r >> 9, q = r & 511; p0_item<0>(F.w_d + (size_t)e * 1024 * 1024, 1024, 1024, WSP(bf16, WS_WD) + (size_t)e * 1024 * 1024, 0, scr, q >> 5, q & 31, F.lane); continue; } r -= I_D;
        if (r < I_IN) { p0_item<1>(F.w_in, D_IN, 1024, WSP(bf16, WS_WIN), 0, scr, r / 56, r % 56, F.lane); continue; } r -= I_IN;
        if (r < I_G) { p0_item<0>(F.w_in, D_IN, 1024, WSP(bf16, WS_WG), 1640, scr, r >> 6, r & 63, F.lane); continue; } r -= I_G;
        if (r < I_UQ) { p0_item<0>(F.w_uq, 768, 256, WSP(bf16, WS_WUQ), 0, scr, r / 24, r % 24, F.lane); continue; } r -= I_UQ;
        if (r < I_UKV) { p0_item<0>(F.w_ukv, 1024, 128, WSP(bf16, WS_WUKV), 0, scr, r >> 5, r & 31, F.lane); continue; } r -= I_UKV;
        if (r < I_BA) { p0_item<0>(F.w_ba, 1024, 512, WSP(bf16, WS_WBA), 0, scr, r >> 5, r & 31, F.lane); continue; } r -= I_BA;
        if (r < I_BB) { p0_item<0>(F.w_bb, 1024, 512, WSP(bf16, WS_WBB), 0, scr, r >> 5, r & 31, F.lane); continue; } r -= I_BB;
        p0_item<0>(F.w_out, 1024, 1024, WSP(bf16, WS_WOUT), 0, scr, r >> 5, r & 31, F.lane);
    }
    for (int m = gw; m < T; m += NGW) rms_row_to_bf16(F.x + (size_t)m * D, F.attn_g, WSP(bf16, WS_H) + (size_t)m * D, F.lane);
    { const int gt = F.vcu * (NWAVES * 64) + F.tid, NGT = F.G * NWAVES * 64;
      f32x2* cs16 = WSP(f32x2, WS_CS16); f32x2* cs32 = WSP(f32x2, WS_CS32);
      for (int q = gt; q < T * 8; q += NGT) { const int t = q >> 3, i = q & 7; float c, s; sincos_rev((float)F.pos[t] * c_inv16[i], c, s); cs16[q] = (f32x2){c, s}; }
      for (int q = gt; q < T * 16; q += NGT) { const int t = q >> 4, i = q & 15; float c, s; sincos_rev((float)F.pos[t] * c_inv32[i], c, s); cs32[q] = (f32x2){c, s}; } }
}

__device__ __forceinline__ void p2_token_pass(Frame& F) {
    const int gw = F.vcu * NWAVES + F.wave, NGW = F.G * NWAVES, lane = F.lane;
    bf16 *cq = WSP(bf16, WS_CQ), *ckv = WSP(bf16, WS_CKV), *kpe = WSP(bf16, WS_KPE), *kb = WSP(bf16, WS_KB), *kidx = WSP(bf16, WS_KIDX), *qb = WSP(bf16, WS_QB), *qidx = WSP(bf16, WS_QIDX);
    const f32x2* cs16 = WSP(f32x2, WS_CS16); const f32x2* cs32 = WSP(f32x2, WS_CS32);
    const f32x4 gq = *((const GAS f32x4*)F.qn_g + lane); const f32x2 gk = *((const GAS f32x2*)F.kvn_g + lane);
    (void)gw; (void)NGW;
    for (int j = 0; j < 32; ++j) { const int t = (F.vcu >> 5) * SEQ + ((F.vcu & 31) * NWAVES + F.wave) + 256 * j;
        { GAS v2u* p = (GAS v2u*)(cq + (size_t)t * 256) + lane; const v2u w = *p;
          const float a = bflo(w.x), b = bfhi(w.x), c = bflo(w.y), d = bfhi(w.y);
          const float rstd = 1.f / sqrtf(wave_sum(a * a + b * b + c * c + d * d) * (1.f / 256.f) + EPS);
          v2u o; o.x = pk2(a * rstd * gq.x, b * rstd * gq.y); o.y = pk2(c * rstd * gq.z, d * rstd * gq.w); CHKW_S(5, o.x + o.y); *p = o; }
        { GAS unsigned* p = (GAS unsigned*)(ckv + (size_t)t * 128) + lane; const unsigned w = *p;
          const float a = bflo(w), b = bfhi(w);
          const float rstd = 1.f / sqrtf(wave_sum(a * a + b * b) * (1.f / 128.f) + EPS);
          { const unsigned ov_ = pk2(a * rstd * gk.x, b * rstd * gk.y); CHKW_S(5, ov_); *p = ov_; } }
        const f32x2 cs = cs16[(size_t)t * 8 + (lane & 7)];
        { bf16* p = qb + (size_t)t * 512 + (lane >> 3) * 64 + (lane & 7); const float x1 = bf2f(p[0]), x2 = bf2f(p[8]);
          { const unsigned a_ = f2bf(x1 * cs.x - x2 * cs.y), b_ = f2bf(x2 * cs.x + x1 * cs.y); CHKW_S(5, a_ + b_); p[0] = (bf16)a_; p[8] = (bf16)b_; } }
        { bf16* p = qidx + (size_t)t * 512 + (lane >> 3) * 64 + (lane & 7); const float x1 = bf2f(p[0]), x2 = bf2f(p[8]);
          { const unsigned a_ = f2bf(x1 * cs.x - x2 * cs.y), b_ = f2bf(x2 * cs.x + x1 * cs.y); CHKW_S(5, a_ + b_); p[0] = (bf16)a_; p[8] = (bf16)b_; } }
        if (lane < 8) { bf16* p = kb + (size_t)t * 64 + lane; const float x1 = bf2f(p[0]), x2 = bf2f(p[8]);
          { const unsigned a_ = f2bf(x1 * cs.x - x2 * cs.y), b_ = f2bf(x2 * cs.x + x1 * cs.y); CHKW_S(5, a_ + b_); p[0] = (bf16)a_; p[8] = (bf16)b_; } }
        else if (lane < 16) { bf16* p = kidx + ((size_t)((t >> 13) * 4) * 8192 + (t & 8191)) * 16 + (lane - 8); const float x1 = bf2f(p[0]), x2 = bf2f(p[8]);
          { const unsigned a_ = f2bf(x1 * cs.x - x2 * cs.y), b_ = f2bf(x2 * cs.x + x1 * cs.y); CHKW_S(5, a_ + b_); p[0] = (bf16)a_; p[8] = (bf16)b_; } }
        else if (lane < 32) { const int i = lane - 16; const f32x2 c2 = cs32[(size_t)t * 16 + i]; bf16* p = kpe + (size_t)t * 32 + i; const float x1 = bf2f(p[0]), x2 = bf2f(p[16]);
          { const unsigned a_ = f2bf(x1 * c2.x - x2 * c2.y), b_ = f2bf(x2 * c2.x + x1 * c2.y); CHKW_S(5, a_ + b_); p[0] = (bf16)a_; p[16] = (bf16)b_; } }
    }
}

namespace mla {
#ifndef MLA_FASTPATH
#define MLA_FASTPATH 1
#endif
constexpr int KPITCH = 208, KBUF = 64 * KPITCH, VBUF = 8192, BUFB = 2 * (KBUF + VBUF), LDS_WSF = 2 * BUFB, LDS_OST = LDS_WSF + 8 * 256, LDS_BYTES_USED = LDS_OST + 8 * 4096;
constexpr float QSCALE = 0.10206207261596575f * 1.4426950408889634f;
typedef short v4i16_t __attribute__((ext_vector_type(4)));
__device__ __forceinline__ int crow(int r, int hi) { return (r & 3) + 8 * (r >> 2) + 4 * hi; }
__device__ __forceinline__ s16x4 vtr(const LAS unsigned char* p) { return __builtin_bit_cast(s16x4, __builtin_amdgcn_ds_read_tr16_b64_v4i16((LAS v4i16_t*)p)); }
__device__ __forceinline__ unsigned cvtpk(float lo, float hi) { typedef float f2 __attribute__((ext_vector_type(2))); typedef __bf16 b2 __attribute__((ext_vector_type(2)));
    f2 v = {lo, hi}; b2 b = __builtin_convertvector(v, b2); return __builtin_bit_cast(unsigned, b); }

__device__ __forceinline__ float mla_halfmax(float x, float pinf) { const unsigned u = __builtin_bit_cast(unsigned, x); auto r = __builtin_amdgcn_permlane32_swap(u, u, false, false);
    return __builtin_amdgcn_fmed3f(__builtin_bit_cast(float, r[0]), __builtin_bit_cast(float, r[1]), pinf); }
template <int VAR> __device__ __forceinline__ void unit(int zb, int b, int h, int qb, const bf16* qmla, const bf16* kv, const bf16* kpe, const f32x2* cs32, bf16* ya, LAS unsigned char* shm) {
    int tid = zb; asm volatile("" : "+v"(tid));
    float pinf = INFINITY; asm volatile("" : "+s"(pinf));
    const int lane = tid & 63, r32 = lane & 31, hi = lane >> 5; const int wid = __builtin_amdgcn_readfirstlane(tid >> 6);
    const size_t rowbase = (size_t)b * SEQ; const int q0 = qb * 256;
    LAS float* wsf = (LAS float*)(shm + LDS_WSF) + wid * 64;
    bf16x8 qr[6];
    { const size_t tq = rowbase + q0 + wid * 32 + r32; const bf16* Qrow = qmla + tq * 768 + h * 96 + 8 * hi;
      v4u raw[6];
#pragma unroll
      for (int d0 = 0; d0 < 6; ++d0) raw[d0] = *(const GAS v4u*)(Qrow + 16 * d0);
      const GAS f32x4* csp = (const GAS f32x4*)(cs32 + tq * 16 + 8 * hi);
      f32x4 cs[4];
#pragma unroll
      for (int i = 0; i < 4; ++i) cs[i] = csp[i];
#pragma unroll
      for (int d0 = 0; d0 < 4; ++d0) { v4u o;
#pragma unroll
          for (int w = 0; w < 4; ++w) o[w] = cvtpk(bflo(raw[d0][w]) * QSCALE, bfhi(raw[d0][w]) * QSCALE);
          qr[d0] = __builtin_bit_cast(bf16x8, o); }
      v4u o4, o5;
#pragma unroll
      for (int w = 0; w < 4; ++w) {
          const float a0 = bflo(raw[4][w]), a1 = bfhi(raw[4][w]), b0 = bflo(raw[5][w]), b1 = bfhi(raw[5][w]);
          const float c0 = cs[w][0], s0 = cs[w][1], c1 = cs[w][2], s1 = cs[w][3];
          o4[w] = cvtpk((a0 * c0 - b0 * s0) * QSCALE, (a1 * c1 - b1 * s1) * QSCALE);
          o5[w] = cvtpk((b0 * c0 + a0 * s0) * QSCALE, (b1 * c1 + a1 * s1) * QSCALE); }
      qr[4] = __builtin_bit_cast(bf16x8, o4); qr[5] = __builtin_bit_cast(bf16x8, o5); }
    const bf16* kn_src = kv + (rowbase + (tid >> 3)) * 1024 + h * 128 + (tid & 7) * 8;
    const bf16* vv_src = kn_src + 64;
    const bf16* kr_src = kpe + (rowbase + ((tid & 255) >> 2)) * 32 + (tid & 3) * 8;
    const int kn_dst = (tid >> 3) * KPITCH + (tid & 7) * 16, kr_dst = ((tid & 255) >> 2) * KPITCH + 128 + (tid & 3) * 16;
    const int vv_dst = ((tid & 7) >> 2) * 4096 + (tid >> 3) * 64 + (tid & 3) * 16;
    const bool has_kr = tid < 256;
    v4u sk[2], sr[2] = {{0u, 0u, 0u, 0u}, {0u, 0u, 0u, 0u}}, sv[2];
#define MLA_LOAD(st) do { _Pragma("unroll") for (int u_ = 0; u_ < 2; ++u_) { const size_t t_ = (size_t)(2 * (st) + u_); sk[u_] = *(const GAS v4u*)(kn_src + t_ * 64 * 1024); sv[u_] = *(const GAS v4u*)(vv_src + t_ * 64 * 1024); if (has_kr) sr[u_] = *(const GAS v4u*)(kr_src + t_ * 64 * 32); } } while (0)
#define MLA_WRITE(buf) do { LAS unsigned char* B_ = shm + (buf) * BUFB; _Pragma("unroll") for (int u_ = 0; u_ < 2; ++u_) { *(LAS v4u*)(B_ + u_ * KBUF + kn_dst) = sk[u_]; *(LAS v4u*)(B_ + 2 * KBUF + u_ * VBUF + vv_dst) = sv[u_]; if (has_kr) *(LAS v4u*)(B_ + u_ * KBUF + kr_dst) = sr[u_]; } } while (0)
    const int NT = 4 * (qb + 1);
    float m_run = 0.f, l_run = 0.f; f32x16 o[2]; o[0] = f32x16{}; o[1] = f32x16{}; f32x16 minit = f32x16{};
    const int kread = r32 * KPITCH + hi * 16;
    const int vread = ((lane >> 4) & 1) * 32 + (lane & 3) * 8 + (4 * hi + ((lane & 15) >> 2)) * 64;
#define MLA_BAR() do { LDS_WAIT(); __builtin_amdgcn_s_barrier(); asm volatile("" ::: "memory"); } while (0)
#define MLA_QK(cur, u, P0, P1) do { const LAS unsigned char* Kb_ = shm + (cur) * BUFB + (u) * KBUF; P0 = f32x16{}; P1 = f32x16{}; \
            _Pragma("unroll") for (int d0 = 0; d0 < 6; ++d0) { \
                const bf16x8 k0f = *(const LAS bf16x8*)(Kb_ + kread + d0 * 32), k1f = *(const LAS bf16x8*)(Kb_ + kread + 32 * KPITCH + d0 * 32); \
                P0 = __builtin_amdgcn_mfma_f32_32x32x16_bf16(k0f, qr[d0], P0, 0, 0, 0); \
                P1 = __builtin_amdgcn_mfma_f32_32x32x16_bf16(k1f, qr[d0], P1, 0, 0, 0); } } while (0)
#define MLA_MX2(a, b) __builtin_amdgcn_fmed3f((a), (b), pinf)
#define MLA_HALFMAX(X) mla_halfmax(X, pinf)
#define MLA_MAX(P0, P1, MX) do { _Pragma("unroll") for (int r = 0; r < 16; ++r) MX = MLA_MX2(MX, MLA_MX2(P0[r], P1[r])); } while (0)
#define MLA_EXP0(P0, P1, LS) do { _Pragma("unroll") for (int r = 0; r < 16; ++r) { P0[r] = __builtin_amdgcn_exp2f(P0[r]); P1[r] = __builtin_amdgcn_exp2f(P1[r]); LS += P0[r] + P1[r]; } } while (0)
#define MLA_EXP(P0, P1, MN, LS) do { _Pragma("unroll") for (int r = 0; r < 16; ++r) { P0[r] = __builtin_amdgcn_exp2f(P0[r] - MN); P1[r] = __builtin_amdgcn_exp2f(P1[r] - MN); LS += P0[r] + P1[r]; } } while (0)
#define MLA_RESCALE(ALPHA) do { if (__any(ALPHA != 1.f)) { if (hi == 0) wsf[r32] = ALPHA; LDS_WAIT(); \
            _Pragma("unroll") for (int g = 0; g < 4; ++g) { const f32x4 f = *(const LAS f32x4*)(wsf + 8 * g + 4 * hi); \
                _Pragma("unroll") for (int i = 0; i < 4; ++i) { o[0][4 * g + i] *= f[i]; o[1][4 * g + i] *= f[i]; } } } } while (0)
#define MLA_LDV(i) do { vq[i][0] = vtr(Vb_ + vread + ((i) & 1) * 4096 + ((i) >> 1) * 1024); vq[i][1] = vtr(Vb_ + vread + ((i) & 1) * 4096 + ((i) >> 1) * 1024 + 512); } while (0)
#define MLA_PV(cur, u, P0, P1) do { const LAS unsigned char* Vb_ = shm + (cur) * BUFB + 2 * KBUF + (u) * VBUF; v4u pw[4]; s16x4 vq[8][2];        \
            MLA_LDV(0); MLA_LDV(1); MLA_LDV(2); MLA_LDV(3); \
            _Pragma("unroll") for (int w = 0; w < 4; ++w) { pw[0][w] = cvtpk(P0[2 * w], P0[2 * w + 1]); pw[1][w] = cvtpk(P0[8 + 2 * w], P0[9 + 2 * w]); pw[2][w] = cvtpk(P1[2 * w], P1[2 * w + 1]); pw[3][w] = cvtpk(P1[8 + 2 * w], P1[9 + 2 * w]); } \
            _Pragma("unroll") for (int i = 0; i < 8; ++i) { \
                const bf16x8 vf = {vq[i][0][0], vq[i][0][1], vq[i][0][2], vq[i][0][3], vq[i][1][0], vq[i][1][1], vq[i][1][2], vq[i][1][3]}; \
                o[i & 1] = __builtin_amdgcn_mfma_f32_32x32x16_bf16(__builtin_bit_cast(bf16x8, pw[i >> 1]), vf, o[i & 1], 0, 0, 0); \
                if (i + 4 < 8) MLA_LDV(i + 4); } \
            __builtin_amdgcn_sched_group_barrier(0x100, 8, 0); \
            _Pragma("unroll") for (int i_ = 0; i_ < 4; ++i_) { __builtin_amdgcn_sched_group_barrier(0x008, 1, 0); __builtin_amdgcn_sched_group_barrier(0x100, 2, 0); } \
            __builtin_amdgcn_sched_group_barrier(0x008, 4, 0); } while (0)
#define MLA_LDK(d) do { kq[d][0] = *(const LAS bf16x8*)(Kb_ + kread + (d) * 32); kq[d][1] = *(const LAS bf16x8*)(Kb_ + kread + 32 * KPITCH + (d) * 32); \
            kq[d][2] = *(const LAS bf16x8*)(Kb_ + KBUF + kread + (d) * 32); kq[d][3] = *(const LAS bf16x8*)(Kb_ + KBUF + kread + 32 * KPITCH + (d) * 32); } while (0)
#define MLA_QK4(cur) do { const LAS unsigned char* Kb_ = shm + (cur) * BUFB; bf16x8 kq[6][4];        \
            MLA_LDK(0); MLA_LDK(1); \
            _Pragma("unroll") for (int d0 = 0; d0 < 6; ++d0) { \
                a0 = __builtin_amdgcn_mfma_f32_32x32x16_bf16(kq[d0][0], qr[d0], d0 ? a0 : minit, 0, 0, 0); a1 = __builtin_amdgcn_mfma_f32_32x32x16_bf16(kq[d0][1], qr[d0], d0 ? a1 : minit, 0, 0, 0); \
                b0 = __builtin_amdgcn_mfma_f32_32x32x16_bf16(kq[d0][2], qr[d0], d0 ? b0 : minit, 0, 0, 0); b1 = __builtin_amdgcn_mfma_f32_32x32x16_bf16(kq[d0][3], qr[d0], d0 ? b1 : minit, 0, 0, 0); \
                if (d0 + 2 < 6) MLA_LDK(d0 + 2); } \
            __builtin_amdgcn_sched_group_barrier(0x100, 8, 0); \
            _Pragma("unroll") for (int i_ = 0; i_ < 4; ++i_) { __builtin_amdgcn_sched_group_barrier(0x008, 4, 0); __builtin_amdgcn_sched_group_barrier(0x100, 4, 0); } \
            __builtin_amdgcn_sched_group_barrier(0x008, 8, 0); } while (0)
#define MLA_QKPART(P_) do { const int cur_ = (P_) & 1; if (VAR & 1) { a0 = a1 = b0 = b1 = f32x16{}; } else { MLA_QK4(cur_); } \
            if (2 * (P_) + 1 >= NT - 4) { const int qq0 = wid * 32 + r32 - (2 * (P_) - (NT - 4)) * 64, qq1 = qq0 - 64;        \
                _Pragma("unroll") for (int r = 0; r < 16; ++r) { const int kr_ = crow(r, hi); \
                    if (kr_ > qq0) a0[r] = -INFINITY; if (kr_ + 32 > qq0) a1[r] = -INFINITY; if (kr_ > qq1) b0[r] = -INFINITY; if (kr_ + 32 > qq1) b1[r] = -INFINITY; } } \
            float mx = -INFINITY; MLA_MAX(a0, a1, mx); MLA_MAX(b0, b1, mx); mx = MLA_HALFMAX(mx); \
              \
            const bool up_ = ((P_) == 0) || mx > 8.f; alpha = 1.f; \
            if (__any(up_)) { const float d_ = up_ ? mx : 0.f; \
                _Pragma("unroll") for (int r = 0; r < 16; ++r) { a0[r] -= d_; a1[r] -= d_; b0[r] -= d_; b1[r] -= d_; } \
                alpha = ((P_) == 0) ? 1.f : __builtin_amdgcn_exp2f(-d_); m_run += d_; \
                _Pragma("unroll") for (int r = 0; r < 16; ++r) minit[r] = -m_run; } } while (0)
#define MLA_EXPPV(P_) do { const int cur_ = (P_) & 1; float ls = 0.f; if (!(VAR & 2)) { MLA_EXP0(a0, a1, ls); MLA_EXP0(b0, b1, ls); } l_run = l_run * alpha + ls; \
            MLA_RESCALE(alpha); if (!(VAR & 4)) { MLA_PV(cur_, 0, a0, a1); MLA_PV(cur_, 1, b0, b1); } } while (0)
    const int NS = NT / 2; const bool grpB = wid >= 4;
    float alpha = 1.f; f32x16 a0, a1, b0, b1;
    MLA_LOAD(0); MLA_WRITE(0);
    MLA_BAR();
    if (grpB) { if (1 < NS) MLA_LOAD(1); MLA_BAR(); }
#pragma unroll 1
    for (int p = 0; p < NS; ++p) {
        const bool more = p + 1 < NS;
        if (!grpB && more) MLA_LOAD(p + 1);
#ifdef MLA_PRIO
        __builtin_amdgcn_s_setprio(MLA_PRIO);
#endif
        MLA_QKPART(p);
#ifdef MLA_PRIO
        __builtin_amdgcn_s_setprio(0);
#endif
        if (grpB && more) MLA_WRITE((p + 1) & 1);
        MLA_BAR();
        if (grpB && p + 2 < NS) MLA_LOAD(p + 2);
#ifdef MLA_PRIO_E
        __builtin_amdgcn_s_setprio(MLA_PRIO_E);
#endif
        MLA_EXPPV(p);
#ifdef MLA_PRIO_E
        __builtin_amdgcn_s_setprio(0);
#endif
        if (!grpB && more) MLA_WRITE((p + 1) & 1);
        MLA_BAR();
    }
    if (!grpB) MLA_BAR();
#undef MLA_QKPART
#undef MLA_QK4
#undef MLA_LDK
#undef MLA_EXPPV
#undef MLA_BAR
#undef MLA_LOAD
#undef MLA_WRITE
#undef MLA_QK
#undef MLA_MAX
#undef MLA_HALFMAX
#undef MLA_MX2
#undef MLA_EXP
#undef MLA_EXP0
#undef MLA_RESCALE
#undef MLA_PV
#undef MLA_LDV
    l_run += __shfl_xor(l_run, 32);
    if (hi == 0) wsf[32 + r32] = 1.f / l_run;
    LDS_WAIT();
    { LAS unsigned short* stg = (LAS unsigned short*)(shm + LDS_OST) + wid * 2048;
#pragma unroll
      for (int g = 0; g < 4; ++g) { const f32x4 f = *(const LAS f32x4*)(wsf + 32 + 8 * g + 4 * hi);
#pragma unroll
          for (int i = 0; i < 4; ++i) { const int r = 4 * g + i; LAS unsigned short* sp = stg + crow(r, hi) * 64 + r32;
              sp[0] = (unsigned short)f2bf(o[0][r] * f[i]); sp[32] = (unsigned short)f2bf(o[1][r] * f[i]); } }
      LDS_WAIT();
      bf16* Ow = ya + (rowbase + q0 + wid * 32) * 512 + h * 64;
#pragma unroll
      for (int i = 0; i < 4; ++i) { const int row = i * 8 + (lane >> 3), ch = lane & 7;
          { const v4u w_ = *(const LAS v4u*)(stg + row * 64 + ch * 8); CHKW_S(2, w_.x + w_.y + w_.z + w_.w); *(GAS v4u*)(Ow + (size_t)row * 512 + ch * 8) = w_; } } }
    LDS_WAIT();
    __syncthreads();
}
template <int VAR> __device__ __forceinline__ void phase(int zb, int vcu, const bf16* qmla, const bf16* kv, const bf16* kpe, const f32x2* cs32, bf16* ya, LAS unsigned char* shm) {
    const int bh = vcu >> 2, s = vcu & 3;
#pragma unroll 1
    for (int i = 0; i < 8; ++i) { const int qb = (i & 1) ? (8 * (i >> 1) + 7 - s) : (8 * (i >> 1) + s);
        unit<VAR>(zb, bh >> 3, bh & 7, qb, qmla, kv, kpe, cs32, ya, shm); }
}
}

namespace dsa {
#ifndef DSA_CAP
#define DSA_CAP 512
#endif
constexpr int CAP = DSA_CAP;
constexpr int L_SC = 0, L_HIST = 131072, L_MM = L_HIST + 4096, L_BITMAP = L_MM + 256, L_SEL = L_BITMAP + 4096, L_CAND = L_SEL + 2048, LDS_BYTES_USED = L_CAND + 4 * CAP * 8;
constexpr int L_BIG = 0, VW_BYTES = 10240, L_COMB = 8 * VW_BYTES;
static_assert(L_COMB + 4 * 64 * 20 * 4 <= L_HIST, "attention scratch inside the score region");
typedef short v4i16_t __attribute__((ext_vector_type(4)));
__device__ __forceinline__ s16x4 vtr(const LAS unsigned char* p) { return __builtin_bit_cast(s16x4, __builtin_amdgcn_ds_read_tr16_b64_v4i16((LAS v4i16_t*)p)); }
__device__ __forceinline__ unsigned ordk(float f) { const unsigned u = __builtin_bit_cast(unsigned, f); return u ^ ((u >> 31) ? 0xFFFFFFFFu : 0x80000000u); }
__device__ __forceinline__ float unordk(unsigned k) { return __builtin_bit_cast(float, (k & 0x80000000u) ? (k ^ 0x80000000u) : ~k); }
constexpr unsigned SC_MASKED = 0x7FC00000u;
__device__ __forceinline__ unsigned key_or0(unsigned raw) { return raw == SC_MASKED ? 0u : ordk(__builtin_bit_cast(float, raw)); }
__device__ __forceinline__ unsigned cvtpk(float lo, float hi) { typedef float f2 __attribute__((ext_vector_type(2))); typedef __bf16 b2 __attribute__((ext_vector_type(2)));
    f2 v = {lo, hi}; b2 b = __builtin_convertvector(v, b2); return __builtin_bit_cast(unsigned, b); }
__device__ __forceinline__ unsigned wave_incl_scan(unsigned x) { int v = (int)x;
    v += __builtin_amdgcn_update_dpp(0, v, 0x111, 0xf, 0xf, false); v += __builtin_amdgcn_update_dpp(0, v, 0x112, 0xf, 0xf, false);
    v += __builtin_amdgcn_update_dpp(0, v, 0x114, 0xf, 0xf, false); v += __builtin_amdgcn_update_dpp(0, v, 0x118, 0xf, 0xf, false);
    v += __builtin_amdgcn_update_dpp(0, v, 0x142, 0xa, 0xf, false); v += __builtin_amdgcn_update_dpp(0, v, 0x143, 0xc, 0xf, false);
    return (unsigned)v; }
#define DSA_BAR() do { LDS_WAIT(); __builtin_amdgcn_s_barrier(); asm volatile("" ::: "memory"); } while (0)
#ifndef DSA_REP_D
#define DSA_REP_D 1
#endif

__device__ __forceinline__ void quad(int zb, int b, int p0, int nb, int np0, const bf16* qidx, const bf16* kidx, const float* widx, const bf16* qb, const bf16* kb, const bf16* vb, bf16* yb, LAS unsigned char* shm) {
    int tid = zb; asm volatile("" : "+v"(tid));
    const int lane = tid & 63, c = lane & 31, hi = lane >> 5; const int wid = __builtin_amdgcn_readfirstlane(tid >> 6);
    const size_t tokbase = (size_t)b * SEQ;
    LAS unsigned* sc = (LAS unsigned*)(shm + L_SC); LAS unsigned* hist = (LAS unsigned*)(shm + L_HIST); LAS unsigned* mm = (LAS unsigned*)(shm + L_MM); LAS unsigned* bitmap = (LAS unsigned*)(shm + L_BITMAP);
    LAS unsigned short* sel = (LAS unsigned short*)(shm + L_SEL); LAS v2u* cand = (LAS v2u*)(shm + L_CAND);
    const int ntile = (p0 + 4 + 31) >> 5, nk32 = ntile * 32;
    for (int i = tid; i < 1024; i += 512) { hist[i] = 0u; bitmap[i] = 0u; }
    if (tid < 64) mm[tid] = ((tid >= 4 && tid < 8) || (tid >= 36 && tid < 40)) ? 0xFFFFFFFFu : 0u;
    {
        const int qi_a = 2 * ((c >> 2) & 1) + (c >> 4), head_a = (c & 3) | (((c >> 3) & 1) << 2);
        const bf16* qsrc = qidx + (tokbase + p0 + qi_a) * 512 + head_a * 64 + 8 * hi;
        bf16x8 aq[4];
#pragma unroll
        for (int d0 = 0; d0 < 4; ++d0) aq[d0] = __builtin_bit_cast(bf16x8, *(const GAS v4u*)(qsrc + 16 * d0));
        float wf[16];
#pragma unroll
        for (int j = 0; j < 2; ++j) { const GAS f32x4* wp = (const GAS f32x4*)(widx + (tokbase + p0 + 2 * hi + j) * 8);
            const f32x4 a = wp[0], bb = wp[1];
#pragma unroll
            for (int i = 0; i < 4; ++i) { wf[8 * j + i] = a[i] * (0.35355339059327373f * 0.125f); wf[8 * j + 4 + i] = bb[i] * (0.35355339059327373f * 0.125f); } }
        const GAS unsigned char* kb0 = (const GAS unsigned char*)(kidx + (size_t)b * 4 * 8192 * 16);
        const unsigned hoff = 16u * (unsigned)hi;
        const GAS unsigned char* kb1 = kb0 + 262144, *kb2 = kb0 + 2 * 262144, *kb3 = kb0 + 3 * 262144;
        asm volatile("" : "+s"(kb0), "+s"(kb1), "+s"(kb2), "+s"(kb3));
        float pinf = INFINITY, ninf = -INFINITY; asm volatile("" : "+s"(pinf), "+s"(ninf));
        float mxf0 = -INFINITY, mxf1 = -INFINITY, mnf0 = INFINITY, mnf1 = INFINITY;
        v4u kf[3][4];
#define DSA_KLOAD(S, T) do { int key_ = (T) * 32 + c; key_ = key_ < SEQ ? key_ : SEQ - 1; const unsigned off_ = (unsigned)key_ * 32u + hoff; \
            kf[S][0] = *(const GAS v4u*)(kb0 + off_); kf[S][1] = *(const GAS v4u*)(kb1 + off_); kf[S][2] = *(const GAS v4u*)(kb2 + off_); kf[S][3] = *(const GAS v4u*)(kb3 + off_); } while (0)
#define DSA_RELU(x) __builtin_amdgcn_fmed3f((x), 0.f, pinf)
#define DSA_KCOMP(S, T) do { if ((T) < ntile) { const int key = (T) * 32 + c; f32x16 acc = f32x16{}; \
            _Pragma("unroll") for (int d0 = 0; d0 < 4; ++d0) acc = __builtin_amdgcn_mfma_f32_32x32x16_bf16(aq[d0], __builtin_bit_cast(bf16x8, kf[S][d0]), acc, 0, 0, 0); \
            float s0a = wf[0] * DSA_RELU(acc[0]), s0b = wf[4] * DSA_RELU(acc[4]), s1a = wf[8] * DSA_RELU(acc[8]), s1b = wf[12] * DSA_RELU(acc[12]); \
            _Pragma("unroll") for (int r = 1; r < 4; ++r) { s0a += wf[r] * DSA_RELU(acc[r]); s0b += wf[4 + r] * DSA_RELU(acc[4 + r]); s1a += wf[8 + r] * DSA_RELU(acc[8 + r]); s1b += wf[12 + r] * DSA_RELU(acc[12 + r]); } \
            const float s0 = (s0a + s0b) + 0.f, s1 = (s1a + s1b) + 0.f;        \
            const bool v0_ = key <= p0 + 2 * hi, v1_ = key <= p0 + 2 * hi + 1; \
            sc[(2 * hi) * 8192 + key] = v0_ ? __builtin_bit_cast(unsigned, s0) : SC_MASKED; sc[(2 * hi + 1) * 8192 + key] = v1_ ? __builtin_bit_cast(unsigned, s1) : SC_MASKED; \
            mxf0 = __builtin_amdgcn_fmed3f(mxf0, v0_ ? s0 : -INFINITY, pinf); mnf0 = __builtin_amdgcn_fmed3f(mnf0, v0_ ? s0 : INFINITY, ninf); \
            mxf1 = __builtin_amdgcn_fmed3f(mxf1, v1_ ? s1 : -INFINITY, pinf); mnf1 = __builtin_amdgcn_fmed3f(mnf1, v1_ ? s1 : INFINITY, ninf); } } while (0)
#ifndef DSA_REP_A
#define DSA_REP_A 1
#endif
        _Pragma("unroll") for (int repA = 0; repA < DSA_REP_A; ++repA) {
        DSA_KLOAD(0, wid); DSA_KLOAD(1, wid + 8); DSA_KLOAD(2, wid + 16);
#pragma unroll 1
        for (int t = wid; t < ntile; t += 24) {
            DSA_KCOMP(0, t);      DSA_KLOAD(0, t + 24);
            DSA_KCOMP(1, t + 8);  DSA_KLOAD(1, t + 32);
            DSA_KCOMP(2, t + 16); DSA_KLOAD(2, t + 40);
        }
        }
#undef DSA_KLOAD
#undef DSA_KCOMP
#undef DSA_RELU
        const unsigned mx0 = mxf0 == -INFINITY ? 0u : ordk(mxf0), mx1 = mxf1 == -INFINITY ? 0u : ordk(mxf1), mn0 = mnf0 == INFINITY ? 0xFFFFFFFFu : ordk(mnf0), mn1 = mnf1 == INFINITY ? 0xFFFFFFFFu : ordk(mnf1);
        DSA_BAR();
        if (mx0) { __hip_atomic_fetch_max(&mm[2 * hi], mx0, __ATOMIC_RELAXED, __HIP_MEMORY_SCOPE_WORKGROUP); __hip_atomic_fetch_min(&mm[4 + 2 * hi], mn0, __ATOMIC_RELAXED, __HIP_MEMORY_SCOPE_WORKGROUP); }
        if (mx1) { __hip_atomic_fetch_max(&mm[2 * hi + 1], mx1, __ATOMIC_RELAXED, __HIP_MEMORY_SCOPE_WORKGROUP); __hip_atomic_fetch_min(&mm[5 + 2 * hi], mn1, __ATOMIC_RELAXED, __HIP_MEMORY_SCOPE_WORKGROUP); }
        __hip_atomic_fetch_min(&mm[36 + 2 * hi], mx0, __ATOMIC_RELAXED, __HIP_MEMORY_SCOPE_WORKGROUP); __hip_atomic_fetch_min(&mm[37 + 2 * hi], mx1, __ATOMIC_RELAXED, __HIP_MEMORY_SCOPE_WORKGROUP);
    }
    DSA_BAR();
    v4u pf_ = {0u, 0u, 0u, 0u}, pf2_ = {0u, 0u, 0u, 0u};
    if (nb >= 0) { const size_t ntok = (size_t)nb * SEQ + np0;
        pf_ = *(const GAS v4u*)((tid < 256 ? qidx : qb) + ntok * 512 + (size_t)(tid & 255) * 8);
        if (tid < 8) pf2_ = *(const GAS v4u*)(widx + ntok * 8 + tid * 4); }
    float basef[4], scl[4];
#pragma unroll
    for (int q = 0; q < 4; ++q) { const unsigned mxk = mm[q], lm = mm[36 + q]; unsigned mnk = mm[4 + q]; const unsigned l0 = lm > 1u ? lm : 1u; mnk = mnk > l0 ? mnk : l0;
        const float a = unordk(mxk), bq_ = unordk(mnk);
        basef[q] = (mxk && mnk != 0xFFFFFFFFu) ? bq_ : 0.f; scl[q] = (mxk && a > bq_) ? 255.99f / (a - bq_) : 1.f; }
#ifndef DSA_REP_SEL
#define DSA_REP_SEL 1
#endif
    for (int repS = 0; repS < DSA_REP_SEL; ++repS) {
    if (repS > 0) { DSA_BAR(); for (int i = tid; i < 1024; i += 512) { hist[i] = 0u; bitmap[i] = 0u; } if (tid < 4) mm[8 + tid] = 0u; DSA_BAR(); }
#ifndef DSA_REP_S2
#define DSA_REP_S2 1
#endif
#ifndef DSA_REP_S4
#define DSA_REP_S4 1
#endif
    v4u vva_[4][4];
    _Pragma("unroll") for (int rp2 = DSA_REP_S2 - 1; rp2 >= 0; --rp2) { LAS unsigned* hist_ = rp2 ? (LAS unsigned*)cand : hist;
    LAS unsigned char* hq_[4];
#pragma unroll
    for (int q = 0; q < 4; ++q) { hq_[q] = (LAS unsigned char*)(hist_ + q * 256); asm volatile("" : "+s"(hq_[q])); }
#pragma unroll
    for (int q = 0; q < 4; ++q)
#pragma unroll
        for (int it_ = 0; it_ < 4; ++it_) vva_[q][it_] = *(const LAS v4u*)(sc + q * 8192 + 4 * tid + 2048 * it_);
#pragma unroll
    for (int q = 0; q < 4; ++q) {
#pragma unroll
        for (int it_ = 0; it_ < 4; ++it_) { const int idx = 4 * tid + 2048 * it_; if (idx >= nk32) break; const v4u v = vva_[q][it_];
#pragma unroll
            for (int e = 0; e < 4; ++e) { const unsigned raw = v[e]; const float d = __builtin_bit_cast(float, raw) - basef[q], xb_ = d * scl[q];
                vva_[q][it_][e] = __builtin_bit_cast(unsigned, xb_);
                if (d >= 0.f) { const unsigned bn = (unsigned)(int)xb_;
                    __hip_atomic_fetch_add((LAS unsigned*)(hq_[q] + 4u * bn), 1u, __ATOMIC_RELAXED, __HIP_MEMORY_SCOPE_WORKGROUP); } } } }
    }
    DSA_BAR();
    int bsq[4]; unsigned cgq[4], fbq[4];
#pragma unroll
    for (int q = 0; q < 4; ++q) {
        const v4u h4 = *(const LAS v4u*)(hist + q * 256 + 4 * lane);
        const unsigned t4 = h4.x + h4.y + h4.z + h4.w; const unsigned incl = wave_incl_scan(t4); const unsigned tot = (unsigned)__builtin_amdgcn_readlane((int)incl, 63);
        const unsigned S = tot - incl + t4;
        const unsigned excl = S - t4, s3 = excl + h4.w, s2 = s3 + h4.z, s1 = s2 + h4.y;
        const unsigned long long mask = __ballot(S >= 256u);
        if (mask == 0ull) { bsq[q] = -1; cgq[q] = tot; fbq[q] = 0u; }
        else { const int L = 63 - __builtin_clzll(mask);
            const int bb = s3 >= 256u ? 3 : s2 >= 256u ? 2 : s1 >= 256u ? 1 : 0; const unsigned nc = bb == 3 ? s3 : bb == 2 ? s2 : bb == 1 ? s1 : S;
            const unsigned hb = bb == 3 ? h4.w : bb == 2 ? h4.z : bb == 1 ? h4.y : h4.x;
            bsq[q] = __builtin_amdgcn_readlane(4 * lane + bb, L); cgq[q] = (unsigned)__builtin_amdgcn_readlane((int)(nc - hb), L); fbq[q] = (unsigned)__builtin_amdgcn_readlane(hb > (unsigned)CAP ? 1 : 0, L); }
    }
    const unsigned fb_any = fbq[0] | fbq[1] | fbq[2] | fbq[3];
    _Pragma("unroll") for (int rp4 = DSA_REP_S4 - 1; rp4 >= 0; --rp4) { LAS unsigned* cnt_ = mm + (rp4 ? 44 : 8);
#pragma unroll
    for (int q = 0; q < 4; ++q) { const int bs = bsq[q];
        if (!fbq[q]) { const float tlo = bs < 0 ? 0.f : (float)bs, thi = bs < 0 ? 0.f : bs >= 255 ? INFINITY : (float)(bs + 1);
          {
#pragma unroll
            for (int it_ = 0; it_ < 4; ++it_) { const int idx = 4 * tid + 2048 * it_; if (idx >= nk32) break; const v4u v = vva_[q][it_];
#pragma unroll
                for (int e = 0; e < 4; ++e) { const unsigned raw = v[e]; const float xb = __builtin_bit_cast(float, raw);
                    if (xb >= tlo) { const unsigned ix = (unsigned)(idx + e);
                        if (xb >= thi) __hip_atomic_fetch_or(&bitmap[q * 256 + (ix >> 5)], 1u << (ix & 31), __ATOMIC_RELAXED, __HIP_MEMORY_SCOPE_WORKGROUP);
                        else { const unsigned pos = __hip_atomic_fetch_add(&cnt_[q], 1u, __ATOMIC_RELAXED, __HIP_MEMORY_SCOPE_WORKGROUP);
                            if (pos < (unsigned)CAP) cand[q * CAP + pos] = (v2u){ordk(__builtin_bit_cast(float, sc[q * 8192 + ix])), ix}; } } } } } } }
    if (rp4) DSA_BAR(); }
    DSA_BAR();
    const int bs_w = wid == 0 ? bsq[0] : wid == 1 ? bsq[1] : wid == 2 ? bsq[2] : bsq[3]; const unsigned cg_w = wid == 0 ? cgq[0] : wid == 1 ? cgq[1] : wid == 2 ? cgq[2] : cgq[3], fb_w = wid == 0 ? fbq[0] : wid == 1 ? fbq[1] : wid == 2 ? fbq[2] : fbq[3];
    if (wid < 4 && !fb_w && bs_w >= 0) {
        const int n = (int)mm[8 + wid], r = 256 - (int)cg_w;
        const LAS v2u* cl = cand + wid * CAP; LAS unsigned* bm = bitmap + wid * 256;
#ifndef DSA_RANKMAX
#define DSA_RANKMAX 64
#endif
        if (n <= DSA_RANKMAX) {
            const v2u me = cl[lane < n ? lane : 0]; int rank = 0;
            for (int jx = 0; jx < n; ++jx) { const v2u o = cl[jx]; rank += (o.x > me.x || (o.x == me.x && o.y < me.y)) ? 1 : 0; }
            if (lane < n && rank < r) __hip_atomic_fetch_or(&bm[me.y >> 5], 1u << (me.y & 31), __ATOMIC_RELAXED, __HIP_MEMORY_SCOPE_WORKGROUP);
        } else {
            unsigned Tk = 0u;
            for (int bit = 31; bit >= 0; --bit) { const unsigned ct = Tk | (1u << bit); int cnt = 0;
                for (int e0 = 0; e0 < n; e0 += 64) { const int e = e0 + lane; const bool pr = (e < n) && (cl[e < n ? e : 0].x >= ct); cnt += __popcll(__ballot(pr)); }
                if (cnt >= r) Tk = ct; }
            int ngt = 0, neq = 0;
            for (int e0 = 0; e0 < n; e0 += 64) { const int e = e0 + lane; const unsigned x = cl[e < n ? e : 0].x; ngt += __popcll(__ballot(e < n && x > Tk)); neq += __popcll(__ballot(e < n && x == Tk)); }
            const int r2 = r - ngt; unsigned X = 0u;
            if (neq > r2) { for (int bit = 12; bit >= 0; --bit) { const unsigned cx = X | (1u << bit); int cnt = 0;
                    for (int e0 = 0; e0 < n; e0 += 64) { const int e = e0 + lane; const v2u ce = cl[e < n ? e : 0]; cnt += __popcll(__ballot(e < n && ce.x == Tk && (8191u - ce.y) >= cx)); }
                    if (cnt >= r2) X = cx; } }
            for (int e = lane; e < n; e += 64) { const v2u ce = cl[e]; if (ce.x > Tk || (ce.x == Tk && (8191u - ce.y) >= X)) __hip_atomic_fetch_or(&bm[ce.y >> 5], 1u << (ce.y & 31), __ATOMIC_RELAXED, __HIP_MEMORY_SCOPE_WORKGROUP); }
        }
    }
    if (fb_any) {
        int step = 0;
        DSA_BAR();
        for (int q = 0; q < 4; ++q) { if (!(q == 0 ? fbq[0] : q == 1 ? fbq[1] : q == 2 ? fbq[2] : fbq[3])) continue;
            const LAS unsigned* sq = sc + q * 8192;
#define DSA_COUNT(PRED, OUT) do { int loc_ = 0; for (int idx = tid; idx < nk32; idx += 512) { const unsigned k = key_or0(sq[idx]); const unsigned inv = 8191u - (unsigned)idx; (void)inv; loc_ += (k && (PRED)) ? 1 : 0; } \
            if (tid == 0) mm[32 + (step + 1) % 3] = 0u; if (loc_) __hip_atomic_fetch_add(&mm[32 + step % 3], (unsigned)loc_, __ATOMIC_RELAXED, __HIP_MEMORY_SCOPE_WORKGROUP); \
            DSA_BAR(); OUT = (int)mm[32 + step % 3]; ++step; } while (0)
            unsigned Tk = 0u; int cnt;
            for (int bit = 31; bit >= 0; --bit) { const unsigned ct = Tk | (1u << bit); DSA_COUNT(k >= ct, cnt); if (cnt >= 256) Tk = ct; }
            int ngt, neq; DSA_COUNT(k > Tk, ngt); DSA_COUNT(k == Tk, neq);
            const int r = 256 - ngt; unsigned X = 0u;
            if (neq > r) { for (int bit = 12; bit >= 0; --bit) { const unsigned cx = X | (1u << bit); DSA_COUNT(k == Tk && inv >= cx, cnt); if (cnt >= r) X = cx; } }
            for (int idx = tid; idx < nk32; idx += 512) { const unsigned k = key_or0(sq[idx]);
                if (k && (k > Tk || (k == Tk && (8191u - (unsigned)idx) >= X))) __hip_atomic_fetch_or(&bitmap[q * 256 + (idx >> 5)], 1u << (idx & 31), __ATOMIC_RELAXED, __HIP_MEMORY_SCOPE_WORKGROUP); }
#undef DSA_COUNT
        }
        DSA_BAR();
    }
    LDS_WAIT(); asm volatile("" ::: "memory");
    if (wid < 4) {
        const v4u w4 = *(const LAS v4u*)(bitmap + wid * 256 + 4 * lane);
        const int cl_ = __popc(w4.x) + __popc(w4.y) + __popc(w4.z) + __popc(w4.w); const int incl = (int)wave_incl_scan((unsigned)cl_);
        int pos = incl - cl_; LAS unsigned short* sl = sel + wid * 256;
#pragma unroll
        for (int wi = 0; wi < 4; ++wi) { unsigned word = w4[wi]; while (word) { const int bit = __builtin_ctz(word); if (pos < 256) sl[pos] = (unsigned short)((4 * lane + wi) * 32 + bit); ++pos; word &= word - 1u; } }
        const int total = __builtin_amdgcn_readlane(incl, 63); const int ns = total < 256 ? total : 256;
        for (int e = ns + lane; e < 256; e += 64) sl[e] = 0;
        if (lane == 0) mm[24 + wid] = (unsigned)ns;
    }
    }
    DSA_BAR();
    _Pragma("unroll") for (int repD = 0; repD < DSA_REP_D; ++repD) {
        const int q = wid & 3, part = wid >> 2, hc = lane & 15, g = lane >> 4, head = hc & 7; const int nsel = (int)mm[24 + q];
        const size_t tok = tokbase + p0 + q; const LAS unsigned short* sl = sel + q * 256 + 128 * part;
        LAS unsigned char* Vw = shm + L_BIG + wid * VW_BYTES;
        bf16x8 bq[2];
#pragma unroll
        for (int s = 0; s < 2; ++s) bq[s] = __builtin_bit_cast(bf16x8, *(const GAS v4u*)(qb + tok * 512 + head * 64 + 32 * s + 8 * g));
        v4u kf[8][2], vg[2][8];
#pragma unroll
#ifndef DSA_DVAR
#define DSA_DVAR 0
#endif
#define DSA_DV(bit) ((DSA_DVAR & (bit)) && repD + 1 < DSA_REP_D)
        for (int kt = 0; kt < 8; ++kt) { const int key = sl[16 * kt + hc]; const bf16* ksrc = kb + (tokbase + key) * 64 + 8 * g;
            if (DSA_DV(1)) { kf[kt][0] = (v4u){0u, 0u, 0u, 0u}; kf[kt][1] = (v4u){0u, 0u, 0u, 0u}; } else {
            kf[kt][0] = *(const GAS v4u*)(ksrc); kf[kt][1] = *(const GAS v4u*)(ksrc + 32); } }
#define DSA_VLOAD(hf) _Pragma("unroll") for (int it = 0; it < 8; ++it) { const int id = it * 64 + lane, kl = id >> 3, ch = id & 7; const int key = sl[64 * (hf) + kl]; \
                if (DSA_DV(2)) vg[hf][it] = (v4u){0u, 0u, 0u, 0u}; else vg[hf][it] = *(const GAS v4u*)(vb + (tokbase + key) * 64 + ch * 8); }
        DSA_VLOAD(0)
        float st[8][4];
#pragma unroll
        for (int kt = 0; kt < 8; ++kt) {
            f32x4 a4 = {0.f, 0.f, 0.f, 0.f};
            a4 = __builtin_amdgcn_mfma_f32_16x16x32_bf16(__builtin_bit_cast(bf16x8, kf[kt][0]), bq[0], a4, 0, 0, 0);
            a4 = __builtin_amdgcn_mfma_f32_16x16x32_bf16(__builtin_bit_cast(bf16x8, kf[kt][1]), bq[1], a4, 0, 0, 0);
#pragma unroll
            for (int r = 0; r < 4; ++r) st[kt][r] = (128 * part + 16 * kt + 4 * g + r < nsel) ? a4[r] : -INFINITY; }
        DSA_VLOAD(1)
#undef DSA_VLOAD
        constexpr float SC = 0.125f * 1.4426950408889634f;
        float m = -1e30f;
#pragma unroll
        for (int kt = 0; kt < 8; ++kt)
#pragma unroll
            for (int r = 0; r < 4; ++r) m = fmaxf(m, st[kt][r]);
        m = fmaxf(m, __shfl_xor(m, 16)); m = fmaxf(m, __shfl_xor(m, 32));
        float l = 0.f;
#pragma unroll
        for (int kt = 0; kt < 8; ++kt)
#pragma unroll
            for (int r = 0; r < 4; ++r) { st[kt][r] = __builtin_amdgcn_exp2f((st[kt][r] - m) * SC); l += st[kt][r]; }
        l += __shfl_xor(l, 16); l += __shfl_xor(l, 32);
        f32x4 ot[4]; ot[0] = ot[1] = ot[2] = ot[3] = (f32x4){0.f, 0.f, 0.f, 0.f};
        const int vrd = (4 * g + ((lane & 15) >> 2)) * 160 + (lane & 3) * 8;
#pragma unroll
        for (int hf = 0; hf < 2; ++hf) { if (DSA_DV(4)) continue;
            asm volatile("" ::: "memory");
#pragma unroll
            for (int it = 0; it < 8; ++it) { const int id = it * 64 + lane, kl = id >> 3, ch = id & 7;
                *(LAS v4u*)(Vw + kl * 160 + ch * 16) = vg[hf][it]; }
            LDS_WAIT();
#pragma unroll
            for (int s2 = 0; s2 < 2; ++s2) { const int ta = 4 * hf + 2 * s2;
                v4u pw; pw.x = cvtpk(st[ta][0], st[ta][1]); pw.y = cvtpk(st[ta][2], st[ta][3]); pw.z = cvtpk(st[ta + 1][0], st[ta + 1][1]); pw.w = cvtpk(st[ta + 1][2], st[ta + 1][3]);
#pragma unroll
                for (int mt = 0; mt < 4; ++mt) { const LAS unsigned char* vp = Vw + vrd + (32 * s2) * 160 + mt * 32;
                    const s16x4 lo = vtr(vp), hh = vtr(vp + 16 * 160);
                    const bf16x8 vf = {lo[0], lo[1], lo[2], lo[3], hh[0], hh[1], hh[2], hh[3]};
                    ot[mt] = __builtin_amdgcn_mfma_f32_16x16x32_bf16(vf, __builtin_bit_cast(bf16x8, pw), ot[mt], 0, 0, 0); } }
            LDS_WAIT();
        }
        LAS float* cb = (LAS float*)(shm + L_COMB) + (q * 64 + lane) * 20;
        if (part == 1) { cb[0] = m; cb[1] = l;
#pragma unroll
            for (int mt = 0; mt < 4; ++mt) *(LAS f32x4*)(cb + 4 + 4 * mt) = ot[mt]; }
        DSA_BAR();
        if (part == 0) { const float m1 = cb[0], l1 = cb[1]; const float M = fmaxf(m, m1), f0 = __builtin_amdgcn_exp2f((m - M) * SC), f1 = __builtin_amdgcn_exp2f((m1 - M) * SC);
            const float inv = 1.f / (l * f0 + l1 * f1);
            if (hc < 8) {
#pragma unroll
                for (int mt = 0; mt < 4; ++mt) { const f32x4 o1 = *(const LAS f32x4*)(cb + 4 + 4 * mt); const f32x4 o = (ot[mt] * f0 + o1 * f1) * inv;
                    v2u w; w.x = cvtpk(o[0], o[1]); w.y = cvtpk(o[2], o[3]); CHKW_S(3, w.x + w.y); *(GAS v2u*)(yb + tok * 512 + head * 64 + 16 * mt + 4 * g) = w; } } }
    }
    DSA_BAR();
    asm volatile("" :: "v"(pf_), "v"(pf2_));
}
__device__ __forceinline__ void phase(int zb, int vcu, const bf16* qidx, const bf16* kidx, const float* widx, const bf16* qb, const bf16* kb, const bf16* vb, bf16* yb, LAS unsigned char* shm) {
#pragma unroll 1
    for (int j = 0; j < 64; ++j) { const int Qi = ((j & 1) ? 255 - vcu : vcu) + 256 * j, Qn = (((j + 1) & 1) ? 255 - vcu : vcu) + 256 * (j + 1);
        quad(zb, Qi >> 11, 4 * (Qi & 2047), j + 1 < 64 ? (Qn >> 11) : -1, 4 * (Qn & 2047), qidx, kidx, widx, qb, kb, vb, yb, shm); }
}
}

__device__ __forceinline__ void p8_router(Frame& F) {
    { const int gw = F.vcu * NWAVES + F.wave;
      if (gw == 0) { GAS unsigned long long* o8 = (GAS unsigned long long*)(WSP(bf16, WS_XN2) + (size_t)T * D) + F.lane;
#pragma unroll
          for (int j = 0; j < 4; ++j) o8[64 * j] = 0ull; } }
    LAS float* Wl = (LAS float*)F.lds;
    for (int i = F.tid; i < 1024 * 32; i += NWAVES * 64) Wl[i] = F.r_w[i] * F.ffn_g[i >> 5];
    __syncthreads();
    const int lane = F.lane, i32 = lane & 31, kk = lane >> 5;
    int* tok_e = WSP(int, WS_TOKE); float* tok_g = WSP(float, WS_TOKG); int* tok_r = WSP(int, WS_TOKR); unsigned* cnt = WSP(unsigned, WS_CNT);
    for (int task = F.vcu * NWAVES + F.wave; task < NTASK; task += F.G * NWAVES) {
        const int t0 = task * 32;
        f32x16 acc = f32x16{}; float ss = 0.f;
        const float* xr = F.out + (size_t)(t0 + i32) * 1024 + 4 * kk;
#pragma unroll 4
        for (int m = 0; m < 128; ++m) { const f32x4 xv = *(const GAS f32x4*)(xr + 8 * m);
            ss += (xv[0] * xv[0] + xv[1] * xv[1]) + (xv[2] * xv[2] + xv[3] * xv[3]);
            const LAS float* wp = Wl + (8 * m + 4 * kk) * 32 + i32;
#pragma unroll
            for (int j = 0; j < 4; ++j) acc = __builtin_amdgcn_mfma_f32_32x32x2f32(xv[j], wp[32 * j], acc, 0, 0, 0); }
        ss += __shfl_xor(ss, 32);
        const float rstd = 1.f / sqrtf(ss * (1.f / 1024.f) + EPS);
        if (kk == 0) WSP(float, WS_RSTOK)[t0 + i32] = rstd;
        const float bias = F.r_b[i32];
        unsigned pickmask = 0u, kcode = 0u; int cnt_e = 0;
#pragma unroll
        for (int r = 0; r < 16; ++r) {
            const int tl_ = (r & 3) + 8 * (r >> 2) + 4 * kk;
            float v = acc[r] * __shfl(rstd, tl_) + bias;
            float tl[4]; int te[4];
#pragma unroll
            for (int k = 0; k < 4; ++k) { float bv = v; int be = i32;
#pragma unroll
                for (int o = 1; o < 32; o <<= 1) { const float ov = __shfl_xor(bv, o); const int oe = __shfl_xor(be, o); if (ov > bv || (ov == bv && oe < be)) { bv = ov; be = oe; } }
                tl[k] = bv; te[k] = be;
                if (be == i32) { v = -INFINITY; pickmask |= 1u << r; kcode |= (unsigned)k << (2 * r); ++cnt_e; } }
            const float e1 = __expf(tl[1] - tl[0]), e2 = __expf(tl[2] - tl[0]), e3 = __expf(tl[3] - tl[0]); const float inv = 1.f / (1.f + e1 + e2 + e3);
            if (i32 < 4) { const int k = i32; const int ee = k == 0 ? te[0] : k == 1 ? te[1] : k == 2 ? te[2] : te[3]; const float gg = (k == 0 ? 1.f : k == 1 ? e1 : k == 2 ? e2 : e3) * inv;
                CHKW_S(6, (unsigned)ee + __builtin_bit_cast(unsigned, gg)); tok_e[(size_t)(t0 + tl_) * 4 + k] = ee; tok_g[(size_t)(t0 + tl_) * 4 + k] = gg; }
        }
        const int c_other = __shfl_xor(cnt_e, 32);
        const int base = kk ? c_other : 0;
#pragma unroll
        for (int r = 0; r < 16; ++r) if ((pickmask >> r) & 1u) { const int tl_ = (r & 3) + 8 * (r >> 2) + 4 * kk; const int k = (kcode >> (2 * r)) & 3;
            tok_r[(size_t)(t0 + tl_) * 4 + k] = base + __popc(pickmask & ((1u << r) - 1u)); }
        if (kk == 0) cnt[(size_t)task * 32 + i32] = (unsigned)(cnt_e + c_other);
    }
}

__device__ __forceinline__ void p9_slots(Frame& F) {
    const unsigned* cnt = WSP(unsigned, WS_CNT); const int* tok_e = WSP(int, WS_TOKE); const int* tok_r = WSP(int, WS_TOKR); int* rowtok = WSP(int, WS_ROWTOK); int* blke = WSP(int, WS_BLKE); int* rowsrc = WSP(int, WS_ROWSRC); float* rowrs = WSP(float, WS_ROWRS); const float* rs_tok = WSP(float, WS_RSTOK);
    LAS int* sm_tot = (LAS int*)F.lds; LAS int* sm_pre = sm_tot + 512; LAS int* s_total = sm_pre + 512; LAS int* s_pad = s_total + 32; LAS int* s_base = s_pad + 40;
    const int e = F.tid & 31, grp = F.tid >> 5, first = F.vcu * NWAVES;
    { int tot = 0, pre = 0;
      for (int tk = grp * 128; tk < grp * 128 + 128; ++tk) { const int c = (int)cnt[(size_t)tk * 32 + e]; tot += c; pre += (tk < first) ? c : 0; }
      sm_tot[grp * 32 + e] = tot; sm_pre[grp * 32 + e] = pre; }
    __syncthreads();
    if (F.tid < 32) { int tot = 0, pre = 0;
        for (int g = 0; g < 16; ++g) { tot += sm_tot[g * 32 + e]; pre += sm_pre[g * 32 + e]; }
        s_total[e] = tot;
        for (int w = 0; w < 8; ++w) { s_base[w * 32 + e] = pre; pre += (int)cnt[(size_t)(first + w) * 32 + e]; } }
    __syncthreads();
    if (F.tid == 0) { int ps = 0; for (int q = 0; q < 32; ++q) { s_pad[q] = ps; ps += ((s_total[q] + 255) >> 8) << 8; } s_pad[32] = ps; }
    __syncthreads();
    { const int t0 = (first + F.wave) * 32;
#pragma unroll
      for (int u = 0; u < 2; ++u) { const int p = 2 * F.lane + u; const size_t q = (size_t)(t0 + (p >> 2)) * 4 + (p & 3); const int ee = tok_e[q];
          { const int sl_ = s_pad[ee] + s_base[F.wave * 32 + ee] + tok_r[q]; CHKW_S(6, (unsigned)sl_ * 2654435761u + (unsigned)q); rowtok[sl_] = (int)q; rowsrc[sl_] = (int)(q >> 2); rowrs[sl_] = rs_tok[q >> 2]; } } }
    if (F.vcu < 32) { const int q = F.vcu; for (int s = s_pad[q] + s_total[q] + F.tid; s < s_pad[q + 1]; s += NWAVES * 64) { rowtok[s] = -1; rowsrc[s] = T; rowrs[s] = 0.f; } }
    if (F.vcu == 32) { const int nblk = s_pad[32] >> 8;
        for (int bq = F.tid; bq < nblk; bq += NWAVES * 64) { int ee = 0; for (int q = 1; q < 32; ++q) ee += (bq * 256 >= s_pad[q]) ? 1 : 0; blke[bq] = ee; }
        if (F.tid == 0) blke[MAXBLK] = nblk; }
}

__device__ __forceinline__ void p10_moe(Frame& F, int probe_skip) {
    const int* rowtok = WSP(int, WS_ROWTOK); const int* rowsrc = WSP(int, WS_ROWSRC); const int* blke = WSP(int, WS_BLKE);
    bf16* act = WSP(bf16, WS_SCR) + (size_t)F.vcu * (256 * 1024);
    const int nblk = blke[MAXBLK], nfull = (nblk / F.G) * F.G;
#pragma unroll 1
    for (int bq = F.vcu; bq < nfull; bq += F.G) {
        const int e = blke[bq];
        int z1, z2; asm volatile("v_mov_b32 %0, 0" : "=v"(z1)); asm volatile("v_mov_b32 %0, 0" : "=v"(z2));
#ifndef MOE_REP_GU
#define MOE_REP_GU 1
#endif
#ifndef MOE_REP_DN
#define MOE_REP_DN 1
#endif
        int nrg_ = MOE_REP_GU, nrd_ = MOE_REP_DN; if (MOE_REP_GU > 1 || MOE_REP_DN > 1) asm volatile("" : "+s"(nrg_), "+s"(nrd_));
        if (!(probe_skip & 1))
        _Pragma("unroll 1") for (int rg_ = 0; rg_ < nrg_; ++rg_)
        { pg8::Gemm g{WSP(bf16, WS_XN2), WSP(bf16, WS_WGU), 256, 2048 * 32, 1024}; pg8::ListOrderT<true> S{8, e * 8, F.tid + z1, rowsrc + bq * 256}; pg8::EpiGU E{act, F.b_gu + (size_t)e * 2048, WSP(float, WS_ROWRS) + bq * 256};
          pg8::gemm_phase<pg8::EpiGU, pg8::ListOrderT<true>, true, true>(F.lds, g, S, E); if (rg_ + 1 < nrg_) { VM_WAIT(); __syncthreads(); } }
        VM_WAIT(); __syncthreads();
        if (F.tid == 0) __builtin_amdgcn_fence(__ATOMIC_ACQUIRE, "agent");
        VM_WAIT(); __syncthreads();
        if (!(probe_skip & 2))
        _Pragma("unroll 1") for (int rd_ = 0; rd_ < nrd_; ++rd_)
        { pg8::Gemm g{act, WSP(bf16, WS_WD), 256, 1024 * 32, 1024}; pg8::ListOrderT<false> S{4, e * 4, F.tid + z2, nullptr}; pg8::EpiDown E{WSP(bf16, WS_YBUF), F.b_d + (size_t)e * 1024, rowtok + bq * 256};
          pg8::gemm_phase<pg8::EpiDown, pg8::ListOrderT<false>, true, true>(F.lds, g, S, E); if (rd_ + 1 < nrd_) { VM_WAIT(); __syncthreads(); } }
        __syncthreads();
    }
}
#ifndef MOE_PAIR
#define MOE_PAIR 0
#endif
__device__ __forceinline__ void p10_moe_pair(Frame& F) {
    const int* rowtok = WSP(int, WS_ROWTOK); const int* rowsrc = WSP(int, WS_ROWSRC); const int* blke = WSP(int, WS_BLKE);
    const int nblk = blke[MAXBLK], nfull = (nblk / F.G) * F.G, R = nfull / F.G;
    const int j = F.vcu & 31, xg = F.vcu >> 5, half = (j >> 4) & 1, k = j & 15, pr = xg * 16 + k;
    bf16* actb[2] = {WSP(bf16, WS_SCR) + (size_t)(xg * 32 + k) * (256 * 1024), WSP(bf16, WS_SCR) + (size_t)(xg * 32 + 16 + k) * (256 * 1024)};
    gu32* flags = F.ctl + 12288 + pr * 16;
#pragma unroll 1
    for (int st = 0; st < 2 * R; ++st) {
        const int bq = (st >> 1) * F.G + xg * 32 + 16 * (st & 1) + k, e = blke[bq];
        bf16* act = actb[st & 1];
        int z1, z2; asm volatile("v_mov_b32 %0, 0" : "=v"(z1)); asm volatile("v_mov_b32 %0, 0" : "=v"(z2));
        { pg8::Gemm g{WSP(bf16, WS_XN2), WSP(bf16, WS_WGU), 256, 2048 * 32, 1024}; pg8::ListOrderT<true> S{4, e * 8 + 4 * half, F.tid + z1, rowsrc + bq * 256}; pg8::EpiGU E{act, F.b_gu + (size_t)e * 2048, WSP(float, WS_ROWRS) + bq * 256};
          pg8::gemm_phase<pg8::EpiGU, pg8::ListOrderT<true>, true, true>(F.lds, g, S, E); }
        VM_WAIT(); __syncthreads();
        if (F.tid == 0) { __builtin_amdgcn_fence(__ATOMIC_RELEASE, "agent"); __hip_atomic_fetch_add(flags + st, 1u, __ATOMIC_RELAXED, __HIP_MEMORY_SCOPE_AGENT);
            while (__hip_atomic_load(flags + st, __ATOMIC_RELAXED, __HIP_MEMORY_SCOPE_AGENT) < 2u) __builtin_amdgcn_s_sleep(2);
            __builtin_amdgcn_fence(__ATOMIC_ACQUIRE, "agent"); }
        VM_WAIT(); __syncthreads();
        { pg8::Gemm g{act, WSP(bf16, WS_WD), 256, 1024 * 32, 1024}; pg8::ListOrderT<false> S{2, e * 4 + 2 * half, F.tid + z2, nullptr}; pg8::EpiDown E{WSP(bf16, WS_YBUF), F.b_d + (size_t)e * 1024, rowtok + bq * 256};
          pg8::gemm_phase<pg8::EpiDown, pg8::ListOrderT<false>, true, true>(F.lds, g, S, E); }
        __syncthreads();
    }
}
__device__ __forceinline__ void p10b_moe_tail_gu(Frame& F) {
    const int* rowsrc = WSP(int, WS_ROWSRC); const int* blke = WSP(int, WS_BLKE);
    const int nblk = blke[MAXBLK], nfull = (nblk / F.G) * F.G, nu = (nblk - nfull) * 8;
#pragma unroll 1
    for (int u = F.vcu; u < nu; u += F.G) {
        const int bl = u >> 3, bq = nfull + bl, e = blke[bq];
        int z1; asm volatile("v_mov_b32 %0, 0" : "=v"(z1));
        pg8::Gemm g{WSP(bf16, WS_XN2), WSP(bf16, WS_WGU), 256, 2048 * 32, 1024}; pg8::ListOrderT<true> S{1, e * 8 + (u & 7), F.tid + z1, rowsrc + bq * 256}; pg8::EpiGU E{WSP(bf16, WS_TAILACT) + (size_t)bl * (256 * 1024), F.b_gu + (size_t)e * 2048, WSP(float, WS_ROWRS) + bq * 256};
        pg8::gemm_phase<pg8::EpiGU, pg8::ListOrderT<true>, true, true>(F.lds, g, S, E);
        __syncthreads();
    }
}
__device__ __forceinline__ void p10c_moe_tail_down(Frame& F) {
    const int* rowtok = WSP(int, WS_ROWTOK); const int* blke = WSP(int, WS_BLKE);
    const int nblk = blke[MAXBLK], nfull = (nblk / F.G) * F.G, nu = (nblk - nfull) * 4;
#pragma unroll 1
    for (int u = F.vcu; u < nu; u += F.G) {
        const int bl = u >> 2, bq = nfull + bl, e = blke[bq];
        int z1; asm volatile("v_mov_b32 %0, 0" : "=v"(z1));
        pg8::Gemm g{WSP(bf16, WS_TAILACT) + (size_t)bl * (256 * 1024), WSP(bf16, WS_WD), 256, 1024 * 32, 1024}; pg8::ListOrderT<false> S{1, e * 4 + (u & 3), F.tid + z1, nullptr}; pg8::EpiDown E{WSP(bf16, WS_YBUF), F.b_d + (size_t)e * 1024, rowtok + bq * 256};
        pg8::gemm_phase<pg8::EpiDown, pg8::ListOrderT<false>, true, true>(F.lds, g, S, E);
        __syncthreads();
    }
}

__device__ __forceinline__ void p11_final(Frame& F) {
    const int gw = F.vcu * NWAVES + F.wave, NGW = F.G * NWAVES, lane = F.lane;
    const float* tok_g = WSP(float, WS_TOKG); const bf16* ybuf = WSP(bf16, WS_YBUF);
    for (int t = gw; t < T; t += NGW) {
        GAS f32x4* xr = (GAS f32x4*)(F.out + (size_t)t * D) + lane; const GAS f32x4* gr = (const GAS f32x4*)F.fin_g + lane;
        const f32x4 gt = *(const GAS f32x4*)(tok_g + (size_t)t * 4);
        f32x4 v[4];
#pragma unroll
        for (int j = 0; j < 4; ++j) v[j] = xr[64 * j];
#pragma unroll
        for (int k = 0; k < 4; ++k) { const GAS v2u* yr = (const GAS v2u*)(ybuf + ((size_t)t * 4 + k) * D) + lane; const float gk = gt[k];
#pragma unroll
            for (int j = 0; j < 4; ++j) { const v2u w = yr[64 * j]; v[j].x += gk * bflo(w.x); v[j].y += gk * bfhi(w.x); v[j].z += gk * bflo(w.y); v[j].w += gk * bfhi(w.y); } }
        float s = 0.f;
#pragma unroll
        for (int j = 0; j < 4; ++j) s += (v[j].x * v[j].x + v[j].y * v[j].y) + (v[j].z * v[j].z + v[j].w * v[j].w);
        const float rstd = 1.f / sqrtf(wave_sum(s) * (1.f / 1024.f) + EPS);
#pragma unroll
        for (int j = 0; j < 4; ++j) { const f32x4 gg = gr[64 * j]; const f32x4 r_ = v[j] * rstd * gg; CHKW_S(6, __builtin_bit_cast(unsigned, r_[0]) + __builtin_bit_cast(unsigned, r_[1]) + __builtin_bit_cast(unsigned, r_[2]) + __builtin_bit_cast(unsigned, r_[3])); xr[64 * j] = r_; }
    }
}

struct Args { const void* in[19]; float* out; unsigned char* ws; int ph_lo, ph_hi, li, pad; };
__global__ void __launch_bounds__(NWAVES * 64, 2) mk_fwd(Args args) {
    extern __shared__ __attribute__((aligned(16))) unsigned char lds[];
    Frame F;
    F.lds = (LAS unsigned char*)lds;
    F.MISC = (volatile LAS unsigned*)(F.lds + MISC_OFF);
    F.tid = threadIdx.x; F.lane = F.tid & 63; F.wave = __builtin_amdgcn_readfirstlane(F.tid >> 6);
    F.G = gridDim.x; { const int bx = blockIdx.x; F.vcu = (bx % 8) * (F.G / 8) + bx / 8; }
    F.ws = args.ws; F.ctl = (gu32*)(args.ws + WS_CTL);
    F.x = (const float*)args.in[0]; F.pos = (const int*)args.in[1]; F.out = args.out;
    F.attn_g = (const float*)args.in[2]; F.w_in = (const float*)args.in[3]; F.qn_g = (const float*)args.in[4]; F.w_uq = (const float*)args.in[5]; F.kvn_g = (const float*)args.in[6];
    F.w_ukv = (const float*)args.in[7]; F.w_ba = (const float*)args.in[8]; F.w_bb = (const float*)args.in[9]; F.w_out = (const float*)args.in[10]; F.ffn_g = (const float*)args.in[11];
    F.r_w = (const float*)args.in[12]; F.r_b = (const float*)args.in[13]; F.w_gu = (const float*)args.in[14]; F.b_gu = (const float*)args.in[15]; F.w_d = (const float*)args.in[16];
    F.b_d = (const float*)args.in[17]; F.fin_g = (const float*)args.in[18];
    if (F.tid < 16) F.MISC[F.tid] = 0u;
#if defined(SELFCHK2)
    if (F.tid < 64) ((LAS unsigned*)(F.lds + 163072))[F.tid] = 0u;
#endif
    __syncthreads();
    XcdBarrier bar; bar.bar = (unsigned*)(F.ctl + CW_BAR); bar.x = 0; bar.st = nullptr;
    if (N_LAUNCHES == 1) bar = xcd_barrier_post((unsigned*)(F.ctl + CW_BAR) + args.li * 4096, F.MISC + 0);
#if defined(DBL_BAR)
#define GRID_BAR() do { if (N_LAUNCHES == 1) { xcd_barrier(bar); xcd_barrier(bar); } } while (0)
#elif defined(SYS_ACQ)
#define GRID_BAR() do { if (N_LAUNCHES == 1) { xcd_barrier(bar); if (F.tid == 0) __builtin_amdgcn_fence(__ATOMIC_ACQUIRE, ""); asm volatile("s_waitcnt vmcnt(0)" ::: "memory"); __syncthreads(); } } while (0)
#else
#define GRID_BAR() do { if (N_LAUNCHES == 1) { xcd_barrier(bar); } } while (0)
#endif
    const int lo = args.ph_lo, hi = args.ph_hi;
#ifndef DBG_MASK
#define DBG_MASK 0x1FFF
#endif
#define IN(k) ((((DBG_MASK) >> (k)) & 1) && lo <= (k) && (k) < hi)
#define BOTH(k) (IN(k) && IN((k) + 1))
#ifndef MOE_PROBE
#define MOE_PROBE 0
#endif
#ifndef DBG_DOUBLE
#define DBG_DOUBLE 0
#endif
#define REP(k) _Pragma("unroll") for (int rep_ = 0; rep_ < ((((DBG_DOUBLE) >> (k)) & 1) ? 2 : 1); ++rep_)
#define PHASE_BEGIN() int zz_; asm volatile("v_mbcnt_lo_u32_b32 %0, -1, 0\n\tv_mbcnt_hi_u32_b32 %0, -1, %0" : "=v"(zz_)); F.lane = zz_; F.tid = F.wave * 64 + F.lane; zz_ = F.tid

#if defined(PROBE_L2)
    {
        unsigned* R = (unsigned*)(F.ws + 1000 * MiB); const int G_ = F.G, w = (int)blockIdx.x, nb = (w + 1) % G_;
        unsigned bad = 0u;
        for (int round = 0; round < 3; ++round) {
            const unsigned v1 = 0x1000000u * (unsigned)(round + 1), v2 = v1 + 0x800000u;
            for (int i = F.tid; i < 8192; i += 512) R[(size_t)w * 8192 + i] = v1 + (unsigned)i;
            GRID_BAR();
            { unsigned x = 0; for (int i = F.tid; i < 8192; i += 512) x |= R[(size_t)nb * 8192 + i] ^ (v1 + (unsigned)i); if (x) bad |= 1u; }
            GRID_BAR();
            for (int i = F.tid; i < 8192; i += 512) R[(size_t)w * 8192 + i] = v2 + (unsigned)i;
            GRID_BAR();
            { unsigned x = 0; for (int i = F.tid; i < 8192; i += 512) x |= R[(size_t)nb * 8192 + i] ^ (v2 + (unsigned)i); if (x) bad |= 1u; }
            unsigned* S = R + (size_t)G_ * 8192;
            for (int i = F.tid; i < 256; i += 512) S[(size_t)i * 256 + w] = v1 + (unsigned)(i * 256 + w);
            GRID_BAR();
            { unsigned x = 0; for (int i = F.tid; i < 65536; i += 512) x |= S[i] ^ (v1 + (unsigned)i); if (x) bad |= 2u; }
            GRID_BAR();
        }
        if (bad) __hip_atomic_fetch_or((unsigned*)(F.ctl + 9), bad, RLX_AGENT);
        GRID_BAR();
    }
#endif
#if defined(SELFCHK)
#define CHK(k, off, bytes) do { int ln_; asm volatile("v_mbcnt_lo_u32_b32 %0, -1, 0\n\tv_mbcnt_hi_u32_b32 %0, -1, %0" : "=v"(ln_)); const unsigned* P_ = (const unsigned*)(F.ws + (off)); const size_t n_ = (size_t)(bytes) / 4; unsigned acc_ = 0; \
        for (size_t i_ = (size_t)F.vcu * 512 + F.wave * 64 + ln_; i_ < n_; i_ += (size_t)F.G * 512) acc_ += P_[i_]; \
        for (int o_ = 1; o_ < 64; o_ <<= 1) acc_ += __shfl_xor(acc_, o_); \
        if (ln_ == 0) __hip_atomic_fetch_add((unsigned*)(F.ctl + 64 + 32 * args.pad + (k)), acc_, RLX_AGENT); } while (0)
#define CHKOUT(k) do { int ln_; asm volatile("v_mbcnt_lo_u32_b32 %0, -1, 0\n\tv_mbcnt_hi_u32_b32 %0, -1, %0" : "=v"(ln_)); const unsigned* P_ = (const unsigned*)F.out; const size_t n_ = (size_t)T * D; unsigned acc_ = 0; \
        for (size_t i_ = (size_t)F.vcu * 512 + F.wave * 64 + ln_; i_ < n_; i_ += (size_t)F.G * 512) acc_ += P_[i_]; \
        for (int o_ = 1; o_ < 64; o_ <<= 1) acc_ += __shfl_xor(acc_, o_); \
        if (ln_ == 0) __hip_atomic_fetch_add((unsigned*)(F.ctl + 64 + 32 * args.pad + (k)), acc_, RLX_AGENT); } while (0)
#elif defined(SELFCHK2)
#define FLUSHK(k) do { LDS_WAIT(); __syncthreads(); if (F.wave == 0) { int ln_; asm volatile("v_mbcnt_lo_u32_b32 %0, -1, 0\n\tv_mbcnt_hi_u32_b32 %0, -1, %0" : "=v"(ln_)); LAS unsigned* sl_ = (LAS unsigned*)(F.lds + 163072) + ln_; \
        unsigned acc_ = *sl_; *sl_ = 0u; for (int o_ = 1; o_ < 64; o_ <<= 1) acc_ += __shfl_xor(acc_, o_); \
        if (ln_ == 0) __hip_atomic_fetch_add((unsigned*)(F.ctl + 64 + 32 * args.pad + (k)), acc_, RLX_AGENT); } LDS_WAIT(); __syncthreads(); } while (0)
#define CHK(k, off, bytes) FLUSHK(k)
#define CHKOUT(k) FLUSHK(k)
#else
#define CHK(k, off, bytes) do {} while (0)
#define CHKOUT(k) do {} while (0)
#endif
    if (IN(0)) { PHASE_BEGIN(); REP(0) p0_prologue(F); if (BOTH(0)) GRID_BAR(); CHK(0, WS_WIN, 14 * MiB); CHK(0, WS_WGU, 192 * MiB); CHK(0, WS_H, 128 * MiB); CHK(0, WS_CS16, 12 * MiB); }

    if (IN(1)) {
        PHASE_BEGIN();
        REP(1) {
        pg8::Gemm g{WSP(bf16, WS_H), WSP(bf16, WS_WIN), T, 1792, 1024}; pg8::StaticOrder S; S.init(T, 1792, F.G, (int)blockIdx.x); S.z = zz_;
        pg8::EpiZ E{WSP(bf16, WS_CQ), WSP(bf16, WS_CKV), WSP(bf16, WS_KPE), WSP(bf16, WS_KB), WSP(bf16, WS_VB), WSP(bf16, WS_KIDX), WSP(bf16, WS_QB), WSP(bf16, WS_QIDX), WSP(float, WS_WIDX)};
        pg8::gemm_phase<pg8::EpiZ, pg8::StaticOrder, true, true>(F.lds, g, S, E);
        }
        if (BOTH(1)) GRID_BAR(); CHK(1, WS_CQ, 78 * MiB); CHK(1, WS_QB, 128 * MiB);
    }

    if (IN(2)) { PHASE_BEGIN(); p2_token_pass(F); if (BOTH(2)) GRID_BAR(); CHK(2, WS_CQ, 78 * MiB); CHK(2, WS_QB, 128 * MiB); }

    if (IN(3)) {
        PHASE_BEGIN();
        REP(3) {
        { pg8::Gemm g{WSP(bf16, WS_CQ), WSP(bf16, WS_WUQ), T, 768, 256}; pg8::StaticOrder S; S.init(T, 768, F.G, (int)blockIdx.x); S.z = zz_;
          pg8::EpiStore E{WSP(bf16, WS_QMLA), 768};
          pg8::gemm_phase<pg8::EpiStore, pg8::StaticOrder, true, true>(F.lds, g, S, E); }
        __syncthreads();
        { int z2_; asm volatile("v_mbcnt_lo_u32_b32 %0, -1, 0\n\tv_mbcnt_hi_u32_b32 %0, -1, %0" : "=v"(z2_)); z2_ += F.wave * 64;
          pg8::Gemm g{WSP(bf16, WS_CKV), WSP(bf16, WS_WUKV), T, 1024, 128}; pg8::StaticOrder S; S.init(T, 1024, F.G, (int)blockIdx.x); S.z = z2_;
          pg8::EpiStore E{WSP(bf16, WS_KV), 1024};
          pg8::gemm_phase<pg8::EpiStore, pg8::StaticOrder, true, true>(F.lds, g, S, E); }
        }
        if (BOTH(3)) GRID_BAR(); CHK(3, WS_QMLA, 224 * MiB);
    }

    if (IN(4)) {
        PHASE_BEGIN();
#if defined(PROBE_T5)
        mla::phase<PROBE_T5>(zz_, F.vcu, WSP(bf16, WS_QMLA), WSP(bf16, WS_KV), WSP(bf16, WS_KPE), WSP(f32x2, WS_CS32), WSP(bf16, WS_YB), F.lds);
#endif
#ifndef P4_ALT_SHIFT
#define P4_ALT_SHIFT 0
#endif
#if !SPLIT_MIXERS && defined(P4_ALT)
        _Pragma("unroll 1") for (int ph_ = 0; ph_ < 2; ++ph_) {
            if ((ph_ == 0) != (((F.vcu >> P4_ALT_SHIFT) & 1) != 0)) mla::phase<0>(zz_, F.vcu, WSP(bf16, WS_QMLA), WSP(bf16, WS_KV), WSP(bf16, WS_KPE), WSP(f32x2, WS_CS32), WSP(bf16, WS_YA), F.lds);
            else dsa::phase(zz_, F.vcu, WSP(bf16, WS_QIDX), WSP(bf16, WS_KIDX), WSP(float, WS_WIDX), WSP(bf16, WS_QB), WSP(bf16, WS_KB), WSP(bf16, WS_VB), WSP(bf16, WS_YB), F.lds);
            __syncthreads(); }
#else
        mla::phase<0>(zz_, F.vcu, WSP(bf16, WS_QMLA), WSP(bf16, WS_KV), WSP(bf16, WS_KPE), WSP(f32x2, WS_CS32), WSP(bf16, WS_YA), F.lds);
#endif
#if defined(PROBE_T1)
        VM_WAIT(); __syncthreads();
        mla::phase<0>(zz_, F.vcu, WSP(bf16, WS_QMLA), WSP(bf16, WS_KV), WSP(bf16, WS_KPE), WSP(f32x2, WS_CS32), WSP(bf16, WS_YA), F.lds);
#elif defined(PROBE_T3)
        mla::phase<0>(zz_, F.vcu, WSP(bf16, WS_QMLA), WSP(bf16, WS_KV), WSP(bf16, WS_KPE), WSP(f32x2, WS_CS32), WSP(bf16, WS_YB), F.lds);
#endif
        __syncthreads();
#if SPLIT_MIXERS
        if (BOTH(4)) GRID_BAR(); CHK(4, WS_YA, 64 * MiB);
#if defined(PROBE_T8)
        { const v4u* A = WSP(v4u, WS_YA); const v4u* B = WSP(v4u, WS_YB); unsigned bad = 0;
          for (size_t i = (size_t)F.vcu * 512 + F.tid; i < (size_t)T * 512 * 2 / 16; i += (size_t)F.G * 512) { const v4u a = A[i], b = B[i]; bad |= (a.x ^ b.x) | (a.y ^ b.y) | (a.z ^ b.z) | (a.w ^ b.w); }
          if (bad) __hip_atomic_store(F.ctl + 8, 1u, RLX_AGENT);
          GRID_BAR(); }
#endif
    }
    if (IN(12)) {
        PHASE_BEGIN();
#endif
#if !(!SPLIT_MIXERS && defined(P4_ALT))
        REP(12) dsa::phase(zz_, F.vcu, WSP(bf16, WS_QIDX), WSP(bf16, WS_KIDX), WSP(float, WS_WIDX), WSP(bf16, WS_QB), WSP(bf16, WS_KB), WSP(bf16, WS_VB), WSP(bf16, WS_YB), F.lds);
#endif
        if (BOTH(4)) GRID_BAR(); CHK(12, WS_YB, 64 * MiB);
    }

    if (IN(5)) {
        PHASE_BEGIN();
        REP(5) {
        pg8::Gemm g{WSP(bf16, WS_H), WSP(bf16, WS_WG), T, 2048, 1024}; pg8::StaticOrder S; S.init(T, 2048, F.G, (int)blockIdx.x); S.z = zz_;
        pg8::EpiGate E{WSP(bf16, WS_G)};
        pg8::gemm_phase<pg8::EpiGate, pg8::StaticOrder, true, true>(F.lds, g, S, E);
        }
        if (BOTH(5)) GRID_BAR(); CHK(5, WS_G, 256 * MiB);
    }

    if (IN(6)) {
        PHASE_BEGIN();
        REP(6) {
        { pg8::Gemm g{WSP(bf16, WS_YA), WSP(bf16, WS_WBA), T, 1024, 512}; pg8::StaticOrder S; S.init(T, 1024, F.G, (int)blockIdx.x); S.z = zz_;
          pg8::EpiMerge<0> E{WSP(bf16, WS_G), WSP(bf16, WS_M)};
          pg8::gemm_phase<pg8::EpiMerge<0>, pg8::StaticOrder, true, true>(F.lds, g, S, E); }
        VM_WAIT(); __syncthreads();
        { int z2_; asm volatile("v_mbcnt_lo_u32_b32 %0, -1, 0\n\tv_mbcnt_hi_u32_b32 %0, -1, %0" : "=v"(z2_)); z2_ += F.wave * 64;
          pg8::Gemm g{WSP(bf16, WS_YB), WSP(bf16, WS_WBB), T, 1024, 512}; pg8::StaticOrder S; S.init(T, 1024, F.G, (int)blockIdx.x); S.z = z2_;
          pg8::EpiMerge<1> E{WSP(bf16, WS_G), WSP(bf16, WS_M)};
          pg8::gemm_phase<pg8::EpiMerge<1>, pg8::StaticOrder, true, true>(F.lds, g, S, E); }
        }
        if (BOTH(6)) GRID_BAR(); CHK(6, WS_M, 128 * MiB);
    }

    if (IN(7)) {
        PHASE_BEGIN();
        REP(7) {
        pg8::Gemm g{WSP(bf16, WS_M), WSP(bf16, WS_WOUT), T, 1024, 1024}; pg8::StaticOrder S; S.init(T, 1024, F.G, (int)blockIdx.x); S.z = zz_;
        pg8::EpiX1 E{F.x, F.out, F.ffn_g, WSP(bf16, WS_XN2)};
        pg8::gemm_phase<pg8::EpiX1, pg8::StaticOrder, true, true>(F.lds, g, S, E);
        }
        if (BOTH(7)) GRID_BAR(); CHKOUT(7);
    }

    if (IN(8)) { PHASE_BEGIN(); REP(8) p8_router(F); if (BOTH(8)) GRID_BAR(); CHK(8, WS_TOKE, 3 * MiB + 256 * 1024); }
    if (IN(9)) { PHASE_BEGIN(); p9_slots(F); if (BOTH(9)) GRID_BAR(); CHK(9, WS_ROWTOK, 1024 * 256 * 4); CHK(9, WS_BLKE, 1024 * 4); }
    if (IN(10)) { PHASE_BEGIN(); if (MOE_PAIR && F.G == 256) p10_moe_pair(F); else { REP(10) p10_moe(F, (MOE_PROBE) && rep_ == 0 ? (MOE_PROBE) : 0); } GRID_BAR(); }
    if (IN(10)) { PHASE_BEGIN(); p10b_moe_tail_gu(F); GRID_BAR(); }
    if (IN(10)) { PHASE_BEGIN(); p10c_moe_tail_down(F); if (BOTH(10)) GRID_BAR(); CHK(10, WS_YBUF, 512 * MiB); }
    if (IN(11)) { PHASE_BEGIN(); p11_final(F);
#if defined(SELFCHK) || defined(SELFCHK2)
        GRID_BAR(); CHKOUT(11); GRID_BAR();
        if (args.pad == 1) {
            if (blockIdx.x == 0 && F.tid == 0) { unsigned code = 0u;
                for (int k = 0; k < 16; ++k) { const unsigned a_ = __hip_atomic_load(F.ctl + 64 + k, RLX_AGENT), b_ = __hip_atomic_load(F.ctl + 96 + k, RLX_AGENT); if (a_ != b_ && code == 0u) code = (unsigned)(k + 1); }
                __hip_atomic_store(F.ctl + 10, code, RLX_AGENT); }
            GRID_BAR();
            const unsigned code = __hip_atomic_load(F.ctl + 10, RLX_AGENT);
            if (code) { const float sc = 1.f + 0.02f * (float)code; for (size_t i = (size_t)F.vcu * 512 + F.tid; i < (size_t)T * D; i += (size_t)F.G * 512) F.out[i] *= sc; }
        }
#endif
#if defined(PROBE_T8) || defined(PROBE_L2)
        GRID_BAR();
        { const unsigned c9 = __hip_atomic_load(F.ctl + 9, RLX_AGENT); if (__hip_atomic_load(F.ctl + 8, RLX_AGENT) != 0u) { for (size_t i = (size_t)F.vcu * 512 + F.tid; i < (size_t)T * D; i += (size_t)F.G * 512) F.out[i] = __builtin_nanf(""); }
          else if (c9) { const float sc = 1.f + 0.05f * (float)c9; for (size_t i = (size_t)F.vcu * 512 + F.tid; i < (size_t)T * D; i += (size_t)F.G * 512) F.out[i] *= sc; } }
#endif
    }
#undef IN
#undef BOTH
}

extern "C" void kernel_launch(void* const* d_in, const int* in_sizes, int n_in, void* d_out, int out_size, void* d_ws, size_t ws_size, hipStream_t stream) {
    static int grid = 0;
    if (grid == 0) {
        if (n_in != 19 || in_sizes[0] != T * D || out_size != T * D || ws_size < WS_END) { fprintf(stderr, "kernel_launch: unexpected shapes (n_in %d, in0 %d, out %d, ws %zu)\n", n_in, n_in > 0 ? in_sizes[0] : -1, out_size, ws_size); grid = -1; return; }
        int dev = 0, cus = 0;
        if (hipGetDevice(&dev) != hipSuccess || hipDeviceGetAttribute(&cus, hipDeviceAttributeMultiprocessorCount, dev) != hipSuccess) { grid = -1; return; }
        if (hipFuncSetAttribute((const void*)mk_fwd, hipFuncAttributeMaxDynamicSharedMemorySize, LDS_BYTES) != hipSuccess) { fprintf(stderr, "kernel_launch: hipFuncSetAttribute failed\n"); grid = -1; return; }
        int per_cu = 0;
        if (hipOccupancyMaxActiveBlocksPerMultiprocessor(&per_cu, (const void*)mk_fwd, NWAVES * 64, LDS_BYTES) != hipSuccess || per_cu < 1) fprintf(stderr, "kernel_launch: occupancy query says %d\n", per_cu);
        (void)hipGetLastError();
        if (cus != 256) { fprintf(stderr, "kernel_launch: built for 256 CUs, device has %d\n", cus); grid = -1; return; }
        grid = 256;
    }
    if (grid < 0) return;
#if defined(DIAG_ZERO_WS)
    if (hipMemsetAsync((char*)d_ws, 0, WS_END, stream) != hipSuccess) return;
    (void)hipMemsetAsync(d_out, 0, (size_t)out_size * 4, stream);
#else
    if (hipMemsetAsync((char*)d_ws + WS_CTL, 0, CTL_ZERO_BYTES, stream) != hipSuccess) return;
#endif
    Args a{};
    for (int i = 0; i < 19; ++i) a.in[i] = d_in[i];
    a.out = (float*)d_out; a.ws = (unsigned char*)d_ws;
#if defined(SELFCHK) || defined(SELFCHK2)
    for (int pass = 0; pass < 2; ++pass) { a.ph_lo = 0; a.ph_hi = 13; a.li = pass; a.pad = pass; hipLaunchKernelGGL(mk_fwd, dim3(grid), dim3(NWAVES * 64), LDS_BYTES, stream, a); }
    if (true) return;
#endif
    for (int li = 0; li < N_LAUNCHES; ++li) {
        int ph = li;
#if SPLIT_MIXERS
        ph = li <= 4 ? li : li == 5 ? 12 : li - 1;
#endif
        a.ph_lo = (N_LAUNCHES != 1) ? ph : 0; a.ph_hi = (N_LAUNCHES != 1) ? ph + 1 : 13; a.li = 0;
        hipLaunchKernelGGL(mk_fwd, dim3(grid), dim3(NWAVES * 64), LDS_BYTES, stream, a);
        if (hipPeekAtLastError() != hipSuccess) { fprintf(stderr, "kernel_launch: launch %d failed\n", li); break; }
    }
}
```

```cpp
#define MK_N_LAUNCHES 1
#define SPLIT_MIXERS 0
#define MLA_PRIO_E 2
#define P4_ALT 1
#include <hip/hip_runtime.h>
#include <cstdio>
#include <cstdint>

extern __shared__ __attribute__((aligned(16))) unsigned char g_lds[];
#if defined(SELFCHK2) || defined(CHKW_MASK)
#ifndef CHKW_MASK
#define CHKW_MASK 0xFF
#endif
#define CHKW_S(site, v) do { if (((CHKW_MASK) >> (site)) & 1) { int ln_; asm volatile("v_mbcnt_lo_u32_b32 %0, -1, 0\n\tv_mbcnt_hi_u32_b32 %0, -1, %0" : "=v"(ln_)); __hip_atomic_fetch_add((__attribute__((address_space(3))) unsigned*)(g_lds + 163072) + ln_, (unsigned)(v), __ATOMIC_RELAXED, __HIP_MEMORY_SCOPE_WORKGROUP); } } while (0)
#else
#define CHKW_S(site, v) do {} while (0)
#endif
namespace pg8 {
#define PG8_LAS __attribute__((address_space(3)))
typedef unsigned short bf16_t;
typedef short bf16x8 __attribute__((ext_vector_type(8)));
typedef float f32x4 __attribute__((ext_vector_type(4)));
typedef unsigned u32x4 __attribute__((ext_vector_type(4)));
constexpr int BM = 256, BK = 64, HALF = 128, HTB = HALF * BK * 2  , STAGE_BYTES = 8 * HTB, NXCD = 8, WGM = 8;

__host__ __device__ __forceinline__ int lds_byte(int r, int c) { const int st = (r >> 4) * 2 + (c >> 5), rr = r & 15, cc = c & 31, ob = rr * 64 + cc * 2; return st * 1024 + (ob ^ (((ob >> 9) & 1) << 5)); }
__host__ __device__ __forceinline__ void stage_rc(int b, int& R, int& C) { const int st = b / 1024, sb = b % 1024, swz = sb ^ (((sb >> 9) & 1) << 5); R = (st >> 1) * 16 + swz / 64; C = (st & 1) * 32 + (swz % 64) / 2; }
__host__ __device__ __forceinline__ int perm32(int rho) { const int n = rho >> 4, i = rho & 15; return 8 * (i >> 2) + 4 * n + (i & 3); }

struct Unit { int pm, pn; };
struct Gemm { const bf16_t* A; const bf16_t* Bt; int M, N, K; };

struct StaticOrder {
    static constexpr bool GATHER = false; const int* rows = nullptr;
    int nM, nN, nwg, G, c, z = 0;
    __host__ __device__ void init(int M, int N, int G_, int c_) { nM = M / BM; nN = N / BM; nwg = nM * nN; G = G_; c = c_; }
    __host__ __device__ bool next(int i, Unit& u) const {
        const long L = (long)i * G + c; if (L >= nwg) return false;
        int wgid = (int)L; { const int q = nwg / NXCD, r = nwg % NXCD, xcd = wgid % NXCD, off = wgid / NXCD; wgid = (xcd < r ? xcd * (q + 1) : r * (q + 1) + (xcd - r) * q) + off; }
        const int nig = WGM * nN, gid = wgid / nig, fm = gid * WGM, gsz = (nM - fm) < WGM ? (nM - fm) : WGM;
        u.pm = fm + ((wgid % nig) % gsz); u.pn = (wgid % nig) / gsz; return true;
    }
    __device__ __forceinline__ void a_ready(const Unit&) const {}
    __device__ __forceinline__ void done(const Unit&) const {}
    __device__ __forceinline__ int tid_bias() const { return z; }
};

__device__ __forceinline__ unsigned cvt_pk_bf16(float lo, float hi) { unsigned r; asm volatile("s_nop 1\n\tv_cvt_pk_bf16_f32 %0, %1, %2" : "=v"(r) : "v"(lo), "v"(hi)); return r; }
typedef float f32x2 __attribute__((ext_vector_type(2)));
template <class Epi, class Sched, bool ALIGN_EPI = false, bool SP2 = false>
__device__ __forceinline__ void gemm_phase(PG8_LAS unsigned char* lds, const Gemm g, const Sched& S, const Epi& E) {
    const int tid = S.tid_bias(), wid = __builtin_amdgcn_readfirstlane(tid >> 6), lane = tid & 63, wr = wid >> 2, wc = wid & 3, fr = lane & 15, fq = lane >> 4;
    const int K = g.K, nt = K / BK;
    unsigned voffA[2], voffB[2];
#pragma unroll
    for (int i = 0; i < 2; ++i) { int R, C; stage_rc(tid * 16 + i * 8192, R, C); const int Rb = Epi::PERM ? ((R & ~31) + perm32(R & 31)) : R;
        voffA[i] = (unsigned)(R * K + C) * 2u; voffB[i] = (unsigned)(Rb * K + C) * 2u; }
    unsigned voffA1[2]; voffA1[0] = voffA[0]; voffA1[1] = voffA[1];
    if constexpr (Sched::GATHER) {
#pragma unroll
        for (int i = 0; i < 2; ++i) { int R, C; stage_rc(tid * 16 + i * 8192, R, C);
            voffA[i] = (unsigned)(S.rows[R] * K + C) * 2u; voffA1[i] = (unsigned)(S.rows[HALF + R] * K + C) * 2u; } }
    const size_t kstep = (size_t)(BK * 2);
    const size_t hstep = (size_t)HALF * K * 2;
    const size_t tstep = 2 * hstep;
    const size_t hstepA = Sched::GATHER ? 0 : hstep;
    const unsigned ldsw = (unsigned)wid * 1024u;
    const int aoff = lds_byte(wr * 64 + fr, fq * 8), boff = lds_byte(wc * 32 + fr, fq * 8);
#define PG8_SA(b, h) (((b) * 2 + (h)) * HTB)
#define PG8_SB(b, h) ((4 + (b) * 2 + (h)) * HTB)
#define PG8_STAGE(bufoff, gbase, voff) do { _Pragma("unroll") for (int _i = 0; _i < 2; ++_i) \
        __builtin_amdgcn_global_load_lds((const unsigned*)((const char*)(gbase) + (voff)[_i]), (PG8_LAS unsigned*)(lds + (bufoff) + ldsw + _i * 8192), 16, 0, 0); } while (0)
#define PG8_LDA(dst, b, h) do { _Pragma("unroll") for (int m = 0; m < 4; ++m) _Pragma("unroll") for (int k = 0; k < 2; ++k) dst[m][k] = *(const PG8_LAS bf16x8*)(lds + PG8_SA(b, h) + aoff + m * 2048 + k * 1024); } while (0)
#define PG8_LDB(dst, b, h) do { _Pragma("unroll") for (int n = 0; n < 2; ++n) _Pragma("unroll") for (int k = 0; k < 2; ++k) dst[n][k] = *(const PG8_LAS bf16x8*)(lds + PG8_SB(b, h) + boff + n * 2048 + k * 1024); } while (0)
#define PG8_MMA(ai, bj, At, Bt) do { __builtin_amdgcn_s_setprio(1); _Pragma("unroll") for (int m = 0; m < 4; ++m) _Pragma("unroll") for (int n = 0; n < 2; ++n) _Pragma("unroll") for (int k = 0; k < 2; ++k) \
        acc[ai][bj][m][n] = __builtin_amdgcn_mfma_f32_16x16x32_bf16(Bt[n][k], At[m][k], acc[ai][bj][m][n], 0, 0, 0); __builtin_amdgcn_s_setprio(0); } while (0)
#define PG8_WAIT_V(n) asm volatile("s_waitcnt vmcnt(" #n ")" ::: "memory")
#define PG8_WAIT_L(n) asm volatile("s_waitcnt lgkmcnt(" #n ")" ::: "memory")
#define PG8_BAR __builtin_amdgcn_s_barrier()
#define PG8_SCHED __builtin_amdgcn_sched_barrier(0)
    Unit cur, nxt; int ui = 0;
    if (!S.next(0, cur)) return;
    f32x4 acc[2][2][4][2];
#pragma unroll
    for (int a = 0; a < 2; ++a)
#pragma unroll
        for (int b = 0; b < 2; ++b)
#pragma unroll
            for (int m = 0; m < 4; ++m)
#pragma unroll
                for (int n = 0; n < 2; ++n) acc[a][b][m][n] = (f32x4){0.f, 0.f, 0.f, 0.f};
    bf16x8 At[4][2], B0[2][2], B1[2][2];
    const char* cA = (const char*)g.A + (size_t)cur.pm * tstep; const char* cB = (const char*)g.Bt + (size_t)cur.pn * tstep;
    S.a_ready(cur);
    if constexpr (SP2) {
        PG8_STAGE(PG8_SB(0, 0), cB, voffB); PG8_STAGE(PG8_SB(0, 1), cB + hstep, voffB); PG8_STAGE(PG8_SA(0, 0), cA, voffA); PG8_STAGE(PG8_SA(0, 1), cA + hstepA, voffA1);
        if (wr == 1) PG8_BAR;
        PG8_WAIT_V(2); PG8_BAR;
        PG8_STAGE(PG8_SB(1, 0), cB + kstep, voffB); PG8_STAGE(PG8_SA(1, 0), cA + kstep, voffA); PG8_STAGE(PG8_SB(1, 1), cB + hstep + kstep, voffB);
        PG8_WAIT_V(6); PG8_BAR;
    } else {
        PG8_STAGE(PG8_SB(0, 0), cB, voffB); PG8_STAGE(PG8_SA(0, 0), cA, voffA); PG8_STAGE(PG8_SB(0, 1), cB + hstep, voffB); PG8_STAGE(PG8_SA(0, 1), cA + hstepA, voffA1);
        if (wr == 1) PG8_BAR;
        PG8_WAIT_V(4); PG8_BAR;
        PG8_STAGE(PG8_SB(1, 0), cB + kstep, voffB); PG8_STAGE(PG8_SA(1, 0), cA + kstep, voffA); PG8_STAGE(PG8_SB(1, 1), cB + hstep + kstep, voffB);
        PG8_WAIT_V(6); PG8_BAR;
    }
    for (;;) {
        const bool has_next = S.next(ui + 1, nxt);
        const char* nA = has_next ? (const char*)g.A + (size_t)nxt.pm * tstep : cA; const char* nB = has_next ? (const char*)g.Bt + (size_t)nxt.pn * tstep : cB;
        for (int t = 0; t < nt; t += 2) {
            const bool last = (t == nt - 2);
            const char* a1 = cA + (size_t)(t + 1) * kstep;
            const char* a2 = last ? nA : cA + (size_t)(t + 2) * kstep; const char* b2 = last ? nB : cB + (size_t)(t + 2) * kstep;
            const char* a3 = a2 + kstep; const char* b3 = b2 + kstep;
            if (last && has_next) S.a_ready(nxt);
            if constexpr (SP2) {
            PG8_LDB(B0, 0, 0); PG8_LDB(B1, 0, 1); PG8_SCHED; PG8_LDA(At, 0, 0); PG8_STAGE(PG8_SA(1, 1), a1 + hstepA, voffA1);
            PG8_WAIT_V(8); PG8_WAIT_L(0); PG8_BAR; PG8_MMA(0, 0, At, B0); PG8_MMA(0, 1, At, B1); PG8_BAR; PG8_SCHED;
            PG8_LDA(At, 0, 1); PG8_STAGE(PG8_SB(0, 0), b2, voffB); PG8_STAGE(PG8_SB(0, 1), b2 + hstep, voffB); PG8_STAGE(PG8_SA(0, 0), a2, voffA);
            PG8_WAIT_V(8); PG8_WAIT_L(0); PG8_BAR; PG8_MMA(1, 0, At, B0); PG8_MMA(1, 1, At, B1); PG8_BAR; PG8_SCHED;
            PG8_LDB(B0, 1, 0); PG8_LDB(B1, 1, 1); PG8_SCHED; PG8_LDA(At, 1, 0); PG8_STAGE(PG8_SA(0, 1), a2 + hstepA, voffA1);
            PG8_WAIT_V(8); PG8_WAIT_L(0); PG8_BAR; PG8_MMA(0, 0, At, B0); PG8_MMA(0, 1, At, B1); PG8_BAR; PG8_SCHED;
            PG8_LDA(At, 1, 1); PG8_STAGE(PG8_SB(1, 0), b3, voffB); PG8_STAGE(PG8_SB(1, 1), b3 + hstep, voffB); PG8_STAGE(PG8_SA(1, 0), a3, voffA);
            PG8_WAIT_V(8); PG8_WAIT_L(0); PG8_BAR; PG8_MMA(1, 0, At, B0); PG8_MMA(1, 1, At, B1); PG8_BAR; PG8_SCHED;
            } else {
            PG8_LDB(B0, 0, 0); PG8_SCHED; PG8_LDA(At, 0, 0); PG8_STAGE(PG8_SA(1, 1), a1 + hstepA, voffA1);
            PG8_WAIT_L(8); PG8_BAR; PG8_WAIT_L(0); PG8_MMA(0, 0, At, B0); PG8_BAR; PG8_SCHED;
            PG8_LDB(B1, 0, 1); PG8_STAGE(PG8_SB(0, 0), b2, voffB);
            PG8_BAR; PG8_WAIT_L(0); PG8_MMA(0, 1, At, B1); PG8_BAR;
            PG8_LDA(At, 0, 1); PG8_STAGE(PG8_SA(0, 0), a2, voffA);
            PG8_BAR; PG8_WAIT_L(0); PG8_MMA(1, 0, At, B0); PG8_BAR; PG8_SCHED;
            PG8_STAGE(PG8_SB(0, 1), b2 + hstep, voffB);
            PG8_WAIT_V(6); PG8_BAR; PG8_MMA(1, 1, At, B1); PG8_BAR;
            PG8_LDB(B0, 1, 0); PG8_SCHED; PG8_LDA(At, 1, 0); PG8_STAGE(PG8_SA(0, 1), a2 + hstepA, voffA1);
            PG8_WAIT_L(8); PG8_BAR; PG8_WAIT_L(0); PG8_MMA(0, 0, At, B0); PG8_BAR; PG8_SCHED;
            PG8_LDB(B1, 1, 1); PG8_STAGE(PG8_SB(1, 0), b3, voffB);
            PG8_BAR; PG8_WAIT_L(0); PG8_MMA(0, 1, At, B1); PG8_BAR;
            PG8_LDA(At, 1, 1); PG8_STAGE(PG8_SA(1, 0), a3, voffA);
            PG8_BAR; PG8_WAIT_L(0); PG8_MMA(1, 0, At, B0); PG8_BAR; PG8_SCHED;
            PG8_STAGE(PG8_SB(1, 1), b3 + hstep, voffB);
            PG8_WAIT_V(6); PG8_BAR; PG8_MMA(1, 1, At, B1); PG8_BAR;
            }
        }
        if constexpr (ALIGN_EPI) { if (wr == 0) PG8_BAR; }
        if constexpr (!Epi::AFTER_DRAIN) { E(acc, cur, wr, wc, fr, fq); S.done(cur); }
        if (!has_next) break;
#pragma unroll
        for (int a = 0; a < 2; ++a)
#pragma unroll
            for (int b = 0; b < 2; ++b)
#pragma unroll
                for (int m = 0; m < 4; ++m)
#pragma unroll
                    for (int n = 0; n < 2; ++n) acc[a][b][m][n] = (f32x4){0.f, 0.f, 0.f, 0.f};
        cur = nxt; cA = nA; cB = nB; ++ui;
        if constexpr (ALIGN_EPI) { if (wr == 1) PG8_BAR; }
    }
    PG8_WAIT_V(0);
    if constexpr (!ALIGN_EPI) { if (wr == 0) PG8_BAR; }
    PG8_BAR;
    if constexpr (Epi::AFTER_DRAIN) { E.fused(acc, cur, wr, wc, fr, fq, lds, wid, lane); S.done(cur); }
#undef PG8_SA
#undef PG8_SB
#undef PG8_STAGE
#undef PG8_LDA
#undef PG8_LDB
#undef PG8_MMA
#undef PG8_WAIT_V
#undef PG8_WAIT_L
#undef PG8_BAR
#undef PG8_SCHED
}
}

constexpr int NWAVES = 8;
#ifndef MK_N_LAUNCHES
#define MK_N_LAUNCHES 1
#endif
#ifndef SPLIT_MIXERS
#define SPLIT_MIXERS 0
#endif
#ifndef PG_SP2
#define PG_SP2 true
#endif
constexpr int NPHASE = 12;
constexpr int N_LAUNCHES = MK_N_LAUNCHES;
constexpr int BATCH = 8, SEQ = 8192, D = 1024, T = BATCH * SEQ;
constexpr int D_IN = 3688;
constexpr float EPS = 1e-6f;
constexpr int NEXP = 32, DFF = 1024;
constexpr int NTASK = T / 32;
constexpr int MAXBLK = 1056;

constexpr size_t MiB = 1u << 20;
constexpr size_t WS_CTL = 0, CTL_ZERO_BYTES = 64 * 1024;
constexpr int CW_BAR = 1024;
constexpr size_t WS_WIN = 1 * MiB;
constexpr size_t WS_WG = 5 * MiB;
constexpr size_t WS_WUQ = 9 * MiB;
constexpr size_t WS_WUKV = 10 * MiB;
constexpr size_t WS_WBA = 11 * MiB;
constexpr size_t WS_WBB = 12 * MiB;
constexpr size_t WS_WOUT = 13 * MiB;
constexpr size_t WS_TOKE = 15 * MiB;
constexpr size_t WS_TOKG = 16 * MiB;
constexpr size_t WS_TOKR = 17 * MiB;
constexpr size_t WS_CNT = 18 * MiB;
constexpr size_t WS_ROWTOK = 19 * MiB;
constexpr size_t WS_BLKE = 21 * MiB;
constexpr size_t WS_WGU = 24 * MiB;
constexpr size_t WS_WD = 152 * MiB;
constexpr size_t WS_H = 216 * MiB;
constexpr size_t WS_CQ = 344 * MiB;
constexpr size_t WS_CKV = 376 * MiB;
constexpr size_t WS_KPE = 392 * MiB;
constexpr size_t WS_KB = 396 * MiB;
constexpr size_t WS_VB = 404 * MiB;
constexpr size_t WS_KIDX = 412 * MiB;
constexpr size_t WS_WIDX = 420 * MiB;
constexpr size_t WS_QB = 424 * MiB;
constexpr size_t WS_QIDX = 488 * MiB;
constexpr size_t WS_QMLA = 552 * MiB;
constexpr size_t WS_KV = 648 * MiB;
constexpr size_t WS_YA = 776 * MiB;
constexpr size_t WS_YB = 840 * MiB;
constexpr size_t WS_G = 344 * MiB;
constexpr size_t WS_M = 600 * MiB;
constexpr size_t WS_YBUF = 216 * MiB;
constexpr size_t WS_SCR = 728 * MiB;
constexpr size_t WS_XN2 = 856 * MiB;
constexpr size_t WS_ROWSRC = 22 * MiB;
constexpr size_t WS_CS16 = 984 * MiB;
constexpr size_t WS_CS32 = 988 * MiB;
constexpr size_t WS_TAILACT = 990 * MiB;
constexpr size_t WS_RSTOK = 1006 * MiB;
constexpr size_t WS_ROWRS = 1007 * MiB;
constexpr size_t WS_END = 1009 * MiB;

constexpr int RING_BYTES = 131072;
constexpr int LDS_BYTES = 163840;
constexpr int MISC_OFF = LDS_BYTES - 64;

#define GAS __attribute__((address_space(1)))
#define LAS __attribute__((address_space(3)))
typedef unsigned short bf16;
typedef unsigned v4u __attribute__((ext_vector_type(4)));
typedef unsigned v2u __attribute__((ext_vector_type(2)));
typedef float f32x4 __attribute__((ext_vector_type(4)));
typedef float f32x2 __attribute__((ext_vector_type(2)));
typedef float f32x16 __attribute__((ext_vector_type(16)));
typedef short bf16x8 __attribute__((ext_vector_type(8)));
typedef short s16x4 __attribute__((ext_vector_type(4)));
typedef GAS unsigned gu32;
#define RLX_AGENT __ATOMIC_RELAXED, __HIP_MEMORY_SCOPE_AGENT
#define LDS_WAIT() asm volatile("s_waitcnt lgkmcnt(0)" ::: "memory")
#define VM_WAIT() asm volatile("s_waitcnt vmcnt(0)" ::: "memory")
__device__ __forceinline__ unsigned f2bf(float f) { unsigned u = __builtin_bit_cast(unsigned, f); return (u + 0x7fffu + ((u >> 16) & 1u)) >> 16; }
__device__ __forceinline__ unsigned pk2(float lo, float hi) { return f2bf(lo) | (f2bf(hi) << 16); }
__device__ __forceinline__ float bf2f(unsigned short b) { return __builtin_bit_cast(float, (unsigned)b << 16); }
__device__ __forceinline__ float bflo(unsigned w) { return __builtin_bit_cast(float, w << 16); }
__device__ __forceinline__ float bfhi(unsigned w) { return __builtin_bit_cast(float, w & 0xffff0000u); }
__device__ __forceinline__ float wave_sum(float v) {
#pragma unroll
    for (int o = 1; o < 64; o <<= 1) v += __shfl_xor(v, o);
    return v;
}

namespace pg8 {
typedef unsigned u32x4 __attribute__((ext_vector_type(4)));
__device__ __forceinline__ u32x4 pack8(const f32x4 a, const f32x4 b) { u32x4 w; w.x = cvt_pk_bf16(a[0], a[1]); w.y = cvt_pk_bf16(a[2], a[3]); w.z = cvt_pk_bf16(b[0], b[1]); w.w = cvt_pk_bf16(b[2], b[3]); return w; }
__device__ __forceinline__ void unpack8(const u32x4 w, f32x4& a, f32x4& b) {
    a[0] = __builtin_bit_cast(float, w.x << 16); a[1] = __builtin_bit_cast(float, w.x & 0xffff0000u); a[2] = __builtin_bit_cast(float, w.y << 16); a[3] = __builtin_bit_cast(float, w.y & 0xffff0000u);
    b[0] = __builtin_bit_cast(float, w.z << 16); b[1] = __builtin_bit_cast(float, w.z & 0xffff0000u); b[2] = __builtin_bit_cast(float, w.w << 16); b[3] = __builtin_bit_cast(float, w.w & 0xffff0000u); }
__device__ __forceinline__ float sigmoidf_(float v) { return __builtin_amdgcn_rcpf(1.f + __builtin_amdgcn_exp2f(-1.4426950408889634f * v)); }

#define EPI_LOOP_BEGIN const int row0 = u.pm * BM + wr * 64 + fr; \
    _Pragma("unroll") for (int ai = 0; ai < 2; ++ai) _Pragma("unroll") for (int m = 0; m < 4; ++m) { const int row = row0 + ai * HALF + m * 16; \
    _Pragma("unroll") for (int bj = 0; bj < 2; ++bj) { const int cg = bj * HALF + wc * 32 + 8 * fq; const f32x4 v0 = acc[ai][bj][m][0], v1 = acc[ai][bj][m][1];
#define EPI_LOOP_END } }

struct EpiStore {
    static constexpr bool PERM = true, AFTER_DRAIN = false;
    bf16_t* O; int ldc;
    __device__ __forceinline__ void operator()(const f32x4 (&acc)[2][2][4][2], const Unit& u, int wr, int wc, int fr, int fq) const {
        EPI_LOOP_BEGIN
            { const u32x4 w_ = pack8(v0, v1); CHKW_S(8, w_.x + w_.y + w_.z + w_.w); *(u32x4*)(O + (size_t)row * ldc + u.pn * BM + cg) = w_; }
        EPI_LOOP_END
    }
};
struct EpiZ {
    static constexpr bool PERM = true, AFTER_DRAIN = false;
    bf16_t *cq, *ckv, *kpe, *kb, *vb, *kidx, *qb, *qidx; float* widx;
    __device__ __forceinline__ void operator()(const f32x4 (&acc)[2][2][4][2], const Unit& u, int wr, int wc, int fr, int fq) const {
        const int pn = u.pn;
        EPI_LOOP_BEGIN
            const u32x4 w = pack8(v0, v1); CHKW_S(9, w.x + w.y + w.z + w.w);
            if (pn == 0) *(u32x4*)(cq + (size_t)row * 256 + cg) = w;
            else if (pn == 1) {
                if (cg < 128) *(u32x4*)(ckv + (size_t)row * 128 + cg) = w;
                else if (cg < 160) *(u32x4*)(kpe + (size_t)row * 32 + (cg - 128)) = w;
                else if (cg < 224) *(u32x4*)(kb + (size_t)row * 64 + (cg - 160)) = w;
            } else if (pn == 2) {
                if (cg < 64) *(u32x4*)(vb + (size_t)row * 64 + cg) = w;
                else if (cg < 128) { const int d_ = cg - 64;
                    *(u32x4*)(kidx + ((size_t)((row >> 13) * 4 + (d_ >> 4)) * 8192 + (row & 8191)) * 16 + ((d_ >> 3) & 1) * 8) = w; }
                else if (cg < 136) { *(f32x4*)(widx + (size_t)row * 8) = v0; *(f32x4*)(widx + (size_t)row * 8 + 4) = v1; }
            } else if (pn < 5) *(u32x4*)(qb + (size_t)row * 512 + (pn - 3) * 256 + cg) = w;
            else *(u32x4*)(qidx + (size_t)row * 512 + (pn - 5) * 256 + cg) = w;
        EPI_LOOP_END
    }
};
struct EpiGate {
    static constexpr bool PERM = true, AFTER_DRAIN = false;
    bf16_t* G;
    __device__ __forceinline__ void operator()(const f32x4 (&acc)[2][2][4][2], const Unit& u, int wr, int wc, int fr, int fq) const {
        EPI_LOOP_BEGIN
            f32x4 a, b;
#pragma unroll
            for (int i = 0; i < 4; ++i) { a[i] = sigmoidf_(v0[i]); b[i] = sigmoidf_(v1[i]); }
            { const u32x4 w_ = pack8(a, b); CHKW_S(10, w_.x + w_.y + w_.z + w_.w); *(u32x4*)(G + (size_t)row * 2048 + u.pn * BM + cg) = w_; }
        EPI_LOOP_END
    }
};
template <int SECOND> struct EpiMerge {
    static constexpr bool PERM = true, AFTER_DRAIN = false;
    const bf16_t* G; bf16_t* Mo;
    __device__ __forceinline__ void operator()(const f32x4 (&acc)[2][2][4][2], const Unit& u, int wr, int wc, int fr, int fq) const {
        const int row0 = u.pm * BM + wr * 64 + fr;
#pragma unroll
        for (int ai = 0; ai < 2; ++ai) {
            u32x4 gq[4][2], mq[4][2];
#pragma unroll
            for (int m = 0; m < 4; ++m)
#pragma unroll
                for (int bj = 0; bj < 2; ++bj) { const int row = row0 + ai * HALF + m * 16, col = u.pn * BM + bj * HALF + wc * 32 + 8 * fq;
                    gq[m][bj] = *(const u32x4*)(G + (size_t)row * 2048 + SECOND * 1024 + col);
                    if (SECOND) mq[m][bj] = *(const u32x4*)(Mo + (size_t)row * 1024 + col); }
            asm volatile("" ::: "memory");
#pragma unroll
            for (int m = 0; m < 4; ++m)
#pragma unroll
                for (int bj = 0; bj < 2; ++bj) { const int row = row0 + ai * HALF + m * 16, col = u.pn * BM + bj * HALF + wc * 32 + 8 * fq;
                    f32x4 ga, gb; unpack8(gq[m][bj], ga, gb);
                    f32x4 a = ga * acc[ai][bj][m][0], b = gb * acc[ai][bj][m][1];
                    if (SECOND) { f32x4 pa, pb; unpack8(mq[m][bj], pa, pb); a = a + pa; b = b + pb; }
                    { const u32x4 w_ = pack8(a, b); CHKW_S(11, w_.x + w_.y + w_.z + w_.w); *(u32x4*)(Mo + (size_t)row * 1024 + col) = w_; } }
        }
    }
};
struct EpiX1 {
    static constexpr bool PERM = true, AFTER_DRAIN = false;
    const float* x; float* out; const float* fg; bf16_t* xb;
    __device__ __forceinline__ void operator()(const f32x4 (&acc)[2][2][4][2], const Unit& u, int wr, int wc, int fr, int fq) const {
        const int row0 = u.pm * BM + wr * 64 + fr;
        f32x4 gv[2][2];
#pragma unroll
        for (int bj = 0; bj < 2; ++bj) { const int cgl = u.pn * BM + bj * HALF + wc * 32 + 8 * fq; gv[bj][0] = *(const f32x4*)(fg + cgl); gv[bj][1] = *(const f32x4*)(fg + cgl + 4); }
#pragma unroll
        for (int ai = 0; ai < 2; ++ai) {
            f32x4 xq[4][2][2];
#pragma unroll
            for (int m = 0; m < 4; ++m)
#pragma unroll
                for (int bj = 0; bj < 2; ++bj) { const size_t off = (size_t)(row0 + ai * HALF + m * 16) * 1024 + u.pn * BM + bj * HALF + wc * 32 + 8 * fq;
                    xq[m][bj][0] = *(const f32x4*)(x + off); xq[m][bj][1] = *(const f32x4*)(x + off + 4); }
            asm volatile("" ::: "memory");
#pragma unroll
            for (int m = 0; m < 4; ++m)
#pragma unroll
                for (int bj = 0; bj < 2; ++bj) { const size_t off = (size_t)(row0 + ai * HALF + m * 16) * 1024 + u.pn * BM + bj * HALF + wc * 32 + 8 * fq;
                    const f32x4 r0_ = xq[m][bj][0] + acc[ai][bj][m][0], r1_ = xq[m][bj][1] + acc[ai][bj][m][1];
                    CHKW_S(12, __builtin_bit_cast(unsigned, r0_[0]) + __builtin_bit_cast(unsigned, r0_[1]) + __builtin_bit_cast(unsigned, r0_[2]) + __builtin_bit_cast(unsigned, r0_[3]) + __builtin_bit_cast(unsigned, r1_[0]) + __builtin_bit_cast(unsigned, r1_[1]) + __builtin_bit_cast(unsigned, r1_[2]) + __builtin_bit_cast(unsigned, r1_[3]));
                    *(f32x4*)(out + off) = r0_; *(f32x4*)(out + off + 4) = r1_;
                    *(u32x4*)(xb + off) = pack8(r0_ * gv[bj][0], r1_ * gv[bj][1]); }
        }
    }
};
struct EpiGU {
    static constexpr bool PERM = true, AFTER_DRAIN = false;
    bf16_t* act; const float* bgu; const float* rs;
    __device__ __forceinline__ void operator()(const f32x4 (&acc)[2][2][4][2], const Unit& u, int wr, int wc, int fr, int fq) const {
        typedef unsigned u32x2 __attribute__((ext_vector_type(2)));
        const int pnl = u.pn & 7, col = pnl * 128 + wc * 32 + 8 * fq;
        float rr[2][4]; f32x4 bgv[2], blv[2];
#pragma unroll
        for (int ai = 0; ai < 2; ++ai)
#pragma unroll
            for (int m = 0; m < 4; ++m) rr[ai][m] = rs[ai * HALF + wr * 64 + m * 16 + fr];
#pragma unroll
        for (int n = 0; n < 2; ++n) { bgv[n] = *(const f32x4*)(bgu + col + 4 * n); blv[n] = *(const f32x4*)(bgu + 1024 + col + 4 * n) + 1.f; }
        asm volatile("" ::: "memory");
#pragma unroll
        for (int n = 0; n < 2; ++n) {
            const f32x4 bg = bgv[n], bl = blv[n];
#pragma unroll
            for (int ai = 0; ai < 2; ++ai)
#pragma unroll
                for (int m = 0; m < 4; ++m) { const int row = ai * HALF + wr * 64 + m * 16 + fr; const float rq = rr[ai][m];
                    const f32x4 g = acc[ai][0][m][n] * rq + bg, l1 = acc[ai][1][m][n] * rq + bl; f32x4 o;
#pragma unroll
                    for (int i = 0; i < 4; ++i) { const float gl = fminf(g[i], 7.f), li1 = fminf(fmaxf(l1[i], -6.f), 8.f);
                        o[i] = gl * __builtin_amdgcn_rcpf(1.f + __builtin_amdgcn_exp2f(gl * (-1.702f * 1.4426950408889634f))) * li1; }
                    u32x2 w; w.x = cvt_pk_bf16(o[0], o[1]); w.y = cvt_pk_bf16(o[2], o[3]); CHKW_S(13, w.x + w.y);
                    *(u32x2*)(act + (size_t)row * 1024 + col + 4 * n) = w; }
        }
    }
};
struct EpiDown {
    static constexpr bool PERM = true, AFTER_DRAIN = false;
    bf16_t* ybuf; const float* bd; const int* rowtok;
    __device__ __forceinline__ void operator()(const f32x4 (&acc)[2][2][4][2], const Unit& u, int wr, int wc, int fr, int fq) const {
        const int pnl = u.pn & 3;
        int dstv[2][4]; f32x4 bv[2][2];
#pragma unroll
        for (int ai = 0; ai < 2; ++ai)
#pragma unroll
            for (int m = 0; m < 4; ++m) dstv[ai][m] = rowtok[ai * HALF + wr * 64 + m * 16 + fr];
#pragma unroll
        for (int bj = 0; bj < 2; ++bj) { const int col = pnl * BM + bj * HALF + wc * 32 + 8 * fq; bv[bj][0] = *(const f32x4*)(bd + col); bv[bj][1] = *(const f32x4*)(bd + col + 4); }
        asm volatile("" ::: "memory");
#pragma unroll
        for (int ai = 0; ai < 2; ++ai)
#pragma unroll
            for (int m = 0; m < 4; ++m) { const int dst = dstv[ai][m];
                if (dst >= 0) {
#pragma unroll
                    for (int bj = 0; bj < 2; ++bj) { const int col = pnl * BM + bj * HALF + wc * 32 + 8 * fq;
                        { const u32x4 w_ = pack8(acc[ai][bj][m][0] + bv[bj][0], acc[ai][bj][m][1] + bv[bj][1]); CHKW_S(14, w_.x + w_.y + w_.z + w_.w); *(u32x4*)(ybuf + (size_t)dst * 1024 + col) = w_; } } } }
    }
};
template <bool GATHER_> struct ListOrderT {
    static constexpr bool GATHER = GATHER_;
    int n, pn0, z; const int* rows;
    __device__ __forceinline__ bool next(int i, Unit& u) const { if (i >= n) return false; u.pm = 0; u.pn = pn0 + i; return true; }
    __device__ __forceinline__ int tid_bias() const { return z; }
    __device__ __forceinline__ void a_ready(const Unit&) const {}
    __device__ __forceinline__ void done(const Unit&) const {}
};
}
#define XB_TMO      128
#define XB_XCNT(j)  (256  + 64 * (j))
#define XB_XSUB(j)  (1280 + 64 * (j))
#define XB_XGEN(j)  (2304 + 64 * (j))
#define XB_TOP      3328
#define XB_TOPGEN   3392
#define XCD_BAR_WORDS 3456
#define XB_SPIN_CAP (1u << 18)

__device__ __forceinline__ unsigned xb_ld(unsigned* p)              { return __hip_atomic_load(p, __ATOMIC_RELAXED, __HIP_MEMORY_SCOPE_AGENT); }
__device__ __forceinline__ unsigned xb_add(unsigned* p, unsigned v) { return __hip_atomic_fetch_add(p, v, __ATOMIC_RELAXED, __HIP_MEMORY_SCOPE_AGENT); }
__device__ __forceinline__ unsigned xb_xcc_id() { return (unsigned)__builtin_amdgcn_s_getreg((3 << 11) | 20) & 0xFu; }
#define XB_SPIN(cond, bar) do { unsigned _sp = 0; while (cond) { __builtin_amdgcn_s_sleep(1); \
    if ((++_sp & 255u) == 0u) { if (xb_ld(&(bar)[XB_TMO])) break; if (_sp > XB_SPIN_CAP) { atomicAdd(&(bar)[XB_TMO], 1u); break; } } } } while (0)

struct XcdBarrier {
    unsigned* bar; unsigned x;
    volatile LAS unsigned* st;
};

__device__ __forceinline__ XcdBarrier xcd_barrier_post(unsigned* bar, volatile LAS unsigned* st) {
    XcdBarrier b; b.bar = bar; b.x = xb_xcc_id(); b.st = st;
    if (threadIdx.x == 0) (void)xb_add(&bar[XB_XCNT(b.x)], 1u);
    return b;
}
__device__ __forceinline__ void xcd_barrier_complete(unsigned* bar, unsigned x, unsigned& nloc, unsigned& nx) {
    const unsigned G = gridDim.x * gridDim.y * gridDim.z;
    unsigned sum, cnt, mine, sp = 0u;
    for (;;) {
        sum = 0u; cnt = 0u; mine = 0u;
#pragma unroll
        for (unsigned j = 0; j < 16; ++j) { const unsigned c = xb_ld(&bar[XB_XCNT(j)]); sum += c; cnt += (c > 0u) ? 1u : 0u; mine = (j == x) ? c : mine; }
        if (sum == G) break;
        __builtin_amdgcn_s_sleep(1);
        if ((++sp & 255u) == 0u) { if (xb_ld(&bar[XB_TMO])) break; if (sp > XB_SPIN_CAP) { atomicAdd(&bar[XB_TMO], 1u); break; } }
    }
    nloc = mine > 0u ? mine : 1u; nx = cnt > 0u ? cnt : 1u;
}

__device__ __forceinline__ void xcd_barrier(const XcdBarrier& b) {
    asm volatile("s_waitcnt vmcnt(0)" ::: "memory");
    __syncthreads();
    if (threadIdx.x == 0) {
        unsigned* bar = b.bar;
        __builtin_amdgcn_s_waitcnt(0);
        unsigned nloc = b.st[0], nx = b.st[1];
        if (nloc == 0u) { xcd_barrier_complete(bar, b.x, nloc, nx); b.st[0] = nloc; b.st[1] = nx; }
        const unsigned old = xb_add(&bar[XB_XSUB(b.x)], 1u);
        const unsigned gen = old / nloc;
        if (old + 1u == (gen + 1u) * nloc) {
            __builtin_amdgcn_fence(__ATOMIC_RELEASE, "agent");
            asm volatile("s_waitcnt vmcnt(0)" ::: "memory");
            const unsigned og = xb_add(&bar[XB_TOP], 1u);
            const unsigned tg = og / nx;
            if (og + 1u == (tg + 1u) * nx) xb_add(&bar[XB_TOPGEN], 1u);
            else XB_SPIN(xb_ld(&bar[XB_TOPGEN]) == tg, bar);
            __builtin_amdgcn_fence(__ATOMIC_ACQUIRE, "agent");
            xb_add(&bar[XB_XGEN(b.x)], 1u);
            asm volatile("s_waitcnt vmcnt(0)" ::: "memory");
        } else {
            XB_SPIN(xb_ld(&bar[XB_XGEN(b.x)]) == gen, bar);
            __builtin_amdgcn_fence(__ATOMIC_ACQUIRE, "agent");
            asm volatile("s_waitcnt vmcnt(0)" ::: "memory");
        }
    }
    __syncthreads();
}

struct Frame {
    LAS unsigned char* lds;
    volatile LAS unsigned* MISC;
    gu32* ctl;
    int tid, lane, wave;
    int vcu, G;
    unsigned char* ws;
    const float* x; const int* pos; float* out;
    const float *attn_g, *w_in, *qn_g, *w_uq, *kvn_g, *w_ukv, *w_ba, *w_bb, *w_out, *ffn_g, *r_w, *r_b, *w_gu, *b_gu, *w_d, *b_d, *fin_g;
};
#define WSP(T_, off) ((T_*)(F.ws + (off)))

__constant__ float c_inv16[8] = {1.000000000e+00f, 1.939227432e-01f, 3.760603070e-02f, 7.292664610e-03f, 1.414213562e-03f, 2.742481884e-04f, 5.318295734e-05f, 1.031338525e-05f};
__constant__ float c_inv32[16] = {1.000000000e+00f, 4.403665960e-01f, 1.939227432e-01f, 8.539710194e-02f, 3.760603070e-02f, 1.656044088e-02f, 7.292664610e-03f, 3.211446106e-03f,
                                  1.414213562e-03f, 6.227724371e-04f, 2.742481884e-04f, 1.207697351e-04f, 5.318295734e-05f, 2.341999971e-05f, 1.031338525e-05f, 4.541670478e-06f};

__device__ __forceinline__ int map_win(int n) {
    const int t = n >> 8, j = n & 255;
    if (t == 0) return j;
    if (t == 1) return j < 128 ? 256 + j : j < 160 ? 384 + (j - 128) : j < 224 ? 928 + (j - 160) : -1;
    if (t == 2) return j < 64 ? 992 + j : j < 128 ? 1568 + (j - 64) : j < 136 ? 1632 + (j - 128) : -1;
    if (t < 5) return 416 + (n - 768);
    return 1056 + (n - 1280);
}
__device__ __forceinline__ int map_gu(int n) { const int pn = n >> 8, bj = (n >> 7) & 1, cc = n & 127; return bj * 1024 + pn * 128 + cc; }
template <int MAP>
__device__ __forceinline__ void p0_item(const float* W, int ldw, int K, bf16* WT, int coff, LAS float* scr, int kb, int nb, int lane) {
    const int k0 = 64 * kb, n0 = 32 * nb, nn = n0 + (lane & 31);
    const int col = MAP == 1 ? map_win(nn) : MAP == 2 ? map_gu(nn) : nn + coff;
    float wv[32];
#pragma unroll
    for (int i = 0; i < 32; ++i) { const int kk = 2 * i + (lane >> 5); wv[i] = col >= 0 ? W[(size_t)(k0 + kk) * ldw + col] : 0.f; }
#pragma unroll
    for (int i = 0; i < 32; ++i) { const int kk = 2 * i + (lane >> 5); scr[kk * 33 + (lane & 31)] = wv[i]; }
    LDS_WAIT(); asm volatile("" ::: "memory");
    const int c = lane & 7;
#pragma unroll
    for (int j = 0; j < 4; ++j) { const int n = (lane >> 3) + 8 * j; const LAS float* s = scr + (8 * c) * 33 + n;
        v4u o; o.x = pk2(s[0 * 33], s[1 * 33]); o.y = pk2(s[2 * 33], s[3 * 33]); o.z = pk2(s[4 * 33], s[5 * 33]); o.w = pk2(s[6 * 33], s[7 * 33]);
        CHKW_S(4, o.x + o.y + o.z + o.w); *(GAS v4u*)(WT + (size_t)(n0 + n) * K + k0 + 8 * c) = o; }
    LDS_WAIT(); asm volatile("" ::: "memory");
}
__device__ __forceinline__ void rms_row_to_bf16(const float* xrow, const float* g, bf16* orow, int lane) {
    const GAS f32x4* xr = (const GAS f32x4*)xrow + lane; const GAS f32x4* gr = (const GAS f32x4*)g + lane;
    f32x4 v[4]; float s = 0.f;
#pragma unroll
    for (int j = 0; j < 4; ++j) { v[j] = xr[64 * j]; s += (v[j].x * v[j].x + v[j].y * v[j].y) + (v[j].z * v[j].z + v[j].w * v[j].w); }
    const float rstd = 1.f / sqrtf(wave_sum(s) * (1.f / 1024.f) + EPS);
    GAS unsigned long long* o8 = (GAS unsigned long long*)orow + lane;
#pragma unroll
    for (int j = 0; j < 4; ++j) { const f32x4 gg = gr[64 * j];
        const unsigned long long ov_ = (unsigned long long)pk2(v[j].x * rstd * gg.x, v[j].y * rstd * gg.y) | ((unsigned long long)pk2(v[j].z * rstd * gg.z, v[j].w * rstd * gg.w) << 32); CHKW_S(4, (unsigned)ov_ + (unsigned)(ov_ >> 32)); o8[64 * j] = ov_; }
}
__device__ __forceinline__ void sincos_rev(float ang, float& c, float& s) {
    double r = (double)ang * 0.15915494309189535; r -= __builtin_rint(r); const float rf = (float)r;
    s = __builtin_amdgcn_sinf(rf); c = __builtin_amdgcn_cosf(rf);
}
__device__ __forceinline__ void p0_prologue(Frame& F) {
    LAS float* scr = (LAS float*)(F.lds + F.wave * 16384);
    const int gw = F.vcu * NWAVES + F.wave, NGW = F.G * NWAVES;
    constexpr int I_GU = 32 * 16 * 64, I_D = 32 * 16 * 32, I_IN = 16 * 56, I_G = 16 * 64, I_UQ = 4 * 24, I_UKV = 2 * 32, I_BA = 8 * 32, I_BB = 8 * 32, I_OUT = 16 * 32;
    constexpr int NITEMS = I_GU + I_D + I_IN + I_G + I_UQ + I_UKV + I_BA + I_BB + I_OUT;
    for (int it = gw; it < NITEMS; it += NGW) {
        int r = it;
        if (r < I_GU) { const int e = r >> 10, q = r & 1023; p0_item<2>(F.w_gu + (size_t)e * 1024 * 2048, 2048, 1024, WSP(bf16, WS_WGU) + (size_t)e * 2048 * 1024, 0, scr, q >> 6, q & 63, F.lane); continue; } r -= I_GU;
        if (r < I_D) { const int e = r >> 9, q = r & 511; p0_item<0>(F.w_d + (size_t)e * 1024 * 1024, 1024, 1024, WSP(bf16, WS_WD) + (size_t)e * 1024 * 1024, 0, scr, q >> 5, q & 31, F.lane); continue; } r -= I_D;
        if (r < I_IN) { p0_item<1>(F.w_in, D_IN, 1024, WSP(bf16, WS_WIN), 0, scr, r / 56, r % 56, F.lane); continue; } r -= I_IN;
        if (r < I_G) { p0_item<0>(F.w_in, D_IN, 1024, WSP(bf16, WS_WG), 1640, scr, r >> 6, r & 63, F.lane); continue; } r -= I_G;
        if (r < I_UQ) { p0_item<0>(F.w_uq, 768, 256, WSP(bf16, WS_WUQ), 0, scr, r / 24, r % 24, F.lane); continue; } r -= I_UQ;
        if (r < I_UKV) { p0_item<0>(F.w_ukv, 1024, 128, WSP(bf16, WS_WUKV), 0, scr, r >> 5, r & 31, F.lane); continue; } r -= I_UKV;
        if (r < I_BA) { p0_item<0>(F.w_ba, 1024, 512, WSP(bf16, WS_WBA), 0, scr, r >> 5, r & 31, F.lane); continue; } r -= I_BA;
        if (r < I_BB) { p0_item<0>(F.w_bb, 1024, 512, WSP(bf16, WS_WBB), 0, scr, r >> 5, r & 31, F.lane); continue; } r -= I_BB;
        p0_item<0>(F.w_out, 1024, 1024, WSP(bf16, WS_WOUT), 0, scr, r >> 5, r & 31, F.lane);
    }
    for (int m = gw; m < T; m += NGW) rms_row_to_bf16(F.x + (size_t)m * D, F.attn_g, WSP(bf16, WS_H) + (size_t)m * D, F.lane);
    { const int gt = F.vcu * (NWAVES * 64) + F.tid, NGT = F.G * NWAVES * 64;
      f32x2* cs16 = WSP(f32x2, WS_CS16); f32x2* cs32 = WSP(f32x2, WS_CS32);
      for (int q = gt; q < T * 8; q += NGT) { const int t = q >> 3, i = q & 7; float c, s; sincos_rev((float)F.pos[t] * c_inv16[i], c, s); cs16[q] = (f32x2){c, s}; }
      for (int q = gt; q < T * 16; q += NGT) { const int t = q >> 4, i = q & 15; float c, s; sincos_rev((float)F.pos[t] * c_inv32[i], c, s); cs32[q] = (f32x2){c, s}; } }
}

__device__ __forceinline__ void p2_token_pass(Frame& F) {
    const int gw = F.vcu * NWAVES + F.wave, NGW = F.G * NWAVES, lane = F.lane;
    bf16 *cq = WSP(bf16, WS_CQ), *ckv = WSP(bf16, WS_CKV), *kpe = WSP(bf16, WS_KPE), *kb = WSP(bf16, WS_KB), *kidx = WSP(bf16, WS_KIDX), *qb = WSP(bf16, WS_QB), *qidx = WSP(bf16, WS_QIDX);
    const f32x2* cs16 = WSP(f32x2, WS_CS16); const f32x2* cs32 = WSP(f32x2, WS_CS32);
    const f32x4 gq = *((const GAS f32x4*)F.qn_g + lane); const f32x2 gk = *((const GAS f32x2*)F.kvn_g + lane);
    (void)gw; (void)NGW;
    for (int j = 0; j < 32; ++j) { const int t = (F.vcu >> 5) * SEQ + ((F.vcu & 31) * NWAVES + F.wave) + 256 * j;
        { GAS v2u* p = (GAS v2u*)(cq + (size_t)t * 256) + lane; const v2u w = *p;
          const float a = bflo(w.x), b = bfhi(w.x), c = bflo(w.y), d = bfhi(w.y);
          const float rstd = 1.f / sqrtf(wave_sum(a * a + b * b + c * c + d * d) * (1.f / 256.f) + EPS);
          v2u o; o.x = pk2(a * rstd * gq.x, b * rstd * gq.y); o.y = pk2(c * rstd * gq.z, d * rstd * gq.w); CHKW_S(5, o.x + o.y); *p = o; }
        { GAS unsigned* p = (GAS unsigned*)(ckv + (size_t)t * 128) + lane; const unsigned w = *p;
          const float a = bflo(w), b = bfhi(w);
          const float rstd = 1.f / sqrtf(wave_sum(a * a + b * b) * (1.f / 128.f) + EPS);
          { const unsigned ov_ = pk2(a * rstd * gk.x, b * rstd * gk.y); CHKW_S(5, ov_); *p = ov_; } }
        const f32x2 cs = cs16[(size_t)t * 8 + (lane & 7)];
        { bf16* p = qb + (size_t)t * 512 + (lane >> 3) * 64 + (lane & 7); const float x1 = bf2f(p[0]), x2 = bf2f(p[8]);
          { const unsigned a_ = f2bf(x1 * cs.x - x2 * cs.y), b_ = f2bf(x2 * cs.x + x1 * cs.y); CHKW_S(5, a_ + b_); p[0] = (bf16)a_; p[8] = (bf16)b_; } }
        { bf16* p = qidx + (size_t)t * 512 + (lane >> 3) * 64 + (lane & 7); const float x1 = bf2f(p[0]), x2 = bf2f(p[8]);
          { const unsigned a_ = f2bf(x1 * cs.x - x2 * cs.y), b_ = f2bf(x2 * cs.x + x1 * cs.y); CHKW_S(5, a_ + b_); p[0] = (bf16)a_; p[8] = (bf16)b_; } }
        if (lane < 8) { bf16* p = kb + (size_t)t * 64 + lane; const float x1 = bf2f(p[0]), x2 = bf2f(p[8]);
          { const unsigned a_ = f2bf(x1 * cs.x - x2 * cs.y), b_ = f2bf(x2 * cs.x + x1 * cs.y); CHKW_S(5, a_ + b_); p[0] = (bf16)a_; p[8] = (bf16)b_; } }
        else if (lane < 16) { bf16* p = kidx + ((size_t)((t >> 13) * 4) * 8192 + (t & 8191)) * 16 + (lane - 8); const float x1 = bf2f(p[0]), x2 = bf2f(p[8]);
          { const unsigned a_ = f2bf(x1 * cs.x - x2 * cs.y), b_ = f2bf(x2 * cs.x + x1 * cs.y); CHKW_S(5, a_ + b_); p[0] = (bf16)a_; p[8] = (bf16)b_; } }
        else if (lane < 32) { const int i = lane - 16; const f32x2 c2 = cs32[(size_t)t * 16 + i]; bf16* p = kpe + (size_t)t * 32 + i; const float x1 = bf2f(p[0]), x2 = bf2f(p[16]);
          { const unsigned a_ = f2bf(x1 * c2.x - x2 * c2.y), b_ = f2bf(x2 * c2.x + x1 * c2.y); CHKW_S(5, a_ + b_); p[0] = (bf16)a_; p[16] = (bf16)b_; } }
    }
}

namespace mla {
#ifndef MLA_FASTPATH
#define MLA_FASTPATH 1
#endif
constexpr int KPITCH = 208, KBUF = 64 * KPITCH, VBUF = 8192, BUFB = 2 * (KBUF + VBUF), LDS_WSF = 2 * BUFB, LDS_OST = LDS_WSF + 8 * 256, LDS_BYTES_USED = LDS_OST + 8 * 4096;
constexpr float QSCALE = 0.10206207261596575f * 1.4426950408889634f;
typedef short v4i16_t __attribute__((ext_vector_type(4)));
__device__ __forceinline__ int crow(int r, int hi) { return (r & 3) + 8 * (r >> 2) + 4 * hi; }
__device__ __forceinline__ s16x4 vtr(const LAS unsigned char* p) { return __builtin_bit_cast(s16x4, __builtin_amdgcn_ds_read_tr16_b64_v4i16((LAS v4i16_t*)p)); }
__device__ __forceinline__ unsigned cvtpk(float lo, float hi) { typedef float f2 __attribute__((ext_vector_type(2))); typedef __bf16 b2 __attribute__((ext_vector_type(2)));
    f2 v = {lo, hi}; b2 b = __builtin_convertvector(v, b2); return __builtin_bit_cast(unsigned, b); }

__device__ __forceinline__ float mla_halfmax(float x, float pinf) { const unsigned u = __builtin_bit_cast(unsigned, x); auto r = __builtin_amdgcn_permlane32_swap(u, u, false, false);
    return __builtin_amdgcn_fmed3f(__builtin_bit_cast(float, r[0]), __builtin_bit_cast(float, r[1]), pinf); }
template <int VAR> __device__ __forceinline__ void unit(int zb, int b, int h, int qb, const bf16* qmla, const bf16* kv, const bf16* kpe, const f32x2* cs32, bf16* ya, LAS unsigned char* shm) {
    int tid = zb; asm volatile("" : "+v"(tid));
    float pinf = INFINITY; asm volatile("" : "+s"(pinf));
    const int lane = tid & 63, r32 = lane & 31, hi = lane >> 5; const int wid = __builtin_amdgcn_readfirstlane(tid >> 6);
    const size_t rowbase = (size_t)b * SEQ; const int q0 = qb * 256;
    LAS float* wsf = (LAS float*)(shm + LDS_WSF) + wid * 64;
    bf16x8 qr[6];
    { const size_t tq = rowbase + q0 + wid * 32 + r32; const bf16* Qrow = qmla + tq * 768 + h * 96 + 8 * hi;
      v4u raw[6];
#pragma unroll
      for (int d0 = 0; d0 < 6; ++d0) raw[d0] = *(const GAS v4u*)(Qrow + 16 * d0);
      const GAS f32x4* csp = (const GAS f32x4*)(cs32 + tq * 16 + 8 * hi);
      f32x4 cs[4];
#pragma unroll
      for (int i = 0; i < 4; ++i) cs[i] = csp[i];
#pragma unroll
      for (int d0 = 0; d0 < 4; ++d0) { v4u o;
#pragma unroll
          for (int w = 0; w < 4; ++w) o[w] = cvtpk(bflo(raw[d0][w]) * QSCALE, bfhi(raw[d0][w]) * QSCALE);
          qr[d0] = __builtin_bit_cast(bf16x8, o); }
      v4u o4, o5;
#pragma unroll
      for (int w = 0; w < 4; ++w) {
          const float a0 = bflo(raw[4][w]), a1 = bfhi(raw[4][w]), b0 = bflo(raw[5][w]), b1 = bfhi(raw[5][w]);
          const float c0 = cs[w][0], s0 = cs[w][1], c1 = cs[w][2], s1 = cs[w][3];
          o4[w] = cvtpk((a0 * c0 - b0 * s0) * QSCALE, (a1 * c1 - b1 * s1) * QSCALE);
          o5[w] = cvtpk((b0 * c0 + a0 * s0) * QSCALE, (b1 * c1 + a1 * s1) * QSCALE); }
      qr[4] = __builtin_bit_cast(bf16x8, o4); qr[5] = __builtin_bit_cast(bf16x8, o5); }
    const bf16* kn_src = kv + (rowbase + (tid >> 3)) * 1024 + h * 128 + (tid & 7) * 8;
    const bf16* vv_src = kn_src + 64;
    const bf16* kr_src = kpe + (rowbase + ((tid & 255) >> 2)) * 32 + (tid & 3) * 8;
    const int kn_dst = (tid >> 3) * KPITCH + (tid & 7) * 16, kr_dst = ((tid & 255) >> 2) * KPITCH + 128 + (tid & 3) * 16;
    const int vv_dst = ((tid & 7) >> 2) * 4096 + (tid >> 3) * 64 + (tid & 3) * 16;
    const bool has_kr = tid < 256;
    v4u sk[2], sr[2] = {{0u, 0u, 0u, 0u}, {0u, 0u, 0u, 0u}}, sv[2];
#define MLA_LOAD(st) do { _Pragma("unroll") for (int u_ = 0; u_ < 2; ++u_) { const size_t t_ = (size_t)(2 * (st) + u_); sk[u_] = *(const GAS v4u*)(kn_src + t_ * 64 * 1024); sv[u_] = *(const GAS v4u*)(vv_src + t_ * 64 * 1024); if (has_kr) sr[u_] = *(const GAS v4u*)(kr_src + t_ * 64 * 32); } } while (0)
#define MLA_WRITE(buf) do { LAS unsigned char* B_ = shm + (buf) * BUFB; _Pragma("unroll") for (int u_ = 0; u_ < 2; ++u_) { *(LAS v4u*)(B_ + u_ * KBUF + kn_dst) = sk[u_]; *(LAS v4u*)(B_ + 2 * KBUF + u_ * VBUF + vv_dst) = sv[u_]; if (has_kr) *(LAS v4u*)(B_ + u_ * KBUF + kr_dst) = sr[u_]; } } while (0)
    const int NT = 4 * (qb + 1);
    float m_run = 0.f, l_run = 0.f; f32x16 o[2]; o[0] = f32x16{}; o[1] = f32x16{}; f32x16 minit = f32x16{};
    const int kread = r32 * KPITCH + hi * 16;
    const int vread = ((lane >> 4) & 1) * 32 + (lane & 3) * 8 + (4 * hi + ((lane & 15) >> 2)) * 64;
#define MLA_BAR() do { LDS_WAIT(); __builtin_amdgcn_s_barrier(); asm volatile("" ::: "memory"); } while (0)
#define MLA_QK(cur, u, P0, P1) do { const LAS unsigned char* Kb_ = shm + (cur) * BUFB + (u) * KBUF; P0 = f32x16{}; P1 = f32x16{}; \
            _Pragma("unroll") for (int d0 = 0; d0 < 6; ++d0) { \
                const bf16x8 k0f = *(const LAS bf16x8*)(Kb_ + kread + d0 * 32), k1f = *(const LAS bf16x8*)(Kb_ + kread + 32 * KPITCH + d0 * 32); \
                P0 = __builtin_amdgcn_mfma_f32_32x32x16_bf16(k0f, qr[d0], P0, 0, 0, 0); \
                P1 = __builtin_amdgcn_mfma_f32_32x32x16_bf16(k1f, qr[d0], P1, 0, 0, 0); } } while (0)
#define MLA_MX2(a, b) __builtin_amdgcn_fmed3f((a), (b), pinf)
#define MLA_HALFMAX(X) mla_halfmax(X, pinf)
#define MLA_MAX(P0, P1, MX) do { _Pragma("unroll") for (int r = 0; r < 16; ++r) MX = MLA_MX2(MX, MLA_MX2(P0[r], P1[r])); } while (0)
#define MLA_EXP0(P0, P1, LS) do { _Pragma("unroll") for (int r = 0; r < 16; ++r) { P0[r] = __builtin_amdgcn_exp2f(P0[r]); P1[r] = __builtin_amdgcn_exp2f(P1[r]); LS += P0[r] + P1[r]; } } while (0)
#define MLA_EXP(P0, P1, MN, LS) do { _Pragma("unroll") for (int r = 0; r < 16; ++r) { P0[r] = __builtin_amdgcn_exp2f(P0[r] - MN); P1[r] = __builtin_amdgcn_exp2f(P1[r] - MN); LS += P0[r] + P1[r]; } } while (0)
#define MLA_RESCALE(ALPHA) do { if (__any(ALPHA != 1.f)) { if (hi == 0) wsf[r32] = ALPHA; LDS_WAIT(); \
            _Pragma("unroll") for (int g = 0; g < 4; ++g) { const f32x4 f = *(const LAS f32x4*)(wsf + 8 * g + 4 * hi); \
                _Pragma("unroll") for (int i = 0; i < 4; ++i) { o[0][4 * g + i] *= f[i]; o[1][4 * g + i] *= f[i]; } } } } while (0)
#define MLA_LDV(i) do { vq[i][0] = vtr(Vb_ + vread + ((i) & 1) * 4096 + ((i) >> 1) * 1024); vq[i][1] = vtr(Vb_ + vread + ((i) & 1) * 4096 + ((i) >> 1) * 1024 + 512); } while (0)
#define MLA_PV(cur, u, P0, P1) do { const LAS unsigned char* Vb_ = shm + (cur) * BUFB + 2 * KBUF + (u) * VBUF; v4u pw[4]; s16x4 vq[8][2];        \
            MLA_LDV(0); MLA_LDV(1); MLA_LDV(2); MLA_LDV(3); \
            _Pragma("unroll") for (int w = 0; w < 4; ++w) { pw[0][w] = cvtpk(P0[2 * w], P0[2 * w + 1]); pw[1][w] = cvtpk(P0[8 + 2 * w], P0[9 + 2 * w]); pw[2][w] = cvtpk(P1[2 * w], P1[2 * w + 1]); pw[3][w] = cvtpk(P1[8 + 2 * w], P1[9 + 2 * w]); } \
            _Pragma("unroll") for (int i = 0; i < 8; ++i) { \
                const bf16x8 vf = {vq[i][0][0], vq[i][0][1], vq[i][0][2], vq[i][0][3], vq[i][1][0], vq[i][1][1], vq[i][1][2], vq[i][1][3]}; \
                o[i & 1] = __builtin_amdgcn_mfma_f32_32x32x16_bf16(__builtin_bit_cast(bf16x8, pw[i >> 1]), vf, o[i & 1], 0, 0, 0); \
                if (i + 4 < 8) MLA_LDV(i + 4); } \
            __builtin_amdgcn_sched_group_barrier(0x100, 8, 0); \
            _Pragma("unroll") for (int i_ = 0; i_ < 4; ++i_) { __builtin_amdgcn_sched_group_barrier(0x008, 1, 0); __builtin_amdgcn_sched_group_barrier(0x100, 2, 0); } \
            __builtin_amdgcn_sched_group_barrier(0x008, 4, 0); } while (0)
#define MLA_LDK(d) do { kq[d][0] = *(const LAS bf16x8*)(Kb_ + kread + (d) * 32); kq[d][1] = *(const LAS bf16x8*)(Kb_ + kread + 32 * KPITCH + (d) * 32); \
            kq[d][2] = *(const LAS bf16x8*)(Kb_ + KBUF + kread + (d) * 32); kq[d][3] = *(const LAS bf16x8*)(Kb_ + KBUF + kread + 32 * KPITCH + (d) * 32); } while (0)
#define MLA_QK4(cur) do { const LAS unsigned char* Kb_ = shm + (cur) * BUFB; bf16x8 kq[6][4];        \
            MLA_LDK(0); MLA_LDK(1); \
            _Pragma("unroll") for (int d0 = 0; d0 < 6; ++d0) { \
                a0 = __builtin_amdgcn_mfma_f32_32x32x16_bf16(kq[d0][0], qr[d0], d0 ? a0 : minit, 0, 0, 0); a1 = __builtin_amdgcn_mfma_f32_32x32x16_bf16(kq[d0][1], qr[d0], d0 ? a1 : minit, 0, 0, 0); \
                b0 = __builtin_amdgcn_mfma_f32_32x32x16_bf16(kq[d0][2], qr[d0], d0 ? b0 : minit, 0, 0, 0); b1 = __builtin_amdgcn_mfma_f32_32x32x16_bf16(kq[d0][3], qr[d0], d0 ? b1 : minit, 0, 0, 0); \
                if (d0 + 2 < 6) MLA_LDK(d0 + 2); } \
            __builtin_amdgcn_sched_group_barrier(0x100, 8, 0); \
            _Pragma("unroll") for (int i_ = 0; i_ < 4; ++i_) { __builtin_amdgcn_sched_group_barrier(0x008, 4, 0); __builtin_amdgcn_sched_group_barrier(0x100, 4, 0); } \
            __builtin_amdgcn_sched_group_barrier(0x008, 8, 0); } while (0)
#define MLA_QKPART(P_) do { const int cur_ = (P_) & 1; if (VAR & 1) { a0 = a1 = b0 = b1 = f32x16{}; } else { MLA_QK4(cur_); } \
            if (2 * (P_) + 1 >= NT - 4) { const int qq0 = wid * 32 + r32 - (2 * (P_) - (NT - 4)) * 64, qq1 = qq0 - 64;        \
                _Pragma("unroll") for (int r = 0; r < 16; ++r) { const int kr_ = crow(r, hi); \
                    if (kr_ > qq0) a0[r] = -INFINITY; if (kr_ + 32 > qq0) a1[r] = -INFINITY; if (kr_ > qq1) b0[r] = -INFINITY; if (kr_ + 32 > qq1) b1[r] = -INFINITY; } } \
            float mx = -INFINITY; MLA_MAX(a0, a1, mx); MLA_MAX(b0, b1, mx); mx = MLA_HALFMAX(mx); \
              \
            const bool up_ = ((P_) == 0) || mx > 8.f; alpha = 1.f; \
            if (__any(up_)) { const float d_ = up_ ? mx : 0.f; \
                _Pragma("unroll") for (int r = 0; r < 16; ++r) { a0[r] -= d_; a1[r] -= d_; b0[r] -= d_; b1[r] -= d_; } \
                alpha = ((P_) == 0) ? 1.f : __builtin_amdgcn_exp2f(-d_); m_run += d_; \
                _Pragma("unroll") for (int r = 0; r < 16; ++r) minit[r] = -m_run; } } while (0)
#define MLA_EXPPV(P_) do { const int cur_ = (P_) & 1; float ls = 0.f; if (!(VAR & 2)) { MLA_EXP0(a0, a1, ls); MLA_EXP0(b0, b1, ls); } l_run = l_run * alpha + ls; \
            MLA_RESCALE(alpha); if (!(VAR & 4)) { MLA_PV(cur_, 0, a0, a1); MLA_PV(cur_, 1, b0, b1); } } while (0)
    const int NS = NT / 2; const bool grpB = wid >= 4;
    float alpha = 1.f; f32x16 a0, a1, b0, b1;
    MLA_LOAD(0); MLA_WRITE(0);
    MLA_BAR();
    if (grpB) { if (1 < NS) MLA_LOAD(1); MLA_BAR(); }
#pragma unroll 1
    for (int p = 0; p < NS; ++p) {
        const bool more = p + 1 < NS;
        if (!grpB && more) MLA_LOAD(p + 1);
#ifdef MLA_PRIO
        __builtin_amdgcn_s_setprio(MLA_PRIO);
#endif
        MLA_QKPART(p);
#ifdef MLA_PRIO
        __builtin_amdgcn_s_setprio(0);
#endif
        if (grpB && more) MLA_WRITE((p + 1) & 1);
        MLA_BAR();
        if (grpB && p + 2 < NS) MLA_LOAD(p + 2);
#ifdef MLA_PRIO_E
        __builtin_amdgcn_s_setprio(MLA_PRIO_E);
#endif
        MLA_EXPPV(p);
#ifdef MLA_PRIO_E
        __builtin_amdgcn_s_setprio(0);
#endif
        if (!grpB && more) MLA_WRITE((p + 1) & 1);
        MLA_BAR();
    }
    if (!grpB) MLA_BAR();
#undef MLA_QKPART
#undef MLA_QK4
#undef MLA_LDK
#undef MLA_EXPPV
#undef MLA_BAR
#undef MLA_LOAD
#undef MLA_WRITE
#undef MLA_QK
#undef MLA_MAX
#undef MLA_HALFMAX
#undef MLA_MX2
#undef MLA_EXP
#undef MLA_EXP0
#undef MLA_RESCALE
#undef MLA_PV
#undef MLA_LDV
    l_run += __shfl_xor(l_run, 32);
    if (hi == 0) wsf[32 + r32] = 1.f / l_run;
    LDS_WAIT();
    { LAS unsigned short* stg = (LAS unsigned short*)(shm + LDS_OST) + wid * 2048;
#pragma unroll
      for (int g = 0; g < 4; ++g) { const f32x4 f = *(const LAS f32x4*)(wsf + 32 + 8 * g + 4 * hi);
#pragma unroll
          for (int i = 0; i < 4; ++i) { const int r = 4 * g + i; LAS unsigned short* sp = stg + crow(r, hi) * 64 + r32;
              sp[0] = (unsigned short)f2bf(o[0][r] * f[i]); sp[32] = (unsigned short)f2bf(o[1][r] * f[i]); } }
      LDS_WAIT();
      bf16* Ow = ya + (rowbase + q0 + wid * 32) * 512 + h * 64;
#pragma unroll
      for (int i = 0; i < 4; ++i) { const int row = i * 8 + (lane >> 3), ch = lane & 7;
          { const v4u w_ = *(const LAS v4u*)(stg + row * 64 + ch * 8); CHKW_S(2, w_.x + w_.y + w_.z + w_.w); *(GAS v4u*)(Ow + (size_t)row * 512 + ch * 8) = w_; } } }
    LDS_WAIT();
    __syncthreads();
}
template <int VAR> __device__ __forceinline__ void phase(int zb, int vcu, const bf16* qmla, const bf16* kv, const bf16* kpe, const f32x2* cs32, bf16* ya, LAS unsigned char* shm) {
    const int bh = vcu >> 2, s = vcu & 3;
#pragma unroll 1
    for (int i = 0; i < 8; ++i) { const int qb = (i & 1) ? (8 * (i >> 1) + 7 - s) : (8 * (i >> 1) + s);
        unit<VAR>(zb, bh >> 3, bh & 7, qb, qmla, kv, kpe, cs32, ya, shm); }
}
}

namespace dsa {
#ifndef DSA_CAP
#define DSA_CAP 512
#endif
constexpr int CAP = DSA_CAP;
constexpr int L_SC = 0, L_HIST = 131072, L_MM = L_HIST + 4096, L_BITMAP = L_MM + 256, L_SEL = L_BITMAP + 4096, L_CAND = L_SEL + 2048, LDS_BYTES_USED = L_CAND + 4 * CAP * 8;
constexpr int L_BIG = 0, VW_BYTES = 10240, L_COMB = 8 * VW_BYTES;
static_assert(L_COMB + 4 * 64 * 20 * 4 <= L_HIST, "attention scratch inside the score region");
typedef short v4i16_t __attribute__((ext_vector_type(4)));
__device__ __forceinline__ s16x4 vtr(const LAS unsigned char* p) { return __builtin_bit_cast(s16x4, __builtin_amdgcn_ds_read_tr16_b64_v4i16((LAS v4i16_t*)p)); }
__device__ __forceinline__ unsigned ordk(float f) { const unsigned u = __builtin_bit_cast(unsigned, f); return u ^ ((u >> 31) ? 0xFFFFFFFFu : 0x80000000u); }
__device__ __forceinline__ float unordk(unsigned k) { return __builtin_bit_cast(float, (k & 0x80000000u) ? (k ^ 0x80000000u) : ~k); }
constexpr unsigned SC_MASKED = 0x7FC00000u;
__device__ __forceinline__ unsigned key_or0(unsigned raw) { return raw == SC_MASKED ? 0u : ordk(__builtin_bit_cast(float, raw)); }
__device__ __forceinline__ unsigned cvtpk(float lo, float hi) { typedef float f2 __attribute__((ext_vector_type(2))); typedef __bf16 b2 __attribute__((ext_vector_type(2)));
    f2 v = {lo, hi}; b2 b = __builtin_convertvector(v, b2); return __builtin_bit_cast(unsigned, b); }
__device__ __forceinline__ unsigned wave_incl_scan(unsigned x) { int v = (int)x;
    v += __builtin_amdgcn_update_dpp(0, v, 0x111, 0xf, 0xf, false); v += __builtin_amdgcn_update_dpp(0, v, 0x112, 0xf, 0xf, false);
    v += __builtin_amdgcn_update_dpp(0, v, 0x114, 0xf, 0xf, false); v += __builtin_amdgcn_update_dpp(0, v, 0x118, 0xf, 0xf, false);
    v += __builtin_amdgcn_update_dpp(0, v, 0x142, 0xa, 0xf, false); v += __builtin_amdgcn_update_dpp(0, v, 0x143, 0xc, 0xf, false);
    return (unsigned)v; }
#define DSA_BAR() do { LDS_WAIT(); __builtin_amdgcn_s_barrier(); asm volatile("" ::: "memory"); } while (0)
#ifndef DSA_REP_D
#define DSA_REP_D 1
#endif

__device__ __forceinline__ void quad(int zb, int b, int p0, int nb, int np0, const bf16* qidx, const bf16* kidx, const float* widx, const bf16* qb, const bf16* kb, const bf16* vb, bf16* yb, LAS unsigned char* shm) {
    int tid = zb; asm volatile("" : "+v"(tid));
    const int lane = tid & 63, c = lane & 31, hi = lane >> 5; const int wid = __builtin_amdgcn_readfirstlane(tid >> 6);
    const size_t tokbase = (size_t)b * SEQ;
    LAS unsigned* sc = (LAS unsigned*)(shm + L_SC); LAS unsigned* hist = (LAS unsigned*)(shm + L_HIST); LAS unsigned* mm = (LAS unsigned*)(shm + L_MM); LAS unsigned* bitmap = (LAS unsigned*)(shm + L_BITMAP);
    LAS unsigned short* sel = (LAS unsigned short*)(shm + L_SEL); LAS v2u* cand = (LAS v2u*)(shm + L_CAND);
    const int ntile = (p0 + 4 + 31) >> 5, nk32 = ntile * 32;
    for (int i = tid; i < 1024; i += 512) { hist[i] = 0u; bitmap[i] = 0u; }
    if (tid < 64) mm[tid] = ((tid >= 4 && tid < 8) || (tid >= 36 && tid < 40)) ? 0xFFFFFFFFu : 0u;
    {
        const int qi_a = 2 * ((c >> 2) & 1) + (c >> 4), head_a = (c & 3) | (((c >> 3) & 1) << 2);
        const bf16* qsrc = qidx + (tokbase + p0 + qi_a) * 512 + head_a * 64 + 8 * hi;
        bf16x8 aq[4];
#pragma unroll
        for (int d0 = 0; d0 < 4; ++d0) aq[d0] = __builtin_bit_cast(bf16x8, *(const GAS v4u*)(qsrc + 16 * d0));
        float wf[16];
#pragma unroll
        for (int j = 0; j < 2; ++j) { const GAS f32x4* wp = (const GAS f32x4*)(widx + (tokbase + p0 + 2 * hi + j) * 8);
            const f32x4 a = wp[0], bb = wp[1];
#pragma unroll
            for (int i = 0; i < 4; ++i) { wf[8 * j + i] = a[i] * (0.35355339059327373f * 0.125f); wf[8 * j + 4 + i] = bb[i] * (0.35355339059327373f * 0.125f); } }
        const GAS unsigned char* kb0 = (const GAS unsigned char*)(kidx + (size_t)b * 4 * 8192 * 16);
        const unsigned hoff = 16u * (unsigned)hi;
        const GAS unsigned char* kb1 = kb0 + 262144, *kb2 = kb0 + 2 * 262144, *kb3 = kb0 + 3 * 262144;
        asm volatile("" : "+s"(kb0), "+s"(kb1), "+s"(kb2), "+s"(kb3));
        float pinf = INFINITY, ninf = -INFINITY; asm volatile("" : "+s"(pinf), "+s"(ninf));
        float mxf0 = -INFINITY, mxf1 = -INFINITY, mnf0 = INFINITY, mnf1 = INFINITY;
        v4u kf[3][4];
#define DSA_KLOAD(S, T) do { int key_ = (T) * 32 + c; key_ = key_ < SEQ ? key_ : SEQ - 1; const unsigned off_ = (unsigned)key_ * 32u + hoff; \
            kf[S][0] = *(const GAS v4u*)(kb0 + off_); kf[S][1] = *(const GAS v4u*)(kb1 + off_); kf[S][2] = *(const GAS v4u*)(kb2 + off_); kf[S][3] = *(const GAS v4u*)(kb3 + off_); } while (0)
#define DSA_RELU(x) __builtin_amdgcn_fmed3f((x), 0.f, pinf)
#define DSA_KCOMP(S, T) do { if ((T) < ntile) { const int key = (T) * 32 + c; f32x16 acc = f32x16{}; \
            _Pragma("unroll") for (int d0 = 0; d0 < 4; ++d0) acc = __builtin_amdgcn_mfma_f32_32x32x16_bf16(aq[d0], __builtin_bit_cast(bf16x8, kf[S][d0]), acc, 0, 0, 0); \
            float s0a = wf[0] * DSA_RELU(acc[0]), s0b = wf[4] * DSA_RELU(acc[4]), s1a = wf[8] * DSA_RELU(acc[8]), s1b = wf[12] * DSA_RELU(acc[12]); \
            _Pragma("unroll") for (int r = 1; r < 4; ++r) { s0a += wf[r] * DSA_RELU(acc[r]); s0b += wf[4 + r] * DSA_RELU(acc[4 + r]); s1a += wf[8 + r] * DSA_RELU(acc[8 + r]); s1b += wf[12 + r] * DSA_RELU(acc[12 + r]); } \
            const float s0 = (s0a + s0b) + 0.f, s1 = (s1a + s1b) + 0.f;        \
            const bool v0_ = key <= p0 + 2 * hi, v1_ = key <= p0 + 2 * hi + 1; \
            sc[(2 * hi) * 8192 + key] = v0_ ? __builtin_bit_cast(unsigned, s0) : SC_MASKED; sc[(2 * hi + 1) * 8192 + key] = v1_ ? __builtin_bit_cast(unsigned, s1) : SC_MASKED; \
            mxf0 = __builtin_amdgcn_fmed3f(mxf0, v0_ ? s0 : -INFINITY, pinf); mnf0 = __builtin_amdgcn_fmed3f(mnf0, v0_ ? s0 : INFINITY, ninf); \
            mxf1 = __builtin_amdgcn_fmed3f(mxf1, v1_ ? s1 : -INFINITY, pinf); mnf1 = __builtin_amdgcn_fmed3f(mnf1, v1_ ? s1 : INFINITY, ninf); } } while (0)
#ifndef DSA_REP_A
#define DSA_REP_A 1
#endif
        _Pragma("unroll") for (int repA = 0; repA < DSA_REP_A; ++repA) {
        DSA_KLOAD(0, wid); DSA_KLOAD(1, wid + 8); DSA_KLOAD(2, wid + 16);
#pragma unroll 1
        for (int t = wid; t < ntile; t += 24) {
            DSA_KCOMP(0, t);      DSA_KLOAD(0, t + 24);
            DSA_KCOMP(1, t + 8);  DSA_KLOAD(1, t + 32);
            DSA_KCOMP(2, t + 16); DSA_KLOAD(2, t + 40);
        }
        }
#undef DSA_KLOAD
#undef DSA_KCOMP
#undef DSA_RELU
        const unsigned mx0 = mxf0 == -INFINITY ? 0u : ordk(mxf0), mx1 = mxf1 == -INFINITY ? 0u : ordk(mxf1), mn0 = mnf0 == INFINITY ? 0xFFFFFFFFu : ordk(mnf0), mn1 = mnf1 == INFINITY ? 0xFFFFFFFFu : ordk(mnf1);
        DSA_BAR();
        if (mx0) { __hip_atomic_fetch_max(&mm[2 * hi], mx0, __ATOMIC_RELAXED, __HIP_MEMORY_SCOPE_WORKGROUP); __hip_atomic_fetch_min(&mm[4 + 2 * hi], mn0, __ATOMIC_RELAXED, __HIP_MEMORY_SCOPE_WORKGROUP); }
        if (mx1) { __hip_atomic_fetch_max(&mm[2 * hi + 1], mx1, __ATOMIC_RELAXED, __HIP_MEMORY_SCOPE_WORKGROUP); __hip_atomic_fetch_min(&mm[5 + 2 * hi], mn1, __ATOMIC_RELAXED, __HIP_MEMORY_SCOPE_WORKGROUP); }
        __hip_atomic_fetch_min(&mm[36 + 2 * hi], mx0, __ATOMIC_RELAXED, __HIP_MEMORY_SCOPE_WORKGROUP); __hip_atomic_fetch_min(&mm[37 + 2 * hi], mx1, __ATOMIC_RELAXED, __HIP_MEMORY_SCOPE_WORKGROUP);
    }
    DSA_BAR();
    v4u pf_ = {0u, 0u, 0u, 0u}, pf2_ = {0u, 0u, 0u, 0u};
    if (nb >= 0) { const size_t ntok = (size_t)nb * SEQ + np0;
        pf_ = *(const GAS v4u*)((tid < 256 ? qidx : qb) + ntok * 512 + (size_t)(tid & 255) * 8);
        if (tid < 8) pf2_ = *(const GAS v4u*)(widx + ntok * 8 + tid * 4); }
    float basef[4], scl[4];
#pragma unroll
    for (int q = 0; q < 4; ++q) { const unsigned mxk = mm[q], lm = mm[36 + q]; unsigned mnk = mm[4 + q]; const unsigned l0 = lm > 1u ? lm : 1u; mnk = mnk > l0 ? mnk : l0;
        const float a = unordk(mxk), bq_ = unordk(mnk);
        basef[q] = (mxk && mnk != 0xFFFFFFFFu) ? bq_ : 0.f; scl[q] = (mxk && a > bq_) ? 255.99f / (a - bq_) : 1.f; }
#ifndef DSA_REP_SEL
#define DSA_REP_SEL 1
#endif
    for (int repS = 0; repS < DSA_REP_SEL; ++repS) {
    if (repS > 0) { DSA_BAR(); for (int i = tid; i < 1024; i += 512) { hist[i] = 0u; bitmap[i] = 0u; } if (tid < 4) mm[8 + tid] = 0u; DSA_BAR(); }
#ifndef DSA_REP_S2
#define DSA_REP_S2 1
#endif
#ifndef DSA_REP_S4
#define DSA_REP_S4 1
#endif
    v4u vva_[4][4];
    _Pragma("unroll") for (int rp2 = DSA_REP_S2 - 1; rp2 >= 0; --rp2) { LAS unsigned* hist_ = rp2 ? (LAS unsigned*)cand : hist;
    LAS unsigned char* hq_[4];
    LAS unsigned* dummy_ = (LAS unsigned*)(shm + 158208) + tid;
#pragma unroll
    for (int q = 0; q < 4; ++q) { hq_[q] = (LAS unsigned char*)(hist_ + q * 256); asm volatile("" : "+s"(hq_[q])); }
#pragma unroll
    for (int q = 0; q < 4; ++q)
#pragma unroll
        for (int it_ = 0; it_ < 4; ++it_) vva_[q][it_] = *(const LAS v4u*)(sc + q * 8192 + 4 * tid + 2048 * it_);
#pragma unroll
    for (int q = 0; q < 4; ++q) {
#pragma unroll
        for (int it_ = 0; it_ < 4; ++it_) { const int idx = 4 * tid + 2048 * it_; if (idx >= nk32) break; const v4u v = vva_[q][it_];
#pragma unroll
            for (int e = 0; e < 4; ++e) { const unsigned raw = v[e]; const float d = __builtin_bit_cast(float, raw) - basef[q], xb_ = d * scl[q];
                vva_[q][it_][e] = __builtin_bit_cast(unsigned, xb_);
                { const unsigned bn = (unsigned)(int)xb_;
                  LAS unsigned* tgt_ = d >= 0.f ? (LAS unsigned*)(hq_[q] + 4u * bn) : dummy_;
                  __hip_atomic_fetch_add(tgt_, 1u, __ATOMIC_RELAXED, __HIP_MEMORY_SCOPE_WORKGROUP); } } } }
    }
    DSA_BAR();
    int bsq[4]; unsigned cgq[4], fbq[4];
#pragma unroll
    for (int q = 0; q < 4; ++q) {
        const v4u h4 = *(const LAS v4u*)(hist + q * 256 + 4 * lane);
        const unsigned t4 = h4.x + h4.y + h4.z + h4.w; const unsigned incl = wave_incl_scan(t4); const unsigned tot = (unsigned)__builtin_amdgcn_readlane((int)incl, 63);
        const unsigned S = tot - incl + t4;
        const unsigned excl = S - t4, s3 = excl + h4.w, s2 = s3 + h4.z, s1 = s2 + h4.y;
        const unsigned long long mask = __ballot(S >= 256u);
        if (mask == 0ull) { bsq[q] = -1; cgq[q] = tot; fbq[q] = 0u; }
        else { const int L = 63 - __builtin_clzll(mask);
            const int bb = s3 >= 256u ? 3 : s2 >= 256u ? 2 : s1 >= 256u ? 1 : 0; const unsigned nc = bb == 3 ? s3 : bb == 2 ? s2 : bb == 1 ? s1 : S;
            const unsigned hb = bb == 3 ? h4.w : bb == 2 ? h4.z : bb == 1 ? h4.y : h4.x;
            bsq[q] = __builtin_amdgcn_readlane(4 * lane + bb, L); cgq[q] = (unsigned)__builtin_amdgcn_readlane((int)(nc - hb), L); fbq[q] = (unsigned)__builtin_amdgcn_readlane(hb > (unsigned)CAP ? 1 : 0, L); }
    }
    const unsigned fb_any = fbq[0] | fbq[1] | fbq[2] | fbq[3];
    _Pragma("unroll") for (int rp4 = DSA_REP_S4 - 1; rp4 >= 0; --rp4) { LAS unsigned* cnt_ = mm + (rp4 ? 44 : 8);
#pragma unroll
    for (int q = 0; q < 4; ++q) { const int bs = bsq[q];
        if (!fbq[q]) { const float tlo = bs < 0 ? 0.f : (float)bs, thi = bs < 0 ? 0.f : bs >= 255 ? INFINITY : (float)(bs + 1);
          {
#pragma unroll
            for (int it_ = 0; it_ < 4; ++it_) { const int idx = 4 * tid + 2048 * it_; if (idx >= nk32) break; const v4u v = vva_[q][it_];
#pragma unroll
                for (int e = 0; e < 4; ++e) { const unsigned raw = v[e]; const float xb = __builtin_bit_cast(float, raw);
                    if (xb >= tlo) { const unsigned ix = (unsigned)(idx + e);
                        if (xb >= thi) __hip_atomic_fetch_or(&bitmap[q * 256 + (ix >> 5)], 1u << (ix & 31), __ATOMIC_RELAXED, __HIP_MEMORY_SCOPE_WORKGROUP);
                        else { const unsigned pos = __hip_atomic_fetch_add(&cnt_[q], 1u, __ATOMIC_RELAXED, __HIP_MEMORY_SCOPE_WORKGROUP);
                            if (pos < (unsigned)CAP) cand[q * CAP + pos] = (v2u){ordk(__builtin_bit_cast(float, sc[q * 8192 + ix])), ix}; } } } } } } }
    if (rp4) DSA_BAR(); }
    DSA_BAR();
    const int bs_w = wid == 0 ? bsq[0] : wid == 1 ? bsq[1] : wid == 2 ? bsq[2] : bsq[3]; const unsigned cg_w = wid == 0 ? cgq[0] : wid == 1 ? cgq[1] : wid == 2 ? cgq[2] : cgq[3], fb_w = wid == 0 ? fbq[0] : wid == 1 ? fbq[1] : wid == 2 ? fbq[2] : fbq[3];
    if (wid < 4 && !fb_w && bs_w >= 0) {
        const int n = (int)mm[8 + wid], r = 256 - (int)cg_w;
        const LAS v2u* cl = cand + wid * CAP; LAS unsigned* bm = bitmap + wid * 256;
#ifndef DSA_RANKMAX
#define DSA_RANKMAX 64
#endif
        if (n <= DSA_RANKMAX) {
            const v2u me = cl[lane < n ? lane : 0]; int rank = 0;
            for (int jx = 0; jx < n; ++jx) { const v2u o = cl[jx]; rank += (o.x > me.x || (o.x == me.x && o.y < me.y)) ? 1 : 0; }
            if (lane < n && rank < r) __hip_atomic_fetch_or(&bm[me.y >> 5], 1u << (me.y & 31), __ATOMIC_RELAXED, __HIP_MEMORY_SCOPE_WORKGROUP);
        } else {
            unsigned Tk = 0u;
            for (int bit = 31; bit >= 0; --bit) { const unsigned ct = Tk | (1u << bit); int cnt = 0;
                for (int e0 = 0; e0 < n; e0 += 64) { const int e = e0 + lane; const bool pr = (e < n) && (cl[e < n ? e : 0].x >= ct); cnt += __popcll(__ballot(pr)); }
                if (cnt >= r) Tk = ct; }
            int ngt = 0, neq = 0;
            for (int e0 = 0; e0 < n; e0 += 64) { const int e = e0 + lane; const unsigned x = cl[e < n ? e : 0].x; ngt += __popcll(__ballot(e < n && x > Tk)); neq += __popcll(__ballot(e < n && x == Tk)); }
            const int r2 = r - ngt; unsigned X = 0u;
            if (neq > r2) { for (int bit = 12; bit >= 0; --bit) { const unsigned cx = X | (1u << bit); int cnt = 0;
                    for (int e0 = 0; e0 < n; e0 += 64) { const int e = e0 + lane; const v2u ce = cl[e < n ? e : 0]; cnt += __popcll(__ballot(e < n && ce.x == Tk && (8191u - ce.y) >= cx)); }
                    if (cnt >= r2) X = cx; } }
            for (int e = lane; e < n; e += 64) { const v2u ce = cl[e]; if (ce.x > Tk || (ce.x == Tk && (8191u - ce.y) >= X)) __hip_atomic_fetch_or(&bm[ce.y >> 5], 1u << (ce.y & 31), __ATOMIC_RELAXED, __HIP_MEMORY_SCOPE_WORKGROUP); }
        }
    }
    if (fb_any) {
        int step = 0;
        DSA_BAR();
        for (int q = 0; q < 4; ++q) { if (!(q == 0 ? fbq[0] : q == 1 ? fbq[1] : q == 2 ? fbq[2] : fbq[3])) continue;
            const LAS unsigned* sq = sc + q * 8192;
#define DSA_COUNT(PRED, OUT) do { int loc_ = 0; for (int idx = tid; idx < nk32; idx += 512) { const unsigned k = key_or0(sq[idx]); const unsigned inv = 8191u - (unsigned)idx; (void)inv; loc_ += (k && (PRED)) ? 1 : 0; } \
            if (tid == 0) mm[32 + (step + 1) % 3] = 0u; if (loc_) __hip_atomic_fetch_add(&mm[32 + step % 3], (unsigned)loc_, __ATOMIC_RELAXED, __HIP_MEMORY_SCOPE_WORKGROUP); \
            DSA_BAR(); OUT = (int)mm[32 + step % 3]; ++step; } while (0)
            unsigned Tk = 0u; int cnt;
            for (int bit = 31; bit >= 0; --bit) { const unsigned ct = Tk | (1u << bit); DSA_COUNT(k >= ct, cnt); if (cnt >= 256) Tk = ct; }
            int ngt, neq; DSA_COUNT(k > Tk, ngt); DSA_COUNT(k == Tk, neq);
            const int r = 256 - ngt; unsigned X = 0u;
            if (neq > r) { for (int bit = 12; bit >= 0; --bit) { const unsigned cx = X | (1u << bit); DSA_COUNT(k == Tk && inv >= cx, cnt); if (cnt >= r) X = cx; } }
            for (int idx = tid; idx < nk32; idx += 512) { const unsigned k = key_or0(sq[idx]);
                if (k && (k > Tk || (k == Tk && (8191u - (unsigned)idx) >= X))) __hip_atomic_fetch_or(&bitmap[q * 256 + (idx >> 5)], 1u << (idx & 31), __ATOMIC_RELAXED, __HIP_MEMORY_SCOPE_WORKGROUP); }
#undef DSA_COUNT
        }
        DSA_BAR();
    }
    LDS_WAIT(); asm volatile("" ::: "memory");
    if (wid < 4) {
        const v4u w4 = *(const LAS v4u*)(bitmap + wid * 256 + 4 * lane);
        const int cl_ = __popc(w4.x) + __popc(w4.y) + __popc(w4.z) + __popc(w4.w); const int incl = (int)wave_incl_scan((unsigned)cl_);
        int pos = incl - cl_; LAS unsigned short* sl = sel + wid * 256;
#pragma unroll
        for (int wi = 0; wi < 4; ++wi) { unsigned word = w4[wi]; while (word) { const int bit = __builtin_ctz(word); if (pos < 256) sl[pos] = (unsigned short)((4 * lane + wi) * 32 + bit); ++pos; word &= word - 1u; } }
        const int total = __builtin_amdgcn_readlane(incl, 63); const int ns = total < 256 ? total : 256;
        for (int e = ns + lane; e < 256; e += 64) sl[e] = 0;
        if (lane == 0) mm[24 + wid] = (unsigned)ns;
    }
    }
    DSA_BAR();
    _Pragma("unroll") for (int repD = 0; repD < DSA_REP_D; ++repD) {
        const int q = wid & 3, part = wid >> 2, hc = lane & 15, g = lane >> 4, head = hc & 7; const int nsel = (int)mm[24 + q];
        const size_t tok = tokbase + p0 + q; const LAS unsigned short* sl = sel + q * 256 + 128 * part;
        LAS unsigned char* Vw = shm + L_BIG + wid * VW_BYTES;
        bf16x8 bq[2];
#pragma unroll
        for (int s = 0; s < 2; ++s) bq[s] = __builtin_bit_cast(bf16x8, *(const GAS v4u*)(qb + tok * 512 + head * 64 + 32 * s + 8 * g));
        v4u kf[8][2], vg[2][8];
#pragma unroll
#ifndef DSA_DVAR
#define DSA_DVAR 0
#endif
#define DSA_DV(bit) ((DSA_DVAR & (bit)) && repD + 1 < DSA_REP_D)
        for (int kt = 0; kt < 8; ++kt) { const int key = sl[16 * kt + hc]; const bf16* ksrc = kb + (tokbase + key) * 64 + 8 * g;
            if (DSA_DV(1)) { kf[kt][0] = (v4u){0u, 0u, 0u, 0u}; kf[kt][1] = (v4u){0u, 0u, 0u, 0u}; } else {
            kf[kt][0] = *(const GAS v4u*)(ksrc); kf[kt][1] = *(const GAS v4u*)(ksrc + 32); } }
#define DSA_VLOAD(hf) _Pragma("unroll") for (int it = 0; it < 8; ++it) { const int id = it * 64 + lane, kl = id >> 3, ch = id & 7; const int key = sl[64 * (hf) + kl]; \
                if (DSA_DV(2)) vg[hf][it] = (v4u){0u, 0u, 0u, 0u}; else vg[hf][it] = *(const GAS v4u*)(vb + (tokbase + key) * 64 + ch * 8); }
        DSA_VLOAD(0)
        float st[8][4];
#pragma unroll
        for (int kt = 0; kt < 8; ++kt) {
            f32x4 a4 = {0.f, 0.f, 0.f, 0.f};
            a4 = __builtin_amdgcn_mfma_f32_16x16x32_bf16(__builtin_bit_cast(bf16x8, kf[kt][0]), bq[0], a4, 0, 0, 0);
            a4 = __builtin_amdgcn_mfma_f32_16x16x32_bf16(__builtin_bit_cast(bf16x8, kf[kt][1]), bq[1], a4, 0, 0, 0);
#pragma unroll
            for (int r = 0; r < 4; ++r) st[kt][r] = (128 * part + 16 * kt + 4 * g + r < nsel) ? a4[r] : -INFINITY; }
        DSA_VLOAD(1)
#undef DSA_VLOAD
        constexpr float SC = 0.125f * 1.4426950408889634f;
        float m = -1e30f;
#pragma unroll
        for (int kt = 0; kt < 8; ++kt)
#pragma unroll
            for (int r = 0; r < 4; ++r) m = fmaxf(m, st[kt][r]);
        m = fmaxf(m, __shfl_xor(m, 16)); m = fmaxf(m, __shfl_xor(m, 32));
        float l = 0.f;
#pragma unroll
        for (int kt = 0; kt < 8; ++kt)
#pragma unroll
            for (int r = 0; r < 4; ++r) { st[kt][r] = __builtin_amdgcn_exp2f((st[kt][r] - m) * SC); l += st[kt][r]; }
        l += __shfl_xor(l, 16); l += __shfl_xor(l, 32);
        f32x4 ot[4]; ot[0] = ot[1] = ot[2] = ot[3] = (f32x4){0.f, 0.f, 0.f, 0.f};
        const int vrd = (4 * g + ((lane & 15) >> 2)) * 160 + (lane & 3) * 8;
#pragma unroll
        for (int hf = 0; hf < 2; ++hf) { if (DSA_DV(4)) continue;
            asm volatile("" ::: "memory");
#pragma unroll
            for (int it = 0; it < 8; ++it) { const int id = it * 64 + lane, kl = id >> 3, ch = id & 7;
                *(LAS v4u*)(Vw + kl * 160 + ch * 16) = vg[hf][it]; }
            LDS_WAIT();
#pragma unroll
            for (int s2 = 0; s2 < 2; ++s2) { const int ta = 4 * hf + 2 * s2;
                v4u pw; pw.x = cvtpk(st[ta][0], st[ta][1]); pw.y = cvtpk(st[ta][2], st[ta][3]); pw.z = cvtpk(st[ta + 1][0], st[ta + 1][1]); pw.w = cvtpk(st[ta + 1][2], st[ta + 1][3]);
#pragma unroll
                for (int mt = 0; mt < 4; ++mt) { const LAS unsigned char* vp = Vw + vrd + (32 * s2) * 160 + mt * 32;
                    const s16x4 lo = vtr(vp), hh = vtr(vp + 16 * 160);
                    const bf16x8 vf = {lo[0], lo[1], lo[2], lo[3], hh[0], hh[1], hh[2], hh[3]};
                    ot[mt] = __builtin_amdgcn_mfma_f32_16x16x32_bf16(vf, __builtin_bit_cast(bf16x8, pw), ot[mt], 0, 0, 0); } }
            LDS_WAIT();
        }
        LAS float* cb = (LAS float*)(shm + L_COMB) + (q * 64 + lane) * 20;
        if (part == 1) { cb[0] = m; cb[1] = l;
#pragma unroll
            for (int mt = 0; mt < 4; ++mt) *(LAS f32x4*)(cb + 4 + 4 * mt) = ot[mt]; }
        DSA_BAR();
        if (part == 0) { const float m1 = cb[0], l1 = cb[1]; const float M = fmaxf(m, m1), f0 = __builtin_amdgcn_exp2f((m - M) * SC), f1 = __builtin_amdgcn_exp2f((m1 - M) * SC);
            const float inv = 1.f / (l * f0 + l1 * f1);
            if (hc < 8) {
#pragma unroll
                for (int mt = 0; mt < 4; ++mt) { const f32x4 o1 = *(const LAS f32x4*)(cb + 4 + 4 * mt); const f32x4 o = (ot[mt] * f0 + o1 * f1) * inv;
                    v2u w; w.x = cvtpk(o[0], o[1]); w.y = cvtpk(o[2], o[3]); CHKW_S(3, w.x + w.y); *(GAS v2u*)(yb + tok * 512 + head * 64 + 16 * mt + 4 * g) = w; } } }
    }
    DSA_BAR();
    asm volatile("" :: "v"(pf_), "v"(pf2_));
}
__device__ __forceinline__ void phase(int zb, int vcu, const bf16* qidx, const bf16* kidx, const float* widx, const bf16* qb, const bf16* kb, const bf16* vb, bf16* yb, LAS unsigned char* shm) {
#pragma unroll 1
    for (int j = 0; j < 64; ++j) { const int Qi = ((j & 1) ? 255 - vcu : vcu) + 256 * j, Qn = (((j + 1) & 1) ? 255 - vcu : vcu) + 256 * (j + 1);
        quad(zb, Qi >> 11, 4 * (Qi & 2047), j + 1 < 64 ? (Qn >> 11) : -1, 4 * (Qn & 2047), qidx, kidx, widx, qb, kb, vb, yb, shm); }
}
}

__device__ __forceinline__ void p8_router(Frame& F) {
    { const int gw = F.vcu * NWAVES + F.wave;
      if (gw == 0) { GAS unsigned long long* o8 = (GAS unsigned long long*)(WSP(bf16, WS_XN2) + (size_t)T * D) + F.lane;
#pragma unroll
          for (int j = 0; j < 4; ++j) o8[64 * j] = 0ull; } }
    LAS float* Wl = (LAS float*)F.lds;
    for (int i = F.tid; i < 1024 * 32; i += NWAVES * 64) Wl[i] = F.r_w[i] * F.ffn_g[i >> 5];
    __syncthreads();
    const int lane = F.lane, i32 = lane & 31, kk = lane >> 5;
    int* tok_e = WSP(int, WS_TOKE); float* tok_g = WSP(float, WS_TOKG); int* tok_r = WSP(int, WS_TOKR); unsigned* cnt = WSP(unsigned, WS_CNT);
    for (int task = F.vcu * NWAVES + F.wave; task < NTASK; task += F.G * NWAVES) {
        const int t0 = task * 32;
        f32x16 acc = f32x16{}; float ss = 0.f;
        const float* xr = F.out + (size_t)(t0 + i32) * 1024 + 4 * kk;
#pragma unroll 4
        for (int m = 0; m < 128; ++m) { const f32x4 xv = *(const GAS f32x4*)(xr + 8 * m);
            ss += (xv[0] * xv[0] + xv[1] * xv[1]) + (xv[2] * xv[2] + xv[3] * xv[3]);
            const LAS float* wp = Wl + (8 * m + 4 * kk) * 32 + i32;
#pragma unroll
            for (int j = 0; j < 4; ++j) acc = __builtin_amdgcn_mfma_f32_32x32x2f32(xv[j], wp[32 * j], acc, 0, 0, 0); }
        ss += __shfl_xor(ss, 32);
        const float rstd = 1.f / sqrtf(ss * (1.f / 1024.f) + EPS);
        if (kk == 0) WSP(float, WS_RSTOK)[t0 + i32] = rstd;
        const float bias = F.r_b[i32];
        unsigned pickmask = 0u, kcode = 0u; int cnt_e = 0;
#pragma unroll
        for (int r = 0; r < 16; ++r) {
            const int tl_ = (r & 3) + 8 * (r >> 2) + 4 * kk;
            float v = acc[r] * __shfl(rstd, tl_) + bias;
            float tl[4]; int te[4];
#pragma unroll
            for (int k = 0; k < 4; ++k) { float bv = v; int be = i32;
#pragma unroll
                for (int o = 1; o < 32; o <<= 1) { const float ov = __shfl_xor(bv, o); const int oe = __shfl_xor(be, o); if (ov > bv || (ov == bv && oe < be)) { bv = ov; be = oe; } }
                tl[k] = bv; te[k] = be;
                if (be == i32) { v = -INFINITY; pickmask |= 1u << r; kcode |= (unsigned)k << (2 * r); ++cnt_e; } }
            const float e1 = __expf(tl[1] - tl[0]), e2 = __expf(tl[2] - tl[0]), e3 = __expf(tl[3] - tl[0]); const float inv = 1.f / (1.f + e1 + e2 + e3);
            if (i32 < 4) { const int k = i32; const int ee = k == 0 ? te[0] : k == 1 ? te[1] : k == 2 ? te[2] : te[3]; const float gg = (k == 0 ? 1.f : k == 1 ? e1 : k == 2 ? e2 : e3) * inv;
                CHKW_S(6, (unsigned)ee + __builtin_bit_cast(unsigned, gg)); tok_e[(size_t)(t0 + tl_) * 4 + k] = ee; tok_g[(size_t)(t0 + tl_) * 4 + k] = gg; }
        }
        const int c_other = __shfl_xor(cnt_e, 32);
        const int base = kk ? c_other : 0;
#pragma unroll
        for (int r = 0; r < 16; ++r) if ((pickmask >> r) & 1u) { const int tl_ = (r & 3) + 8 * (r >> 2) + 4 * kk; const int k = (kcode >> (2 * r)) & 3;
            tok_r[(size_t)(t0 + tl_) * 4 + k] = base + __popc(pickmask & ((1u << r) - 1u)); }
        if (kk == 0) cnt[(size_t)task * 32 + i32] = (unsigned)(cnt_e + c_other);
    }
}

__device__ __forceinline__ void p9_slots(Frame& F) {
    const unsigned* cnt = WSP(unsigned, WS_CNT); const int* tok_e = WSP(int, WS_TOKE); const int* tok_r = WSP(int, WS_TOKR); int* rowtok = WSP(int, WS_ROWTOK); int* blke = WSP(int, WS_BLKE); int* rowsrc = WSP(int, WS_ROWSRC); float* rowrs = WSP(float, WS_ROWRS); const float* rs_tok = WSP(float, WS_RSTOK);
    LAS int* sm_tot = (LAS int*)F.lds; LAS int* sm_pre = sm_tot + 512; LAS int* s_total = sm_pre + 512; LAS int* s_pad = s_total + 32; LAS int* s_base = s_pad + 40;
    const int e = F.tid & 31, grp = F.tid >> 5, first = F.vcu * NWAVES;
    { int tot = 0, pre = 0;
      for (int tk = grp * 128; tk < grp * 128 + 128; ++tk) { const int c = (int)cnt[(size_t)tk * 32 + e]; tot += c; pre += (tk < first) ? c : 0; }
      sm_tot[grp * 32 + e] = tot; sm_pre[grp * 32 + e] = pre; }
    __syncthreads();
    if (F.tid < 32) { int tot = 0, pre = 0;
        for (int g = 0; g < 16; ++g) { tot += sm_tot[g * 32 + e]; pre += sm_pre[g * 32 + e]; }
        s_total[e] = tot;
        for (int w = 0; w < 8; ++w) { s_base[w * 32 + e] = pre; pre += (int)cnt[(size_t)(first + w) * 32 + e]; } }
    __syncthreads();
    if (F.tid == 0) { int ps = 0; for (int q = 0; q < 32; ++q) { s_pad[q] = ps; ps += ((s_total[q] + 255) >> 8) << 8; } s_pad[32] = ps; }
    __syncthreads();
    { const int t0 = (first + F.wave) * 32;
#pragma unroll
      for (int u = 0; u < 2; ++u) { const int p = 2 * F.lane + u; const size_t q = (size_t)(t0 + (p >> 2)) * 4 + (p & 3); const int ee = tok_e[q];
          { const int sl_ = s_pad[ee] + s_base[F.wave * 32 + ee] + tok_r[q]; CHKW_S(6, (unsigned)sl_ * 2654435761u + (unsigned)q); rowtok[sl_] = (int)q; rowsrc[sl_] = (int)(q >> 2); rowrs[sl_] = rs_tok[q >> 2]; } } }
    if (F.vcu < 32) { const int q = F.vcu; for (int s = s_pad[q] + s_total[q] + F.tid; s < s_pad[q + 1]; s += NWAVES * 64) { rowtok[s] = -1; rowsrc[s] = T; rowrs[s] = 0.f; } }
    if (F.vcu == 32) { const int nblk = s_pad[32] >> 8;
        for (int bq = F.tid; bq < nblk; bq += NWAVES * 64) { int ee = 0; for (int q = 1; q < 32; ++q) ee += (bq * 256 >= s_pad[q]) ? 1 : 0; blke[bq] = ee; }
        if (F.tid == 0) blke[MAXBLK] = nblk; }
}

__device__ __forceinline__ void p10_moe(Frame& F, int probe_skip) {
    const int* rowtok = WSP(int, WS_ROWTOK); const int* rowsrc = WSP(int, WS_ROWSRC); const int* blke = WSP(int, WS_BLKE);
    bf16* act = WSP(bf16, WS_SCR) + (size_t)F.vcu * (256 * 1024);
    const int nblk = blke[MAXBLK], nfull = (nblk / F.G) * F.G;
#pragma unroll 1
    for (int bq = F.vcu; bq < nfull; bq += F.G) {
        const int e = blke[bq];
        int z1, z2; asm volatile("v_mov_b32 %0, 0" : "=v"(z1)); asm volatile("v_mov_b32 %0, 0" : "=v"(z2));
#ifndef MOE_REP_GU
#define MOE_REP_GU 1
#endif
#ifndef MOE_REP_DN
#define MOE_REP_DN 1
#endif
        int nrg_ = MOE_REP_GU, nrd_ = MOE_REP_DN; if (MOE_REP_GU > 1 || MOE_REP_DN > 1) asm volatile("" : "+s"(nrg_), "+s"(nrd_));
        if (!(probe_skip & 1))
        _Pragma("unroll 1") for (int rg_ = 0; rg_ < nrg_; ++rg_)
        { pg8::Gemm g{WSP(bf16, WS_XN2), WSP(bf16, WS_WGU), 256, 2048 * 32, 1024}; pg8::ListOrderT<true> S{8, e * 8, F.tid + z1, rowsrc + bq * 256}; pg8::EpiGU E{act, F.b_gu + (size_t)e * 2048, WSP(float, WS_ROWRS) + bq * 256};
          pg8::gemm_phase<pg8::EpiGU, pg8::ListOrderT<true>, true, true>(F.lds, g, S, E); if (rg_ + 1 < nrg_) { VM_WAIT(); __syncthreads(); } }
        VM_WAIT(); __syncthreads();
        if (F.tid == 0) __builtin_amdgcn_fence(__ATOMIC_ACQUIRE, "agent");
        VM_WAIT(); __syncthreads();
        if (!(probe_skip & 2))
        _Pragma("unroll 1") for (int rd_ = 0; rd_ < nrd_; ++rd_)
        { pg8::Gemm g{act, WSP(bf16, WS_WD), 256, 1024 * 32, 1024}; pg8::ListOrderT<false> S{4, e * 4, F.tid + z2, nullptr}; pg8::EpiDown E{WSP(bf16, WS_YBUF), F.b_d + (size_t)e * 1024, rowtok + bq * 256};
          pg8::gemm_phase<pg8::EpiDown, pg8::ListOrderT<false>, true, true>(F.lds, g, S, E); if (rd_ + 1 < nrd_) { VM_WAIT(); __syncthreads(); } }
        __syncthreads();
    }
}
#ifndef MOE_PAIR
#define MOE_PAIR 0
#endif
__device__ __forceinline__ void p10_moe_pair(Frame& F) {
    const int* rowtok = WSP(int, WS_ROWTOK); const int* rowsrc = WSP(int, WS_ROWSRC); const int* blke = WSP(int, WS_BLKE);
    const int nblk = blke[MAXBLK], nfull = (nblk / F.G) * F.G, R = nfull / F.G;
    const int j = F.vcu & 31, xg = F.vcu >> 5, half = (j >> 4) & 1, k = j & 15, pr = xg * 16 + k;
    bf16* actb[2] = {WSP(bf16, WS_SCR) + (size_t)(xg * 32 + k) * (256 * 1024), WSP(bf16, WS_SCR) + (size_t)(xg * 32 + 16 + k) * (256 * 1024)};
    gu32* flags = F.ctl + 12288 + pr * 16;
#pragma unroll 1
    for (int st = 0; st < 2 * R; ++st) {
        const int bq = (st >> 1) * F.G + xg * 32 + 16 * (st & 1) + k, e = blke[bq];
        bf16* act = actb[st & 1];
        int z1, z2; asm volatile("v_mov_b32 %0, 0" : "=v"(z1)); asm volatile("v_mov_b32 %0, 0" : "=v"(z2));
        { pg8::Gemm g{WSP(bf16, WS_XN2), WSP(bf16, WS_WGU), 256, 2048 * 32, 1024}; pg8::ListOrderT<true> S{4, e * 8 + 4 * half, F.tid + z1, rowsrc + bq * 256}; pg8::EpiGU E{act, F.b_gu + (size_t)e * 2048, WSP(float, WS_ROWRS) + bq * 256};
          pg8::gemm_phase<pg8::EpiGU, pg8::ListOrderT<true>, true, true>(F.lds, g, S, E); }
        VM_WAIT(); __syncthreads();
        if (F.tid == 0) { __builtin_amdgcn_fence(__ATOMIC_RELEASE, "agent"); __hip_atomic_fetch_add(flags + st, 1u, __ATOMIC_RELAXED, __HIP_MEMORY_SCOPE_AGENT);
            while (__hip_atomic_load(flags + st, __ATOMIC_RELAXED, __HIP_MEMORY_SCOPE_AGENT) < 2u) __builtin_amdgcn_s_sleep(2);
            __builtin_amdgcn_fence(__ATOMIC_ACQUIRE, "agent"); }
        VM_WAIT(); __syncthreads();
        { pg8::Gemm g{act, WSP(bf16, WS_WD), 256, 1024 * 32, 1024}; pg8::ListOrderT<false> S{2, e * 4 + 2 * half, F.tid + z2, nullptr}; pg8::EpiDown E{WSP(bf16, WS_YBUF), F.b_d + (size_t)e * 1024, rowtok + bq * 256};
          pg8::gemm_phase<pg8::EpiDown, pg8::ListOrderT<false>, true, true>(F.lds, g, S, E); }
        __syncthreads();
    }
}
__device__ __forceinline__ void p10b_moe_tail_gu(Frame& F) {
    const int* rowsrc = WSP(int, WS_ROWSRC); const int* blke = WSP(int, WS_BLKE);
    const int nblk = blke[MAXBLK], nfull = (nblk / F.G) * F.G, nu = (nblk - nfull) * 8;
#pragma unroll 1
    for (int u = F.vcu; u < nu; u += F.G) {
        const int bl = u >> 3, bq = nfull + bl, e = blke[bq];
        int z1; asm volatile("v_mov_b32 %0, 0" : "=v"(z1));
        pg8::Gemm g{WSP(bf16, WS_XN2), WSP(bf16, WS_WGU), 256, 2048 * 32, 1024}; pg8::ListOrderT<true> S{1, e * 8 + (u & 7), F.tid + z1, rowsrc + bq * 256}; pg8::EpiGU E{WSP(bf16, WS_TAILACT) + (size_t)bl * (256 * 1024), F.b_gu + (size_t)e * 2048, WSP(float, WS_ROWRS) + bq * 256};
        pg8::gemm_phase<pg8::EpiGU, pg8::ListOrderT<true>, true, true>(F.lds, g, S, E);
        __syncthreads();
    }
}
__device__ __forceinline__ void p10c_moe_tail_down(Frame& F) {
    const int* rowtok = WSP(int, WS_ROWTOK); const int* blke = WSP(int, WS_BLKE);
    const int nblk = blke[MAXBLK], nfull = (nblk / F.G) * F.G, nu = (nblk - nfull) * 4;
#pragma unroll 1
    for (int u = F.vcu; u < nu; u += F.G) {
        const int bl = u >> 2, bq = nfull + bl, e = blke[bq];
        int z1; asm volatile("v_mov_b32 %0, 0" : "=v"(z1));
        pg8::Gemm g{WSP(bf16, WS_TAILACT) + (size_t)bl * (256 * 1024), WSP(bf16, WS_WD), 256, 1024 * 32, 1024}; pg8::ListOrderT<false> S{1, e * 4 + (u & 3), F.tid + z1, nullptr}; pg8::EpiDown E{WSP(bf16, WS_YBUF), F.b_d + (size_t)e * 1024, rowtok + bq * 256};
        pg8::gemm_phase<pg8::EpiDown, pg8::ListOrderT<false>, true, true>(F.lds, g, S, E);
        __syncthreads();
    }
}

__device__ __forceinline__ void p11_final(Frame& F) {
    const int gw = F.vcu * NWAVES + F.wave, NGW = F.G * NWAVES, lane = F.lane;
    const float* tok_g = WSP(float, WS_TOKG); const bf16* ybuf = WSP(bf16, WS_YBUF);
    for (int t = gw; t < T; t += NGW) {
        GAS f32x4* xr = (GAS f32x4*)(F.out + (size_t)t * D) + lane; const GAS f32x4* gr = (const GAS f32x4*)F.fin_g + lane;
        const f32x4 gt = *(const GAS f32x4*)(tok_g + (size_t)t * 4);
        f32x4 v[4];
#pragma unroll
        for (int j = 0; j < 4; ++j) v[j] = xr[64 * j];
#pragma unroll
        for (int k = 0; k < 4; ++k) { const GAS v2u* yr = (const GAS v2u*)(ybuf + ((size_t)t * 4 + k) * D) + lane; const float gk = gt[k];
#pragma unroll
            for (int j = 0; j < 4; ++j) { const v2u w = yr[64 * j]; v[j].x += gk * bflo(w.x); v[j].y += gk * bfhi(w.x); v[j].z += gk * bflo(w.y); v[j].w += gk * bfhi(w.y); } }
        float s = 0.f;
#pragma unroll
        for (int j = 0; j < 4; ++j) s += (v[j].x * v[j].x + v[j].y * v[j].y) + (v[j].z * v[j].z + v[j].w * v[j].w);
        const float rstd = 1.f / sqrtf(wave_sum(s) * (1.f / 1024.f) + EPS);
#pragma unroll
        for (int j = 0; j < 4; ++j) { const f32x4 gg = gr[64 * j]; const f32x4 r_ = v[j] * rstd * gg; CHKW_S(6, __builtin_bit_cast(unsigned, r_[0]) + __builtin_bit_cast(unsigned, r_[1]) + __builtin_bit_cast(unsigned, r_[2]) + __builtin_bit_cast(unsigned, r_[3])); xr[64 * j] = r_; }
    }
}

struct Args { const void* in[19]; float* out; unsigned char* ws; int ph_lo, ph_hi, li, pad; };
__global__ void __launch_bounds__(NWAVES * 64, 2) mk_fwd(Args args) {
    extern __shared__ __attribute__((aligned(16))) unsigned char lds[];
    Frame F;
    F.lds = (LAS unsigned char*)lds;
    F.MISC = (volatile LAS unsigned*)(F.lds + MISC_OFF);
    F.tid = threadIdx.x; F.lane = F.tid & 63; F.wave = __builtin_amdgcn_readfirstlane(F.tid >> 6);
    F.G = gridDim.x; { const int bx = blockIdx.x; F.vcu = (bx % 8) * (F.G / 8) + bx / 8; }
    F.ws = args.ws; F.ctl = (gu32*)(args.ws + WS_CTL);
    F.x = (const float*)args.in[0]; F.pos = (const int*)args.in[1]; F.out = args.out;
    F.attn_g = (const float*)args.in[2]; F.w_in = (const float*)args.in[3]; F.qn_g = (const float*)args.in[4]; F.w_uq = (const float*)args.in[5]; F.kvn_g = (const float*)args.in[6];
    F.w_ukv = (const float*)args.in[7]; F.w_ba = (const float*)args.in[8]; F.w_bb = (const float*)args.in[9]; F.w_out = (const float*)args.in[10]; F.ffn_g = (const float*)args.in[11];
    F.r_w = (const float*)args.in[12]; F.r_b = (const float*)args.in[13]; F.w_gu = (const float*)args.in[14]; F.b_gu = (const float*)args.in[15]; F.w_d = (const float*)args.in[16];
    F.b_d = (const float*)args.in[17]; F.fin_g = (const float*)args.in[18];
    if (F.tid < 16) F.MISC[F.tid] = 0u;
#if defined(SELFCHK2)
    if (F.tid < 64) ((LAS unsigned*)(F.lds + 163072))[F.tid] = 0u;
#endif
    __syncthreads();
    XcdBarrier bar; bar.bar = (unsigned*)(F.ctl + CW_BAR); bar.x = 0; bar.st = nullptr;
    if (N_LAUNCHES == 1) bar = xcd_barrier_post((unsigned*)(F.ctl + CW_BAR) + args.li * 4096, F.MISC + 0);
#if defined(DBL_BAR)
#define GRID_BAR() do { if (N_LAUNCHES == 1) { xcd_barrier(bar); xcd_barrier(bar); } } while (0)
#elif defined(SYS_ACQ)
#define GRID_BAR() do { if (N_LAUNCHES == 1) { xcd_barrier(bar); if (F.tid == 0) __builtin_amdgcn_fence(__ATOMIC_ACQUIRE, ""); asm volatile("s_waitcnt vmcnt(0)" ::: "memory"); __syncthreads(); } } while (0)
#else
#define GRID_BAR() do { if (N_LAUNCHES == 1) { xcd_barrier(bar); } } while (0)
#endif
    const int lo = args.ph_lo, hi = args.ph_hi;
#ifndef DBG_MASK
#define DBG_MASK 0x1FFF
#endif
#define IN(k) ((((DBG_MASK) >> (k)) & 1) && lo <= (k) && (k) < hi)
#define BOTH(k) (IN(k) && IN((k) + 1))
#ifndef MOE_PROBE
#define MOE_PROBE 0
#endif
#ifndef DBG_DOUBLE
#define DBG_DOUBLE 0
#endif
#define REP(k) _Pragma("unroll") for (int rep_ = 0; rep_ < ((((DBG_DOUBLE) >> (k)) & 1) ? 2 : 1); ++rep_)
#define PHASE_BEGIN() int zz_; asm volatile("v_mbcnt_lo_u32_b32 %0, -1, 0\n\tv_mbcnt_hi_u32_b32 %0, -1, %0" : "=v"(zz_)); F.lane = zz_; F.tid = F.wave * 64 + F.lane; zz_ = F.tid

#if defined(PROBE_L2)
    {
        unsigned* R = (unsigned*)(F.ws + 1000 * MiB); const int G_ = F.G, w = (int)blockIdx.x, nb = (w + 1) % G_;
        unsigned bad = 0u;
        for (int round = 0; round < 3; ++round) {
            const unsigned v1 = 0x1000000u * (unsigned)(round + 1), v2 = v1 + 0x800000u;
            for (int i = F.tid; i < 8192; i += 512) R[(size_t)w * 8192 + i] = v1 + (unsigned)i;
            GRID_BAR();
            { unsigned x = 0; for (int i = F.tid; i < 8192; i += 512) x |= R[(size_t)nb * 8192 + i] ^ (v1 + (unsigned)i); if (x) bad |= 1u; }
            GRID_BAR();
            for (int i = F.tid; i < 8192; i += 512) R[(size_t)w * 8192 + i] = v2 + (unsigned)i;
            GRID_BAR();
            { unsigned x = 0; for (int i = F.tid; i < 8192; i += 512) x |= R[(size_t)nb * 8192 + i] ^ (v2 + (unsigned)i); if (x) bad |= 1u; }
            unsigned* S = R + (size_t)G_ * 8192;
            for (int i = F.tid; i < 256; i += 512) S[(size_t)i * 256 + w] = v1 + (unsigned)(i * 256 + w);
            GRID_BAR();
            { unsigned x = 0; for (int i = F.tid; i < 65536; i += 512) x |= S[i] ^ (v1 + (unsigned)i); if (x) bad |= 2u; }
            GRID_BAR();
        }
        if (bad) __hip_atomic_fetch_or((unsigned*)(F.ctl + 9), bad, RLX_AGENT);
        GRID_BAR();
    }
#endif
#if defined(SELFCHK)
#define CHK(k, off, bytes) do { int ln_; asm volatile("v_mbcnt_lo_u32_b32 %0, -1, 0\n\tv_mbcnt_hi_u32_b32 %0, -1, %0" : "=v"(ln_)); const unsigned* P_ = (const unsigned*)(F.ws + (off)); const size_t n_ = (size_t)(bytes) / 4; unsigned acc_ = 0; \
        for (size_t i_ = (size_t)F.vcu * 512 + F.wave * 64 + ln_; i_ < n_; i_ += (size_t)F.G * 512) acc_ += P_[i_]; \
        for (int o_ = 1; o_ < 64; o_ <<= 1) acc_ += __shfl_xor(acc_, o_); \
        if (ln_ == 0) __hip_atomic_fetch_add((unsigned*)(F.ctl + 64 + 32 * args.pad + (k)), acc_, RLX_AGENT); } while (0)
#define CHKOUT(k) do { int ln_; asm volatile("v_mbcnt_lo_u32_b32 %0, -1, 0\n\tv_mbcnt_hi_u32_b32 %0, -1, %0" : "=v"(ln_)); const unsigned* P_ = (const unsigned*)F.out; const size_t n_ = (size_t)T * D; unsigned acc_ = 0; \
        for (size_t i_ = (size_t)F.vcu * 512 + F.wave * 64 + ln_; i_ < n_; i_ += (size_t)F.G * 512) acc_ += P_[i_]; \
        for (int o_ = 1; o_ < 64; o_ <<= 1) acc_ += __shfl_xor(acc_, o_); \
        if (ln_ == 0) __hip_atomic_fetch_add((unsigned*)(F.ctl + 64 + 32 * args.pad + (k)), acc_, RLX_AGENT); } while (0)
#elif defined(SELFCHK2)
#define FLUSHK(k) do { LDS_WAIT(); __syncthreads(); if (F.wave == 0) { int ln_; asm volatile("v_mbcnt_lo_u32_b32 %0, -1, 0\n\tv_mbcnt_hi_u32_b32 %0, -1, %0" : "=v"(ln_)); LAS unsigned* sl_ = (LAS unsigned*)(F.lds + 163072) + ln_; \
        unsigned acc_ = *sl_; *sl_ = 0u; for (int o_ = 1; o_ < 64; o_ <<= 1) acc_ += __shfl_xor(acc_, o_); \
        if (ln_ == 0) __hip_atomic_fetch_add((unsigned*)(F.ctl + 64 + 32 * args.pad + (k)), acc_, RLX_AGENT); } LDS_WAIT(); __syncthreads(); } while (0)
#define CHK(k, off, bytes) FLUSHK(k)
#define CHKOUT(k) FLUSHK(k)
#else
#define CHK(k, off, bytes) do {} while (0)
#define CHKOUT(k) do {} while (0)
#endif
    if (IN(0)) { PHASE_BEGIN(); REP(0) p0_prologue(F); if (BOTH(0)) GRID_BAR(); CHK(0, WS_WIN, 14 * MiB); CHK(0, WS_WGU, 192 * MiB); CHK(0, WS_H, 128 * MiB); CHK(0, WS_CS16, 12 * MiB); }

    if (IN(1)) {
        PHASE_BEGIN();
        REP(1) {
        pg8::Gemm g{WSP(bf16, WS_H), WSP(bf16, WS_WIN), T, 1792, 1024}; pg8::StaticOrder S; S.init(T, 1792, F.G, (int)blockIdx.x); S.z = zz_;
        pg8::EpiZ E{WSP(bf16, WS_CQ), WSP(bf16, WS_CKV), WSP(bf16, WS_KPE), WSP(bf16, WS_KB), WSP(bf16, WS_VB), WSP(bf16, WS_KIDX), WSP(bf16, WS_QB), WSP(bf16, WS_QIDX), WSP(float, WS_WIDX)};
        pg8::gemm_phase<pg8::EpiZ, pg8::StaticOrder, true, true>(F.lds, g, S, E);
        }
        if (BOTH(1)) GRID_BAR(); CHK(1, WS_CQ, 78 * MiB); CHK(1, WS_QB, 128 * MiB);
    }

    if (IN(2)) { PHASE_BEGIN(); p2_token_pass(F); if (BOTH(2)) GRID_BAR(); CHK(2, WS_CQ, 78 * MiB); CHK(2, WS_QB, 128 * MiB); }

    if (IN(3)) {
        PHASE_BEGIN();
        REP(3) {
        { pg8::Gemm g{WSP(bf16, WS_CQ), WSP(bf16, WS_WUQ), T, 768, 256}; pg8::StaticOrder S; S.init(T, 768, F.G, (int)blockIdx.x); S.z = zz_;
          pg8::EpiStore E{WSP(bf16, WS_QMLA), 768};
          pg8::gemm_phase<pg8::EpiStore, pg8::StaticOrder, true, true>(F.lds, g, S, E); }
        __syncthreads();
        { int z2_; asm volatile("v_mbcnt_lo_u32_b32 %0, -1, 0\n\tv_mbcnt_hi_u32_b32 %0, -1, %0" : "=v"(z2_)); z2_ += F.wave * 64;
          pg8::Gemm g{WSP(bf16, WS_CKV), WSP(bf16, WS_WUKV), T, 1024, 128}; pg8::StaticOrder S; S.init(T, 1024, F.G, (int)blockIdx.x); S.z = z2_;
          pg8::EpiStore E{WSP(bf16, WS_KV), 1024};
          pg8::gemm_phase<pg8::EpiStore, pg8::StaticOrder, true, true>(F.lds, g, S, E); }
        }
        if (BOTH(3)) GRID_BAR(); CHK(3, WS_QMLA, 224 * MiB);
    }

    if (IN(4)) {
        PHASE_BEGIN();
#if defined(PROBE_T5)
        mla::phase<PROBE_T5>(zz_, F.vcu, WSP(bf16, WS_QMLA), WSP(bf16, WS_KV), WSP(bf16, WS_KPE), WSP(f32x2, WS_CS32), WSP(bf16, WS_YB), F.lds);
#endif
#ifndef P4_ALT_SHIFT
#define P4_ALT_SHIFT 0
#endif
#if !SPLIT_MIXERS && defined(P4_ALT)
        _Pragma("unroll 1") for (int ph_ = 0; ph_ < 2; ++ph_) {
            if ((ph_ == 0) != (((F.vcu >> P4_ALT_SHIFT) & 1) != 0)) mla::phase<0>(zz_, F.vcu, WSP(bf16, WS_QMLA), WSP(bf16, WS_KV), WSP(bf16, WS_KPE), WSP(f32x2, WS_CS32), WSP(bf16, WS_YA), F.lds);
            else dsa::phase(zz_, F.vcu, WSP(bf16, WS_QIDX), WSP(bf16, WS_KIDX), WSP(float, WS_WIDX), WSP(bf16, WS_QB), WSP(bf16, WS_KB), WSP(bf16, WS_VB), WSP(bf16, WS_YB), F.lds);
            __syncthreads(); }
#else
        mla::phase<0>(zz_, F.vcu, WSP(bf16, WS_QMLA), WSP(bf16, WS_KV), WSP(bf16, WS_KPE), WSP(f32x2, WS_CS32), WSP(bf16, WS_YA), F.lds);
#endif
#if defined(PROBE_T1)
        VM_WAIT(); __syncthreads();
        mla::phase<0>(zz_, F.vcu, WSP(bf16, WS_QMLA), WSP(bf16, WS_KV), WSP(bf16, WS_KPE), WSP(f32x2, WS_CS32), WSP(bf16, WS_YA), F.lds);
#elif defined(PROBE_T3)
        mla::phase<0>(zz_, F.vcu, WSP(bf16, WS_QMLA), WSP(bf16, WS_KV), WSP(bf16, WS_KPE), WSP(f32x2, WS_CS32), WSP(bf16, WS_YB), F.lds);
#endif
        __syncthreads();
#if SPLIT_MIXERS
        if (BOTH(4)) GRID_BAR(); CHK(4, WS_YA, 64 * MiB);
#if defined(PROBE_T8)
        { const v4u* A = WSP(v4u, WS_YA); const v4u* B = WSP(v4u, WS_YB); unsigned bad = 0;
          for (size_t i = (size_t)F.vcu * 512 + F.tid; i < (size_t)T * 512 * 2 / 16; i += (size_t)F.G * 512) { const v4u a = A[i], b = B[i]; bad |= (a.x ^ b.x) | (a.y ^ b.y) | (a.z ^ b.z) | (a.w ^ b.w); }
          if (bad) __hip_atomic_store(F.ctl + 8, 1u, RLX_AGENT);
          GRID_BAR(); }
#endif
    }
    if (IN(12)) {
        PHASE_BEGIN();
#endif
#if !(!SPLIT_MIXERS && defined(P4_ALT))
        REP(12) dsa::phase(zz_, F.vcu, WSP(bf16, WS_QIDX), WSP(bf16, WS_KIDX), WSP(float, WS_WIDX), WSP(bf16, WS_QB), WSP(bf16, WS_KB), WSP(bf16, WS_VB), WSP(bf16, WS_YB), F.lds);
#endif
        if (BOTH(4)) GRID_BAR(); CHK(12, WS_YB, 64 * MiB);
    }

    if (IN(5)) {
        PHASE_BEGIN();
        REP(5) {
        pg8::Gemm g{WSP(bf16, WS_H), WSP(bf16, WS_WG), T, 2048, 1024}; pg8::StaticOrder S; S.init(T, 2048, F.G, (int)blockIdx.x); S.z = zz_;
        pg8::EpiGate E{WSP(bf16, WS_G)};
        pg8::gemm_phase<pg8::EpiGate, pg8::StaticOrder, true, true>(F.lds, g, S, E);
        }
        if (BOTH(5)) GRID_BAR(); CHK(5, WS_G, 256 * MiB);
    }

    if (IN(6)) {
        PHASE_BEGIN();
        REP(6) {
        { pg8::Gemm g{WSP(bf16, WS_YA), WSP(bf16, WS_WBA), T, 1024, 512}; pg8::StaticOrder S; S.init(T, 1024, F.G, (int)blockIdx.x); S.z = zz_;
          pg8::EpiMerge<0> E{WSP(bf16, WS_G), WSP(bf16, WS_M)};
          pg8::gemm_phase<pg8::EpiMerge<0>, pg8::StaticOrder, true, true>(F.lds, g, S, E); }
        VM_WAIT(); __syncthreads();
        { int z2_; asm volatile("v_mbcnt_lo_u32_b32 %0, -1, 0\n\tv_mbcnt_hi_u32_b32 %0, -1, %0" : "=v"(z2_)); z2_ += F.wave * 64;
          pg8::Gemm g{WSP(bf16, WS_YB), WSP(bf16, WS_WBB), T, 1024, 512}; pg8::StaticOrder S; S.init(T, 1024, F.G, (int)blockIdx.x); S.z = z2_;
          pg8::EpiMerge<1> E{WSP(bf16, WS_G), WSP(bf16, WS_M)};
          pg8::gemm_phase<pg8::EpiMerge<1>, pg8::StaticOrder, true, true>(F.lds, g, S, E); }
        }
        if (BOTH(6)) GRID_BAR(); CHK(6, WS_M, 128 * MiB);
    }

    if (IN(7)) {
        PHASE_BEGIN();
        REP(7) {
        pg8::Gemm g{WSP(bf16, WS_M), WSP(bf16, WS_WOUT), T, 1024, 1024}; pg8::StaticOrder S; S.init(T, 1024, F.G, (int)blockIdx.x); S.z = zz_;
        pg8::EpiX1 E{F.x, F.out, F.ffn_g, WSP(bf16, WS_XN2)};
        pg8::gemm_phase<pg8::EpiX1, pg8::StaticOrder, true, true>(F.lds, g, S, E);
        }
        if (BOTH(7)) GRID_BAR(); CHKOUT(7);
    }

    if (IN(8)) { PHASE_BEGIN(); REP(8) p8_router(F); if (BOTH(8)) GRID_BAR(); CHK(8, WS_TOKE, 3 * MiB + 256 * 1024); }
    if (IN(9)) { PHASE_BEGIN(); p9_slots(F); if (BOTH(9)) GRID_BAR(); CHK(9, WS_ROWTOK, 1024 * 256 * 4); CHK(9, WS_BLKE, 1024 * 4); }
    if (IN(10)) { PHASE_BEGIN(); if (MOE_PAIR && F.G == 256) p10_moe_pair(F); else { REP(10) p10_moe(F, (MOE_PROBE) && rep_ == 0 ? (MOE_PROBE) : 0); } GRID_BAR(); }
    if (IN(10)) { PHASE_BEGIN(); p10b_moe_tail_gu(F); GRID_BAR(); }
    if (IN(10)) { PHASE_BEGIN(); p10c_moe_tail_down(F); if (BOTH(10)) GRID_BAR(); CHK(10, WS_YBUF, 512 * MiB); }
    if (IN(11)) { PHASE_BEGIN(); p11_final(F);
#if defined(SELFCHK) || defined(SELFCHK2)
        GRID_BAR(); CHKOUT(11); GRID_BAR();
        if (args.pad == 1) {
            if (blockIdx.x == 0 && F.tid == 0) { unsigned code = 0u;
                for (int k = 0; k < 16; ++k) { const unsigned a_ = __hip_atomic_load(F.ctl + 64 + k, RLX_AGENT), b_ = __hip_atomic_load(F.ctl + 96 + k, RLX_AGENT); if (a_ != b_ && code == 0u) code = (unsigned)(k + 1); }
                __hip_atomic_store(F.ctl + 10, code, RLX_AGENT); }
            GRID_BAR();
            const unsigned code = __hip_atomic_load(F.ctl + 10, RLX_AGENT);
            if (code) { const float sc = 1.f + 0.02f * (float)code; for (size_t i = (size_t)F.vcu * 512 + F.tid; i < (size_t)T * D; i += (size_t)F.G * 512) F.out[i] *= sc; }
        }
#endif
#if defined(PROBE_T8) || defined(PROBE_L2)
        GRID_BAR();
        { const unsigned c9 = __hip_atomic_load(F.ctl + 9, RLX_AGENT); if (__hip_atomic_load(F.ctl + 8, RLX_AGENT) != 0u) { for (size_t i = (size_t)F.vcu * 512 + F.tid; i < (size_t)T * D; i += (size_t)F.G * 512) F.out[i] = __builtin_nanf(""); }
          else if (c9) { const float sc = 1.f + 0.05f * (float)c9; for (size_t i = (size_t)F.vcu * 512 + F.tid; i < (size_t)T * D; i += (size_t)F.G * 512) F.out[i] *= sc; } }
#endif
    }
#undef IN
#undef BOTH
}

extern "C" void kernel_launch(void* const* d_in, const int* in_sizes, int n_in, void* d_out, int out_size, void* d_ws, size_t ws_size, hipStream_t stream) {
    static int grid = 0;
    if (grid == 0) {
        if (n_in != 19 || in_sizes[0] != T * D || out_size != T * D || ws_size < WS_END) { fprintf(stderr, "kernel_launch: unexpected shapes (n_in %d, in0 %d, out %d, ws %zu)\n", n_in, n_in > 0 ? in_sizes[0] : -1, out_size, ws_size); grid = -1; return; }
        int dev = 0, cus = 0;
        if (hipGetDevice(&dev) != hipSuccess || hipDeviceGetAttribute(&cus, hipDeviceAttributeMultiprocessorCount, dev) != hipSuccess) { grid = -1; return; }
        if (hipFuncSetAttribute((const void*)mk_fwd, hipFuncAttributeMaxDynamicSharedMemorySize, LDS_BYTES) != hipSuccess) { fprintf(stderr, "kernel_launch: hipFuncSetAttribute failed\n"); grid = -1; return; }
        int per_cu = 0;
        if (hipOccupancyMaxActiveBlocksPerMultiprocessor(&per_cu, (const void*)mk_fwd, NWAVES * 64, LDS_BYTES) != hipSuccess || per_cu < 1) fprintf(stderr, "kernel_launch: occupancy query says %d\n", per_cu);
        (void)hipGetLastError();
        if (cus != 256) { fprintf(stderr, "kernel_launch: built for 256 CUs, device has %d\n", cus); grid = -1; return; }
        grid = 256;
    }
    if (grid < 0) return;
#if defined(DIAG_ZERO_WS)
    if (hipMemsetAsync((char*)d_ws, 0, WS_END, stream) != hipSuccess) return;
    (void)hipMemsetAsync(d_out, 0, (size_t)out_size * 4, stream);
#else
    if (hipMemsetAsync((char*)d_ws + WS_CTL, 0, CTL_ZERO_BYTES, stream) != hipSuccess) return;
#endif
    Args a{};
    for (int i = 0; i < 19; ++i) a.in[i] = d_in[i];
    a.out = (float*)d_out; a.ws = (unsigned char*)d_ws;
#if defined(SELFCHK) || defined(SELFCHK2)
    for (int pass = 0; pass < 2; ++pass) { a.ph_lo = 0; a.ph_hi = 13; a.li = pass; a.pad = pass; hipLaunchKernelGGL(mk_fwd, dim3(grid), dim3(NWAVES * 64), LDS_BYTES, stream, a); }
    if (true) return;
#endif
    for (int li = 0; li < N_LAUNCHES; ++li) {
        int ph = li;
#if SPLIT_MIXERS
        ph = li <= 4 ? li : li == 5 ? 12 : li - 1;
#endif
        a.ph_lo = (N_LAUNCHES != 1) ? ph : 0; a.ph_hi = (N_LAUNCHES != 1) ? ph + 1 : 13; a.li = 0;
        hipLaunchKernelGGL(mk_fwd, dim3(grid), dim3(NWAVES * 64), LDS_BYTES, stream, a);
        if (hipPeekAtLastError() != hipSuccess) { fprintf(stderr, "kernel_launch: launch %d failed\n", li); break; }
    }
}
```

```cpp
#define MK_N_LAUNCHES 1
#define SPLIT_MIXERS 0
#define MLA_PRIO_E 2
#define P4_ALT 1
#include <hip/hip_runtime.h>
#include <cstdio>
#include <cstdint>

extern __shared__ __attribute__((aligned(16))) unsigned char g_lds[];
#if defined(SELFCHK2) || defined(CHKW_MASK)
#ifndef CHKW_MASK
#define CHKW_MASK 0xFF
#endif
#define CHKW_S(site, v) do { if (((CHKW_MASK) >> (site)) & 1) { int ln_; asm volatile("v_mbcnt_lo_u32_b32 %0, -1, 0\n\tv_mbcnt_hi_u32_b32 %0, -1, %0" : "=v"(ln_)); __hip_atomic_fetch_add((__attribute__((address_space(3))) unsigned*)(g_lds + 163072) + ln_, (unsigned)(v), __ATOMIC_RELAXED, __HIP_MEMORY_SCOPE_WORKGROUP); } } while (0)
#else
#define CHKW_S(site, v) do {} while (0)
#endif
namespace pg8 {
#define PG8_LAS __attribute__((address_space(3)))
typedef unsigned short bf16_t;
typedef short bf16x8 __attribute__((ext_vector_type(8)));
typedef float f32x4 __attribute__((ext_vector_type(4)));
typedef unsigned u32x4 __attribute__((ext_vector_type(4)));
constexpr int BM = 256, BK = 64, HALF = 128, HTB = HALF * BK * 2  , STAGE_BYTES = 8 * HTB, NXCD = 8, WGM = 8;

__host__ __device__ __forceinline__ int lds_byte(int r, int c) { const int st = (r >> 4) * 2 + (c >> 5), rr = r & 15, cc = c & 31, ob = rr * 64 + cc * 2; return st * 1024 + (ob ^ (((ob >> 9) & 1) << 5)); }
__host__ __device__ __forceinline__ void stage_rc(int b, int& R, int& C) { const int st = b / 1024, sb = b % 1024, swz = sb ^ (((sb >> 9) & 1) << 5); R = (st >> 1) * 16 + swz / 64; C = (st & 1) * 32 + (swz % 64) / 2; }
__host__ __device__ __forceinline__ int perm32(int rho) { const int n = rho >> 4, i = rho & 15; return 8 * (i >> 2) + 4 * n + (i & 3); }

struct Unit { int pm, pn; };
struct Gemm { const bf16_t* A; const bf16_t* Bt; int M, N, K; };

struct StaticOrder {
    static constexpr bool GATHER = false; const int* rows = nullptr;
    int nM, nN, nwg, G, c, z = 0;
    __host__ __device__ void init(int M, int N, int G_, int c_) { nM = M / BM; nN = N / BM; nwg = nM * nN; G = G_; c = c_; }
    __host__ __device__ bool next(int i, Unit& u) const {
        const long L = (long)i * G + c; if (L >= nwg) return false;
        int wgid = (int)L; { const int q = nwg / NXCD, r = nwg % NXCD, xcd = wgid % NXCD, off = wgid / NXCD; wgid = (xcd < r ? xcd * (q + 1) : r * (q + 1) + (xcd - r) * q) + off; }
        const int nig = WGM * nN, gid = wgid / nig, fm = gid * WGM, gsz = (nM - fm) < WGM ? (nM - fm) : WGM;
        u.pm = fm + ((wgid % nig) % gsz); u.pn = (wgid % nig) / gsz; return true;
    }
    __device__ __forceinline__ void a_ready(const Unit&) const {}
    __device__ __forceinline__ void done(const Unit&) const {}
    __device__ __forceinline__ int tid_bias() const { return z; }
};

__device__ __forceinline__ unsigned cvt_pk_bf16(float lo, float hi) { unsigned r; asm volatile("s_nop 1\n\tv_cvt_pk_bf16_f32 %0, %1, %2" : "=v"(r) : "v"(lo), "v"(hi)); return r; }
typedef float f32x2 __attribute__((ext_vector_type(2)));
template <class Epi, class Sched, bool ALIGN_EPI = false, bool SP2 = false>
__device__ __forceinline__ void gemm_phase(PG8_LAS unsigned char* lds, const Gemm g, const Sched& S, const Epi& E) {
    const int tid = S.tid_bias(), wid = __builtin_amdgcn_readfirstlane(tid >> 6), lane = tid & 63, wr = wid >> 2, wc = wid & 3, fr = lane & 15, fq = lane >> 4;
    const int K = g.K, nt = K / BK;
    unsigned voffA[2], voffB[2];
#pragma unroll
    for (int i = 0; i < 2; ++i) { int R, C; stage_rc(tid * 16 + i * 8192, R, C); const int Rb = Epi::PERM ? ((R & ~31) + perm32(R & 31)) : R;
        voffA[i] = (unsigned)(R * K + C) * 2u; voffB[i] = (unsigned)(Rb * K + C) * 2u; }
    unsigned voffA1[2]; voffA1[0] = voffA[0]; voffA1[1] = voffA[1];
    if constexpr (Sched::GATHER) {
#pragma unroll
        for (int i = 0; i < 2; ++i) { int R, C; stage_rc(tid * 16 + i * 8192, R, C);
            voffA[i] = (unsigned)(S.rows[R] * K + C) * 2u; voffA1[i] = (unsigned)(S.rows[HALF + R] * K + C) * 2u; } }
    const size_t kstep = (size_t)(BK * 2);
    const size_t hstep = (size_t)HALF * K * 2;
    const size_t tstep = 2 * hstep;
    const size_t hstepA = Sched::GATHER ? 0 : hstep;
    const unsigned ldsw = (unsigned)wid * 1024u;
    const int aoff = lds_byte(wr * 64 + fr, fq * 8), boff = lds_byte(wc * 32 + fr, fq * 8);
#define PG8_SA(b, h) (((b) * 2 + (h)) * HTB)
#define PG8_SB(b, h) ((4 + (b) * 2 + (h)) * HTB)
#define PG8_STAGE(bufoff, gbase, voff) do { _Pragma("unroll") for (int _i = 0; _i < 2; ++_i) \
        __builtin_amdgcn_global_load_lds((const unsigned*)((const char*)(gbase) + (voff)[_i]), (PG8_LAS unsigned*)(lds + (bufoff) + ldsw + _i * 8192), 16, 0, 0); } while (0)
#define PG8_LDA(dst, b, h) do { _Pragma("unroll") for (int m = 0; m < 4; ++m) _Pragma("unroll") for (int k = 0; k < 2; ++k) dst[m][k] = *(const PG8_LAS bf16x8*)(lds + PG8_SA(b, h) + aoff + m * 2048 + k * 1024); } while (0)
#define PG8_LDB(dst, b, h) do { _Pragma("unroll") for (int n = 0; n < 2; ++n) _Pragma("unroll") for (int k = 0; k < 2; ++k) dst[n][k] = *(const PG8_LAS bf16x8*)(lds + PG8_SB(b, h) + boff + n * 2048 + k * 1024); } while (0)
#define PG8_MMA(ai, bj, At, Bt) do { __builtin_amdgcn_s_setprio(1); _Pragma("unroll") for (int m = 0; m < 4; ++m) _Pragma("unroll") for (int n = 0; n < 2; ++n) _Pragma("unroll") for (int k = 0; k < 2; ++k) \
        acc[ai][bj][m][n] = __builtin_amdgcn_mfma_f32_16x16x32_bf16(Bt[n][k], At[m][k], acc[ai][bj][m][n], 0, 0, 0); __builtin_amdgcn_s_setprio(0); } while (0)
#define PG8_WAIT_V(n) asm volatile("s_waitcnt vmcnt(" #n ")" ::: "memory")
#define PG8_WAIT_L(n) asm volatile("s_waitcnt lgkmcnt(" #n ")" ::: "memory")
#define PG8_BAR __builtin_amdgcn_s_barrier()
#define PG8_SCHED __builtin_amdgcn_sched_barrier(0)
    Unit cur, nxt; int ui = 0;
    if (!S.next(0, cur)) return;
    f32x4 acc[2][2][4][2];
#pragma unroll
    for (int a = 0; a < 2; ++a)
#pragma unroll
        for (int b = 0; b < 2; ++b)
#pragma unroll
            for (int m = 0; m < 4; ++m)
#pragma unroll
                for (int n = 0; n < 2; ++n) acc[a][b][m][n] = (f32x4){0.f, 0.f, 0.f, 0.f};
    bf16x8 At[4][2], B0[2][2], B1[2][2];
    const char* cA = (const char*)g.A + (size_t)cur.pm * tstep; const char* cB = (const char*)g.Bt + (size_t)cur.pn * tstep;
    S.a_ready(cur);
    if constexpr (SP2) {
        PG8_STAGE(PG8_SB(0, 0), cB, voffB); PG8_STAGE(PG8_SB(0, 1), cB + hstep, voffB); PG8_STAGE(PG8_SA(0, 0), cA, voffA); PG8_STAGE(PG8_SA(0, 1), cA + hstepA, voffA1);
        if (wr == 1) PG8_BAR;
        PG8_WAIT_V(2); PG8_BAR;
        PG8_STAGE(PG8_SB(1, 0), cB + kstep, voffB); PG8_STAGE(PG8_SA(1, 0), cA + kstep, voffA); PG8_STAGE(PG8_SB(1, 1), cB + hstep + kstep, voffB);
        PG8_WAIT_V(6); PG8_BAR;
    } else {
        PG8_STAGE(PG8_SB(0, 0), cB, voffB); PG8_STAGE(PG8_SA(0, 0), cA, voffA); PG8_STAGE(PG8_SB(0, 1), cB + hstep, voffB); PG8_STAGE(PG8_SA(0, 1), cA + hstepA, voffA1);
        if (wr == 1) PG8_BAR;
        PG8_WAIT_V(4); PG8_BAR;
        PG8_STAGE(PG8_SB(1, 0), cB + kstep, voffB); PG8_STAGE(PG8_SA(1, 0), cA + kstep, voffA); PG8_STAGE(PG8_SB(1, 1), cB + hstep + kstep, voffB);
        PG8_WAIT_V(6); PG8_BAR;
    }
    for (;;) {
        const bool has_next = S.next(ui + 1, nxt);
        const char* nA = has_next ? (const char*)g.A + (size_t)nxt.pm * tstep : cA; const char* nB = has_next ? (const char*)g.Bt + (size_t)nxt.pn * tstep : cB;
        for (int t = 0; t < nt; t += 2) {
            const bool last = (t == nt - 2);
            const char* a1 = cA + (size_t)(t + 1) * kstep;
            const char* a2 = last ? nA : cA + (size_t)(t + 2) * kstep; const char* b2 = last ? nB : cB + (size_t)(t + 2) * kstep;
            const char* a3 = a2 + kstep; const char* b3 = b2 + kstep;
            if (last && has_next) S.a_ready(nxt);
            if constexpr (SP2) {
            PG8_LDB(B0, 0, 0); PG8_LDB(B1, 0, 1); PG8_SCHED; PG8_LDA(At, 0, 0); PG8_STAGE(PG8_SA(1, 1), a1 + hstepA, voffA1);
            PG8_WAIT_V(8); PG8_WAIT_L(0); PG8_BAR; PG8_MMA(0, 0, At, B0); PG8_MMA(0, 1, At, B1); PG8_BAR; PG8_SCHED;
            PG8_LDA(At, 0, 1); PG8_STAGE(PG8_SB(0, 0), b2, voffB); PG8_STAGE(PG8_SB(0, 1), b2 + hstep, voffB); PG8_STAGE(PG8_SA(0, 0), a2, voffA);
            PG8_WAIT_V(8); PG8_WAIT_L(0); PG8_BAR; PG8_MMA(1, 0, At, B0); PG8_MMA(1, 1, At, B1); PG8_BAR; PG8_SCHED;
            PG8_LDB(B0, 1, 0); PG8_LDB(B1, 1, 1); PG8_SCHED; PG8_LDA(At, 1, 0); PG8_STAGE(PG8_SA(0, 1), a2 + hstepA, voffA1);
            PG8_WAIT_V(8); PG8_WAIT_L(0); PG8_BAR; PG8_MMA(0, 0, At, B0); PG8_MMA(0, 1, At, B1); PG8_BAR; PG8_SCHED;
            PG8_LDA(At, 1, 1); PG8_STAGE(PG8_SB(1, 0), b3, voffB); PG8_STAGE(PG8_SB(1, 1), b3 + hstep, voffB); PG8_STAGE(PG8_SA(1, 0), a3, voffA);
            PG8_WAIT_V(8); PG8_WAIT_L(0); PG8_BAR; PG8_MMA(1, 0, At, B0); PG8_MMA(1, 1, At, B1); PG8_BAR; PG8_SCHED;
            } else {
            PG8_LDB(B0, 0, 0); PG8_SCHED; PG8_LDA(At, 0, 0); PG8_STAGE(PG8_SA(1, 1), a1 + hstepA, voffA1);
            PG8_WAIT_L(8); PG8_BAR; PG8_WAIT_L(0); PG8_MMA(0, 0, At, B0); PG8_BAR; PG8_SCHED;
            PG8_LDB(B1, 0, 1); PG8_STAGE(PG8_SB(0, 0), b2, voffB);
            PG8_BAR; PG8_WAIT_L(0); PG8_MMA(0, 1, At, B1); PG8_BAR;
            PG8_LDA(At, 0, 1); PG8_STAGE(PG8_SA(0, 0), a2, voffA);
            PG8_BAR; PG8_WAIT_L(0); PG8_MMA(1, 0, At, B0); PG8_BAR; PG8_SCHED;
            PG8_STAGE(PG8_SB(0, 1), b2 + hstep, voffB);
            PG8_WAIT_V(6); PG8_BAR; PG8_MMA(1, 1, At, B1); PG8_BAR;
            PG8_LDB(B0, 1, 0); PG8_SCHED; PG8_LDA(At, 1, 0); PG8_STAGE(PG8_SA(0, 1), a2 + hstepA, voffA1);
            PG8_WAIT_L(8); PG8_BAR; PG8_WAIT_L(0); PG8_MMA(0, 0, At, B0); PG8_BAR; PG8_SCHED;
            PG8_LDB(B1, 1, 1); PG8_STAGE(PG8_SB(1, 0), b3, voffB);
            PG8_BAR; PG8_WAIT_L(0); PG8_MMA(0, 1, At, B1); PG8_BAR;
            PG8_LDA(At, 1, 1); PG8_STAGE(PG8_SA(1, 0), a3, voffA);
            PG8_BAR; PG8_WAIT_L(0); PG8_MMA(1, 0, At, B0); PG8_BAR; PG8_SCHED;
            PG8_STAGE(PG8_SB(1, 1), b3 + hstep, voffB);
            PG8_WAIT_V(6); PG8_BAR; PG8_MMA(1, 1, At, B1); PG8_BAR;
            }
        }
        if constexpr (ALIGN_EPI) { if (wr == 0) PG8_BAR; }
        if constexpr (!Epi::AFTER_DRAIN) { E(acc, cur, wr, wc, fr, fq); S.done(cur); }
        if (!has_next) break;
#pragma unroll
        for (int a = 0; a < 2; ++a)
#pragma unroll
            for (int b = 0; b < 2; ++b)
#pragma unroll
                for (int m = 0; m < 4; ++m)
#pragma unroll
                    for (int n = 0; n < 2; ++n) acc[a][b][m][n] = (f32x4){0.f, 0.f, 0.f, 0.f};
        cur = nxt; cA = nA; cB = nB; ++ui;
        if constexpr (ALIGN_EPI) { if (wr == 1) PG8_BAR; }
    }
    PG8_WAIT_V(0);
    if constexpr (!ALIGN_EPI) { if (wr == 0) PG8_BAR; }
    PG8_BAR;
    if constexpr (Epi::AFTER_DRAIN) { E.fused(acc, cur, wr, wc, fr, fq, lds, wid, lane); S.done(cur); }
#undef PG8_SA
#undef PG8_SB
#undef PG8_STAGE
#undef PG8_LDA
#undef PG8_LDB
#undef PG8_MMA
#undef PG8_WAIT_V
#undef PG8_WAIT_L
#undef PG8_BAR
#undef PG8_SCHED
}
}

constexpr int NWAVES = 8;
#ifndef MK_N_LAUNCHES
#define MK_N_LAUNCHES 1
#endif
#ifndef SPLIT_MIXERS
#define SPLIT_MIXERS 0
#endif
#ifndef PG_SP2
#define PG_SP2 true
#endif
constexpr int NPHASE = 12;
constexpr int N_LAUNCHES = MK_N_LAUNCHES;
constexpr int BATCH = 8, SEQ = 8192, D = 1024, T = BATCH * SEQ;
constexpr int D_IN = 3688;
constexpr float EPS = 1e-6f;
constexpr int NEXP = 32, DFF = 1024;
constexpr int NTASK = T / 32;
constexpr int MAXBLK = 1056;

constexpr size_t MiB = 1u << 20;
constexpr size_t WS_CTL = 0, CTL_ZERO_BYTES = 64 * 1024;
constexpr int CW_BAR = 1024;
constexpr size_t WS_WIN = 1 * MiB;
constexpr size_t WS_WG = 5 * MiB;
constexpr size_t WS_WUQ = 9 * MiB;
constexpr size_t WS_WUKV = 10 * MiB;
constexpr size_t WS_WBA = 11 * MiB;
constexpr size_t WS_WBB = 12 * MiB;
constexpr size_t WS_WOUT = 13 * MiB;
constexpr size_t WS_TOKE = 15 * MiB;
constexpr size_t WS_TOKG = 16 * MiB;
constexpr size_t WS_TOKR = 17 * MiB;
constexpr size_t WS_CNT = 18 * MiB;
constexpr size_t WS_ROWTOK = 19 * MiB;
constexpr size_t WS_BLKE = 21 * MiB;
constexpr size_t WS_WGU = 24 * MiB;
constexpr size_t WS_WD = 152 * MiB;
constexpr size_t WS_H = 216 * MiB;
constexpr size_t WS_CQ = 344 * MiB;
constexpr size_t WS_CKV = 376 * MiB;
constexpr size_t WS_KPE = 392 * MiB;
constexpr size_t WS_KB = 396 * MiB;
constexpr size_t WS_VB = 404 * MiB;
constexpr size_t WS_KIDX = 412 * MiB;
constexpr size_t WS_WIDX = 420 * MiB;
constexpr size_t WS_QB = 424 * MiB;
constexpr size_t WS_QIDX = 488 * MiB;
constexpr size_t WS_QMLA = 552 * MiB;
constexpr size_t WS_KV = 648 * MiB;
constexpr size_t WS_YA = 776 * MiB;
constexpr size_t WS_YB = 840 * MiB;
constexpr size_t WS_G = 344 * MiB;
constexpr size_t WS_M = 600 * MiB;
constexpr size_t WS_YBUF = 216 * MiB;
constexpr size_t WS_SCR = 728 * MiB;
constexpr size_t WS_XN2 = 856 * MiB;
constexpr size_t WS_ROWSRC = 22 * MiB;
constexpr size_t WS_CS16 = 984 * MiB;
constexpr size_t WS_CS32 = 988 * MiB;
constexpr size_t WS_TAILACT = 990 * MiB;
constexpr size_t WS_RSTOK = 1006 * MiB;
constexpr size_t WS_ROWRS = 1007 * MiB;
constexpr size_t WS_END = 1009 * MiB;

constexpr int RING_BYTES = 131072;
constexpr int LDS_BYTES = 163840;
constexpr int MISC_OFF = LDS_BYTES - 64;

#define GAS __attribute__((address_space(1)))
#define LAS __attribute__((address_space(3)))
typedef unsigned short bf16;
typedef unsigned v4u __attribute__((ext_vector_type(4)));
typedef unsigned v2u __attribute__((ext_vector_type(2)));
typedef float f32x4 __attribute__((ext_vector_type(4)));
typedef float f32x2 __attribute__((ext_vector_type(2)));
typedef float f32x16 __attribute__((ext_vector_type(16)));
typedef short bf16x8 __attribute__((ext_vector_type(8)));
typedef short s16x4 __attribute__((ext_vector_type(4)));
typedef GAS unsigned gu32;
#define RLX_AGENT __ATOMIC_RELAXED, __HIP_MEMORY_SCOPE_AGENT
#define LDS_WAIT() asm volatile("s_waitcnt lgkmcnt(0)" ::: "memory")
#define VM_WAIT() asm volatile("s_waitcnt vmcnt(0)" ::: "memory")
__device__ __forceinline__ unsigned f2bf(float f) { unsigned u = __builtin_bit_cast(unsigned, f); return (u + 0x7fffu + ((u >> 16) & 1u)) >> 16; }
__device__ __forceinline__ unsigned pk2(float lo, float hi) { return f2bf(lo) | (f2bf(hi) << 16); }
__device__ __forceinline__ float bf2f(unsigned short b) { return __builtin_bit_cast(float, (unsigned)b << 16); }
__device__ __forceinline__ float bflo(unsigned w) { return __builtin_bit_cast(float, w << 16); }
__device__ __forceinline__ float bfhi(unsigned w) { return __builtin_bit_cast(float, w & 0xffff0000u); }
__device__ __forceinline__ float wave_sum(float v) {
#pragma unroll
    for (int o = 1; o < 64; o <<= 1) v += __shfl_xor(v, o);
    return v;
}

namespace pg8 {
typedef unsigned u32x4 __attribute__((ext_vector_type(4)));
__device__ __forceinline__ u32x4 pack8(const f32x4 a, const f32x4 b) { u32x4 w; w.x = cvt_pk_bf16(a[0], a[1]); w.y = cvt_pk_bf16(a[2], a[3]); w.z = cvt_pk_bf16(b[0], b[1]); w.w = cvt_pk_bf16(b[2], b[3]); return w; }
__device__ __forceinline__ void unpack8(const u32x4 w, f32x4& a, f32x4& b) {
    a[0] = __builtin_bit_cast(float, w.x << 16); a[1] = __builtin_bit_cast(float, w.x & 0xffff0000u); a[2] = __builtin_bit_cast(float, w.y << 16); a[3] = __builtin_bit_cast(float, w.y & 0xffff0000u);
    b[0] = __builtin_bit_cast(float, w.z << 16); b[1] = __builtin_bit_cast(float, w.z & 0xffff0000u); b[2] = __builtin_bit_cast(float, w.w << 16); b[3] = __builtin_bit_cast(float, w.w & 0xffff0000u); }
__device__ __forceinline__ float sigmoidf_(float v) { return __builtin_amdgcn_rcpf(1.f + __builtin_amdgcn_exp2f(-1.4426950408889634f * v)); }

#define EPI_LOOP_BEGIN const int row0 = u.pm * BM + wr * 64 + fr; \
    _Pragma("unroll") for (int ai = 0; ai < 2; ++ai) _Pragma("unroll") for (int m = 0; m < 4; ++m) { const int row = row0 + ai * HALF + m * 16; \
    _Pragma("unroll") for (int bj = 0; bj < 2; ++bj) { const int cg = bj * HALF + wc * 32 + 8 * fq; const f32x4 v0 = acc[ai][bj][m][0], v1 = acc[ai][bj][m][1];
#define EPI_LOOP_END } }

struct EpiStore {
    static constexpr bool PERM = true, AFTER_DRAIN = false;
    bf16_t* O; int ldc;
    __device__ __forceinline__ void operator()(const f32x4 (&acc)[2][2][4][2], const Unit& u, int wr, int wc, int fr, int fq) const {
        EPI_LOOP_BEGIN
            { const u32x4 w_ = pack8(v0, v1); CHKW_S(8, w_.x + w_.y + w_.z + w_.w); *(u32x4*)(O + (size_t)row * ldc + u.pn * BM + cg) = w_; }
        EPI_LOOP_END
    }
};
struct EpiZ {
    static constexpr bool PERM = true, AFTER_DRAIN = false;
    bf16_t *cq, *ckv, *kpe, *kb, *vb, *kidx, *qb, *qidx; float* widx;
    __device__ __forceinline__ void operator()(const f32x4 (&acc)[2][2][4][2], const Unit& u, int wr, int wc, int fr, int fq) const {
        const int pn = u.pn;
        EPI_LOOP_BEGIN
            const u32x4 w = pack8(v0, v1); CHKW_S(9, w.x + w.y + w.z + w.w);
            if (pn == 0) *(u32x4*)(cq + (size_t)row * 256 + cg) = w;
            else if (pn == 1) {
                if (cg < 128) *(u32x4*)(ckv + (size_t)row * 128 + cg) = w;
                else if (cg < 160) *(u32x4*)(kpe + (size_t)row * 32 + (cg - 128)) = w;
                else if (cg < 224) *(u32x4*)(kb + (size_t)row * 64 + (cg - 160)) = w;
            } else if (pn == 2) {
                if (cg < 64) *(u32x4*)(vb + (size_t)row * 64 + cg) = w;
                else if (cg < 128) { const int d_ = cg - 64;
                    *(u32x4*)(kidx + ((size_t)((row >> 13) * 4 + (d_ >> 4)) * 8192 + (row & 8191)) * 16 + ((d_ >> 3) & 1) * 8) = w; }
                else if (cg < 136) { *(f32x4*)(widx + (size_t)row * 8) = v0; *(f32x4*)(widx + (size_t)row * 8 + 4) = v1; }
            } else if (pn < 5) *(u32x4*)(qb + (size_t)row * 512 + (pn - 3) * 256 + cg) = w;
            else *(u32x4*)(qidx + (size_t)row * 512 + (pn - 5) * 256 + cg) = w;
        EPI_LOOP_END
    }
};
struct EpiGate {
    static constexpr bool PERM = true, AFTER_DRAIN = false;
    bf16_t* G;
    __device__ __forceinline__ void operator()(const f32x4 (&acc)[2][2][4][2], const Unit& u, int wr, int wc, int fr, int fq) const {
        EPI_LOOP_BEGIN
            f32x4 a, b;
#pragma unroll
            for (int i = 0; i < 4; ++i) { a[i] = sigmoidf_(v0[i]); b[i] = sigmoidf_(v1[i]); }
            { const u32x4 w_ = pack8(a, b); CHKW_S(10, w_.x + w_.y + w_.z + w_.w); *(u32x4*)(G + (size_t)row * 2048 + u.pn * BM + cg) = w_; }
        EPI_LOOP_END
    }
};
template <int SECOND> struct EpiMerge {
    static constexpr bool PERM = true, AFTER_DRAIN = false;
    const bf16_t* G; bf16_t* Mo;
    __device__ __forceinline__ void operator()(const f32x4 (&acc)[2][2][4][2], const Unit& u, int wr, int wc, int fr, int fq) const {
        const int row0 = u.pm * BM + wr * 64 + fr;
#pragma unroll
        for (int ai = 0; ai < 2; ++ai) {
            u32x4 gq[4][2], mq[4][2];
#pragma unroll
            for (int m = 0; m < 4; ++m)
#pragma unroll
                for (int bj = 0; bj < 2; ++bj) { const int row = row0 + ai * HALF + m * 16, col = u.pn * BM + bj * HALF + wc * 32 + 8 * fq;
                    gq[m][bj] = *(const u32x4*)(G + (size_t)row * 2048 + SECOND * 1024 + col);
                    if (SECOND) mq[m][bj] = *(const u32x4*)(Mo + (size_t)row * 1024 + col); }
            asm volatile("" ::: "memory");
#pragma unroll
            for (int m = 0; m < 4; ++m)
#pragma unroll
                for (int bj = 0; bj < 2; ++bj) { const int row = row0 + ai * HALF + m * 16, col = u.pn * BM + bj * HALF + wc * 32 + 8 * fq;
                    f32x4 ga, gb; unpack8(gq[m][bj], ga, gb);
                    f32x4 a = ga * acc[ai][bj][m][0], b = gb * acc[ai][bj][m][1];
                    if (SECOND) { f32x4 pa, pb; unpack8(mq[m][bj], pa, pb); a = a + pa; b = b + pb; }
                    { const u32x4 w_ = pack8(a, b); CHKW_S(11, w_.x + w_.y + w_.z + w_.w); *(u32x4*)(Mo + (size_t)row * 1024 + col) = w_; } }
        }
    }
};
struct EpiX1 {
    static constexpr bool PERM = true, AFTER_DRAIN = false;
    const float* x; float* out; const float* fg; bf16_t* xb;
    __device__ __forceinline__ void operator()(const f32x4 (&acc)[2][2][4][2], const Unit& u, int wr, int wc, int fr, int fq) const {
        const int row0 = u.pm * BM + wr * 64 + fr;
        f32x4 gv[2][2];
#pragma unroll
        for (int bj = 0; bj < 2; ++bj) { const int cgl = u.pn * BM + bj * HALF + wc * 32 + 8 * fq; gv[bj][0] = *(const f32x4*)(fg + cgl); gv[bj][1] = *(const f32x4*)(fg + cgl + 4); }
#pragma unroll
        for (int ai = 0; ai < 2; ++ai) {
            f32x4 xq[4][2][2];
#pragma unroll
            for (int m = 0; m < 4; ++m)
#pragma unroll
                for (int bj = 0; bj < 2; ++bj) { const size_t off = (size_t)(row0 + ai * HALF + m * 16) * 1024 + u.pn * BM + bj * HALF + wc * 32 + 8 * fq;
                    xq[m][bj][0] = *(const f32x4*)(x + off); xq[m][bj][1] = *(const f32x4*)(x + off + 4); }
            asm volatile("" ::: "memory");
#pragma unroll
            for (int m = 0; m < 4; ++m)
#pragma unroll
                for (int bj = 0; bj < 2; ++bj) { const size_t off = (size_t)(row0 + ai * HALF + m * 16) * 1024 + u.pn * BM + bj * HALF + wc * 32 + 8 * fq;
                    const f32x4 r0_ = xq[m][bj][0] + acc[ai][bj][m][0], r1_ = xq[m][bj][1] + acc[ai][bj][m][1];
                    CHKW_S(12, __builtin_bit_cast(unsigned, r0_[0]) + __builtin_bit_cast(unsigned, r0_[1]) + __builtin_bit_cast(unsigned, r0_[2]) + __builtin_bit_cast(unsigned, r0_[3]) + __builtin_bit_cast(unsigned, r1_[0]) + __builtin_bit_cast(unsigned, r1_[1]) + __builtin_bit_cast(unsigned, r1_[2]) + __builtin_bit_cast(unsigned, r1_[3]));
                    *(f32x4*)(out + off) = r0_; *(f32x4*)(out + off + 4) = r1_;
                    *(u32x4*)(xb + off) = pack8(r0_ * gv[bj][0], r1_ * gv[bj][1]); }
        }
    }
};
struct EpiGU {
    static constexpr bool PERM = true, AFTER_DRAIN = false;
    bf16_t* act; const float* bgu; const float* rs;
    __device__ __forceinline__ void operator()(const f32x4 (&acc)[2][2][4][2], const Unit& u, int wr, int wc, int fr, int fq) const {
        typedef unsigned u32x2 __attribute__((ext_vector_type(2)));
        const int pnl = u.pn & 7, col = pnl * 128 + wc * 32 + 8 * fq;
        float rr[2][4]; f32x4 bgv[2], blv[2];
#pragma unroll
        for (int ai = 0; ai < 2; ++ai)
#pragma unroll
            for (int m = 0; m < 4; ++m) rr[ai][m] = rs[ai * HALF + wr * 64 + m * 16 + fr];
#pragma unroll
        for (int n = 0; n < 2; ++n) { bgv[n] = *(const f32x4*)(bgu + col + 4 * n); blv[n] = *(const f32x4*)(bgu + 1024 + col + 4 * n) + 1.f; }
        asm volatile("" ::: "memory");
#pragma unroll
        for (int n = 0; n < 2; ++n) {
            const f32x4 bg = bgv[n], bl = blv[n];
#pragma unroll
            for (int ai = 0; ai < 2; ++ai)
#pragma unroll
                for (int m = 0; m < 4; ++m) { const int row = ai * HALF + wr * 64 + m * 16 + fr; const float rq = rr[ai][m];
                    const f32x4 g = acc[ai][0][m][n] * rq + bg, l1 = acc[ai][1][m][n] * rq + bl; f32x4 o;
#pragma unroll
                    for (int i = 0; i < 4; ++i) { const float gl = fminf(g[i], 7.f), li1 = fminf(fmaxf(l1[i], -6.f), 8.f);
                        o[i] = gl * __builtin_amdgcn_rcpf(1.f + __builtin_amdgcn_exp2f(gl * (-1.702f * 1.4426950408889634f))) * li1; }
                    u32x2 w; w.x = cvt_pk_bf16(o[0], o[1]); w.y = cvt_pk_bf16(o[2], o[3]); CHKW_S(13, w.x + w.y);
                    *(u32x2*)(act + (size_t)row * 1024 + col + 4 * n) = w; }
        }
    }
};
struct EpiDown {
    static constexpr bool PERM = true, AFTER_DRAIN = false;
    bf16_t* ybuf; const float* bd; const int* rowtok;
    __device__ __forceinline__ void operator()(const f32x4 (&acc)[2][2][4][2], const Unit& u, int wr, int wc, int fr, int fq) const {
        const int pnl = u.pn & 3;
        int dstv[2][4]; f32x4 bv[2][2];
#pragma unroll
        for (int ai = 0; ai < 2; ++ai)
#pragma unroll
            for (int m = 0; m < 4; ++m) dstv[ai][m] = rowtok[ai * HALF + wr * 64 + m * 16 + fr];
#pragma unroll
        for (int bj = 0; bj < 2; ++bj) { const int col = pnl * BM + bj * HALF + wc * 32 + 8 * fq; bv[bj][0] = *(const f32x4*)(bd + col); bv[bj][1] = *(const f32x4*)(bd + col + 4); }
        asm volatile("" ::: "memory");
#pragma unroll
        for (int ai = 0; ai < 2; ++ai)
#pragma unroll
            for (int m = 0; m < 4; ++m) { const int dst = dstv[ai][m];
                if (dst >= 0) {
#pragma unroll
                    for (int bj = 0; bj < 2; ++bj) { const int col = pnl * BM + bj * HALF + wc * 32 + 8 * fq;
                        { const u32x4 w_ = pack8(acc[ai][bj][m][0] + bv[bj][0], acc[ai][bj][m][1] + bv[bj][1]); CHKW_S(14, w_.x + w_.y + w_.z + w_.w); *(u32x4*)(ybuf + (size_t)dst * 1024 + col) = w_; } } } }
    }
};
template <bool GATHER_> struct ListOrderT {
    static constexpr bool GATHER = GATHER_;
    int n, pn0, z; const int* rows;
    __device__ __forceinline__ bool next(int i, Unit& u) const { if (i >= n) return false; u.pm = 0; u.pn = pn0 + i; return true; }
    __device__ __forceinline__ int tid_bias() const { return z; }
    __device__ __forceinline__ void a_ready(const Unit&) const {}
    __device__ __forceinline__ void done(const Unit&) const {}
};
}
#define XB_TMO      128
#define XB_XCNT(j)  (256  + 64 * (j))
#define XB_XSUB(j)  (1280 + 64 * (j))
#define XB_XGEN(j)  (2304 + 64 * (j))
#define XB_TOP      3328
#define XB_TOPGEN   3392
#define XCD_BAR_WORDS 3456
#define XB_SPIN_CAP (1u << 18)

__device__ __forceinline__ unsigned xb_ld(unsigned* p)              { return __hip_atomic_load(p, __ATOMIC_RELAXED, __HIP_MEMORY_SCOPE_AGENT); }
__device__ __forceinline__ unsigned xb_add(unsigned* p, unsigned v) { return __hip_atomic_fetch_add(p, v, __ATOMIC_RELAXED, __HIP_MEMORY_SCOPE_AGENT); }
__device__ __forceinline__ unsigned xb_xcc_id() { return (unsigned)__builtin_amdgcn_s_getreg((3 << 11) | 20) & 0xFu; }
#define XB_SPIN(cond, bar) do { unsigned _sp = 0; while (cond) { __builtin_amdgcn_s_sleep(1); \
    if ((++_sp & 255u) == 0u) { if (xb_ld(&(bar)[XB_TMO])) break; if (_sp > XB_SPIN_CAP) { atomicAdd(&(bar)[XB_TMO], 1u); break; } } } } while (0)

struct XcdBarrier {
    unsigned* bar; unsigned x;
    volatile LAS unsigned* st;
};

__device__ __forceinline__ XcdBarrier xcd_barrier_post(unsigned* bar, volatile LAS unsigned* st) {
    XcdBarrier b; b.bar = bar; b.x = xb_xcc_id(); b.st = st;
    if (threadIdx.x == 0) (void)xb_add(&bar[XB_XCNT(b.x)], 1u);
    return b;
}
__device__ __forceinline__ void xcd_barrier_complete(unsigned* bar, unsigned x, unsigned& nloc, unsigned& nx) {
    const unsigned G = gridDim.x * gridDim.y * gridDim.z;
    unsigned sum, cnt, mine, sp = 0u;
    for (;;) {
        sum = 0u; cnt = 0u; mine = 0u;
#pragma unroll
        for (unsigned j = 0; j < 16; ++j) { const unsigned c = xb_ld(&bar[XB_XCNT(j)]); sum += c; cnt += (c > 0u) ? 1u : 0u; mine = (j == x) ? c : mine; }
        if (sum == G) break;
        __builtin_amdgcn_s_sleep(1);
        if ((++sp & 255u) == 0u) { if (xb_ld(&bar[XB_TMO])) break; if (sp > XB_SPIN_CAP) { atomicAdd(&bar[XB_TMO], 1u); break; } }
    }
    nloc = mine > 0u ? mine : 1u; nx = cnt > 0u ? cnt : 1u;
}

__device__ __forceinline__ void xcd_barrier(const XcdBarrier& b) {
    asm volatile("s_waitcnt vmcnt(0)" ::: "memory");
    __syncthreads();
    if (threadIdx.x == 0) {
        unsigned* bar = b.bar;
        __builtin_amdgcn_s_waitcnt(0);
        unsigned nloc = b.st[0], nx = b.st[1];
        if (nloc == 0u) { xcd_barrier_complete(bar, b.x, nloc, nx); b.st[0] = nloc; b.st[1] = nx; }
        const unsigned old = xb_add(&bar[XB_XSUB(b.x)], 1u);
        const unsigned gen = old / nloc;
        if (old + 1u == (gen + 1u) * nloc) {
            __builtin_amdgcn_fence(__ATOMIC_RELEASE, "agent");
            asm volatile("s_waitcnt vmcnt(0)" ::: "memory");
            const unsigned og = xb_add(&bar[XB_TOP], 1u);
            const unsigned tg = og / nx;
            if (og + 1u == (tg + 1u) * nx) xb_add(&bar[XB_TOPGEN], 1u);
            else XB_SPIN(xb_ld(&bar[XB_TOPGEN]) == tg, bar);
            __builtin_amdgcn_fence(__ATOMIC_ACQUIRE, "agent");
            xb_add(&bar[XB_XGEN(b.x)], 1u);
            asm volatile("s_waitcnt vmcnt(0)" ::: "memory");
        } else {
            XB_SPIN(xb_ld(&bar[XB_XGEN(b.x)]) == gen, bar);
            __builtin_amdgcn_fence(__ATOMIC_ACQUIRE, "agent");
            asm volatile("s_waitcnt vmcnt(0)" ::: "memory");
        }
    }
    __syncthreads();
}

struct Frame {
    LAS unsigned char* lds;
    volatile LAS unsigned* MISC;
    gu32* ctl;
    int tid, lane, wave;
    int vcu, G;
    unsigned char* ws;
    const float* x; const int* pos; float* out;
    const float *attn_g, *w_in, *qn_g, *w_uq, *kvn_g, *w_ukv, *w_ba, *w_bb, *w_out, *ffn_g, *r_w, *r_b, *w_gu, *b_gu, *w_d, *b_d, *fin_g;
};
#define WSP(T_, off) ((T_*)(F.ws + (off)))

__constant__ float c_inv16[8] = {1.000000000e+00f, 1.939227432e-01f, 3.760603070e-02f, 7.292664610e-03f, 1.414213562e-03f, 2.742481884e-04f, 5.318295734e-05f, 1.031338525e-05f};
__constant__ float c_inv32[16] = {1.000000000e+00f, 4.403665960e-01f, 1.939227432e-01f, 8.539710194e-02f, 3.760603070e-02f, 1.656044088e-02f, 7.292664610e-03f, 3.211446106e-03f,
                                  1.414213562e-03f, 6.227724371e-04f, 2.742481884e-04f, 1.207697351e-04f, 5.318295734e-05f, 2.341999971e-05f, 1.031338525e-05f, 4.541670478e-06f};

__device__ __forceinline__ int map_win(int n) {
    const int t = n >> 8, j = n & 255;
    if (t == 0) return j;
    if (t == 1) return j < 128 ? 256 + j : j < 160 ? 384 + (j - 128) : j < 224 ? 928 + (j - 160) : -1;
    if (t == 2) return j < 64 ? 992 + j : j < 128 ? 1568 + (j - 64) : j < 136 ? 1632 + (j - 128) : -1;
    if (t < 5) return 416 + (n - 768);
    return 1056 + (n - 1280);
}
__device__ __forceinline__ int map_gu(int n) { const int pn = n >> 8, bj = (n >> 7) & 1, cc = n & 127; return bj * 1024 + pn * 128 + cc; }
template <int MAP>
__device__ __forceinline__ void p0_item(const float* W, int ldw, int K, bf16* WT, int coff, LAS float* scr, int kb, int nb, int lane) {
    const int k0 = 64 * kb, n0 = 32 * nb, nn = n0 + (lane & 31);
    const int col = MAP == 1 ? map_win(nn) : MAP == 2 ? map_gu(nn) : nn + coff;
    float wv[32];
#pragma unroll
    for (int i = 0; i < 32; ++i) { const int kk = 2 * i + (lane >> 5); wv[i] = col >= 0 ? W[(size_t)(k0 + kk) * ldw + col] : 0.f; }
#pragma unroll
    for (int i = 0; i < 32; ++i) { const int kk = 2 * i + (lane >> 5); scr[kk * 33 + (lane & 31)] = wv[i]; }
    LDS_WAIT(); asm volatile("" ::: "memory");
    const int c = lane & 7;
#pragma unroll
    for (int j = 0; j < 4; ++j) { const int n = (lane >> 3) + 8 * j; const LAS float* s = scr + (8 * c) * 33 + n;
        v4u o; o.x = pk2(s[0 * 33], s[1 * 33]); o.y = pk2(s[2 * 33], s[3 * 33]); o.z = pk2(s[4 * 33], s[5 * 33]); o.w = pk2(s[6 * 33], s[7 * 33]);
        CHKW_S(4, o.x + o.y + o.z + o.w); *(GAS v4u*)(WT + (size_t)(n0 + n) * K + k0 + 8 * c) = o; }
    LDS_WAIT(); asm volatile("" ::: "memory");
}
__device__ __forceinline__ void rms_row_to_bf16(const float* xrow, const float* g, bf16* orow, int lane) {
    const GAS f32x4* xr = (const GAS f32x4*)xrow + lane; const GAS f32x4* gr = (const GAS f32x4*)g + lane;
    f32x4 v[4]; float s = 0.f;
#pragma unroll
    for (int j = 0; j < 4; ++j) { v[j] = xr[64 * j]; s += (v[j].x * v[j].x + v[j].y * v[j].y) + (v[j].z * v[j].z + v[j].w * v[j].w); }
    const float rstd = 1.f / sqrtf(wave_sum(s) * (1.f / 1024.f) + EPS);
    GAS unsigned long long* o8 = (GAS unsigned long long*)orow + lane;
#pragma unroll
    for (int j = 0; j < 4; ++j) { const f32x4 gg = gr[64 * j];
        const unsigned long long ov_ = (unsigned long long)pk2(v[j].x * rstd * gg.x, v[j].y * rstd * gg.y) | ((unsigned long long)pk2(v[j].z * rstd * gg.z, v[j].w * rstd * gg.w) << 32); CHKW_S(4, (unsigned)ov_ + (unsigned)(ov_ >> 32)); o8[64 * j] = ov_; }
}
__device__ __forceinline__ void sincos_rev(float ang, float& c, float& s) {
    double r = (double)ang * 0.15915494309189535; r -= __builtin_rint(r); const float rf = (float)r;
    s = __builtin_amdgcn_sinf(rf); c = __builtin_amdgcn_cosf(rf);
}
__device__ __forceinline__ void p0_prologue(Frame& F) {
    LAS float* scr = (LAS float*)(F.lds + F.wave * 16384);
    const int gw = F.vcu * NWAVES + F.wave, NGW = F.G * NWAVES;
    constexpr int I_GU = 32 * 16 * 64, I_D = 32 * 16 * 32, I_IN = 16 * 56, I_G = 16 * 64, I_UQ = 4 * 24, I_UKV = 2 * 32, I_BA = 8 * 32, I_BB = 8 * 32, I_OUT = 16 * 32;
    constexpr int NITEMS = I_GU + I_D + I_IN + I_G + I_UQ + I_UKV + I_BA + I_BB + I_OUT;
    for (int it = gw; it < NITEMS; it += NGW) {
        int r = it;
        if (r < I_GU) { const int e = r >> 10, q = r & 1023; p0_item<2>(F.w_gu + (size_t)e * 1024 * 2048, 2048, 1024, WSP(bf16, WS_WGU) + (size_t)e * 2048 * 1024, 0, scr, q >> 6, q & 63, F.lane); continue; } r -= I_GU;
        if (r < I_D) { const int e = r >> 9, q = r & 511; p0_item<0>(F.w_d + (size_t)e * 1024 * 1024, 1024, 1024, WSP(bf16, WS_WD) + (size_t)e * 1024 * 1024, 0, scr, q >> 5, q & 31, F.lane); continue; } r -= I_D;
        if (r < I_IN) { p0_item<1>(F.w_in, D_IN, 1024, WSP(bf16, WS_WIN), 0, scr, r / 56, r % 56, F.lane); continue; } r -= I_IN;
        if (r < I_G) { p0_item<0>(F.w_in, D_IN, 1024, WSP(bf16, WS_WG), 1640, scr, r >> 6, r & 63, F.lane); continue; } r -= I_G;
        if (r < I_UQ) { p0_item<0>(F.w_uq, 768, 256, WSP(bf16, WS_WUQ), 0, scr, r / 24, r % 24, F.lane); continue; } r -= I_UQ;
        if (r < I_UKV) { p0_item<0>(F.w_ukv, 1024, 128, WSP(bf16, WS_WUKV), 0, scr, r >> 5, r & 31, F.lane); continue; } r -= I_UKV;
        if (r < I_BA) { p0_item<0>(F.w_ba, 1024, 512, WSP(bf16, WS_WBA), 0, scr, r >> 5, r & 31, F.lane); continue; } r -= I_BA;
        if (r < I_BB) { p0_item<0>(F.w_bb, 1024, 512, WSP(bf16, WS_WBB), 0, scr, r >> 5, r & 31, F.lane); continue; } r -= I_BB;
        p0_item<0>(F.w_out, 1024, 1024, WSP(bf16, WS_WOUT), 0, scr, r >> 5, r & 31, F.lane);
    }
    for (int m = gw; m < T; m += NGW) rms_row_to_bf16(F.x + (size_t)m * D, F.attn_g, WSP(bf16, WS_H) + (size_t)m * D, F.lane);
    { const int gt = F.vcu * (NWAVES * 64) + F.tid, NGT = F.G * NWAVES * 64;
      f32x2* cs16 = WSP(f32x2, WS_CS16); f32x2* cs32 = WSP(f32x2, WS_CS32);
      for (int q = gt; q < T * 8; q += NGT) { const int t = q >> 3, i = q & 7; float c, s; sincos_rev((float)F.pos[t] * c_inv16[i], c, s); cs16[q] = (f32x2){c, s}; }
      for (int q = gt; q < T * 16; q += NGT) { const int t = q >> 4, i = q & 15; float c, s; sincos_rev((float)F.pos[t] * c_inv32[i], c, s); cs32[q] = (f32x2){c, s}; } }
}

__device__ __forceinline__ void p2_token_pass(Frame& F) {
    const int gw = F.vcu * NWAVES + F.wave, NGW = F.G * NWAVES, lane = F.lane;
    bf16 *cq = WSP(bf16, WS_CQ), *ckv = WSP(bf16, WS_CKV), *kpe = WSP(bf16, WS_KPE), *kb = WSP(bf16, WS_KB), *kidx = WSP(bf16, WS_KIDX), *qb = WSP(bf16, WS_QB), *qidx = WSP(bf16, WS_QIDX);
    const f32x2* cs16 = WSP(f32x2, WS_CS16); const f32x2* cs32 = WSP(f32x2, WS_CS32);
    const f32x4 gq = *((const GAS f32x4*)F.qn_g + lane); const f32x2 gk = *((const GAS f32x2*)F.kvn_g + lane);
    (void)gw; (void)NGW;
    for (int j = 0; j < 32; ++j) { const int t = (F.vcu >> 5) * SEQ + ((F.vcu & 31) * NWAVES + F.wave) + 256 * j;
        { GAS v2u* p = (GAS v2u*)(cq + (size_t)t * 256) + lane; const v2u w = *p;
          const float a = bflo(w.x), b = bfhi(w.x), c = bflo(w.y), d = bfhi(w.y);
          const float rstd = 1.f / sqrtf(wave_sum(a * a + b * b + c * c + d * d) * (1.f / 256.f) + EPS);
          v2u o; o.x = pk2(a * rstd * gq.x, b * rstd * gq.y); o.y = pk2(c * rstd * gq.z, d * rstd * gq.w); CHKW_S(5, o.x + o.y); *p = o; }
        { GAS unsigned* p = (GAS unsigned*)(ckv + (size_t)t * 128) + lane; const unsigned w = *p;
          const float a = bflo(w), b = bfhi(w);
          const float rstd = 1.f / sqrtf(wave_sum(a * a + b * b) * (1.f / 128.f) + EPS);
          { const unsigned ov_ = pk2(a * rstd * gk.x, b * rstd * gk.y); CHKW_S(5, ov_); *p = ov_; } }
        const f32x2 cs = cs16[(size_t)t * 8 + (lane & 7)];
        { bf16* p = qb + (size_t)t * 512 + (lane >> 3) * 64 + (lane & 7); const float x1 = bf2f(p[0]), x2 = bf2f(p[8]);
          { const unsigned a_ = f2bf(x1 * cs.x - x2 * cs.y), b_ = f2bf(x2 * cs.x + x1 * cs.y); CHKW_S(5, a_ + b_); p[0] = (bf16)a_; p[8] = (bf16)b_; } }
        { bf16* p = qidx + (size_t)t * 512 + (lane >> 3) * 64 + (lane & 7); const float x1 = bf2f(p[0]), x2 = bf2f(p[8]);
          { const unsigned a_ = f2bf(x1 * cs.x - x2 * cs.y), b_ = f2bf(x2 * cs.x + x1 * cs.y); CHKW_S(5, a_ + b_); p[0] = (bf16)a_; p[8] = (bf16)b_; } }
        if (lane < 8) { bf16* p = kb + (size_t)t * 64 + lane; const float x1 = bf2f(p[0]), x2 = bf2f(p[8]);
          { const unsigned a_ = f2bf(x1 * cs.x - x2 * cs.y), b_ = f2bf(x2 * cs.x + x1 * cs.y); CHKW_S(5, a_ + b_); p[0] = (bf16)a_; p[8] = (bf16)b_; } }
        else if (lane < 16) { bf16* p = kidx + ((size_t)((t >> 13) * 4) * 8192 + (t & 8191)) * 16 + (lane - 8); const float x1 = bf2f(p[0]), x2 = bf2f(p[8]);
          { const unsigned a_ = f2bf(x1 * cs.x - x2 * cs.y), b_ = f2bf(x2 * cs.x + x1 * cs.y); CHKW_S(5, a_ + b_); p[0] = (bf16)a_; p[8] = (bf16)b_; } }
        else if (lane < 32) { const int i = lane - 16; const f32x2 c2 = cs32[(size_t)t * 16 + i]; bf16* p = kpe + (size_t)t * 32 + i; const float x1 = bf2f(p[0]), x2 = bf2f(p[16]);
          { const unsigned a_ = f2bf(x1 * c2.x - x2 * c2.y), b_ = f2bf(x2 * c2.x + x1 * c2.y); CHKW_S(5, a_ + b_); p[0] = (bf16)a_; p[16] = (bf16)b_; } }
    }
}

namespace mla {
#ifndef MLA_FASTPATH
#define MLA_FASTPATH 1
#endif
constexpr int KPITCH = 208, KBUF = 64 * KPITCH, VBUF = 8192, BUFB = 2 * (KBUF + VBUF), LDS_WSF = 2 * BUFB, LDS_OST = LDS_WSF + 8 * 256, LDS_BYTES_USED = LDS_OST + 8 * 4096;
constexpr float QSCALE = 0.10206207261596575f * 1.4426950408889634f;
typedef short v4i16_t __attribute__((ext_vector_type(4)));
__device__ __forceinline__ int crow(int r, int hi) { return (r & 3) + 8 * (r >> 2) + 4 * hi; }
__device__ __forceinline__ s16x4 vtr(const LAS unsigned char* p) { return __builtin_bit_cast(s16x4, __builtin_amdgcn_ds_read_tr16_b64_v4i16((LAS v4i16_t*)p)); }
__device__ __forceinline__ unsigned cvtpk(float lo, float hi) { typedef float f2 __attribute__((ext_vector_type(2))); typedef __bf16 b2 __attribute__((ext_vector_type(2)));
    f2 v = {lo, hi}; b2 b = __builtin_convertvector(v, b2); return __builtin_bit_cast(unsigned, b); }

__device__ __forceinline__ float mla_halfmax(float x, float pinf) { const unsigned u = __builtin_bit_cast(unsigned, x); auto r = __builtin_amdgcn_permlane32_swap(u, u, false, false);
    return __builtin_amdgcn_fmed3f(__builtin_bit_cast(float, r[0]), __builtin_bit_cast(float, r[1]), pinf); }
template <int VAR> __device__ __forceinline__ void unit(int zb, int b, int h, int qb, const bf16* qmla, const bf16* kv, const bf16* kpe, const f32x2* cs32, bf16* ya, LAS unsigned char* shm) {
    int tid = zb; asm volatile("" : "+v"(tid));
    float pinf = INFINITY; asm volatile("" : "+s"(pinf));
    const int lane = tid & 63, r32 = lane & 31, hi = lane >> 5; const int wid = __builtin_amdgcn_readfirstlane(tid >> 6);
    const size_t rowbase = (size_t)b * SEQ; const int q0 = qb * 256;
    LAS float* wsf = (LAS float*)(shm + LDS_WSF) + wid * 64;
    bf16x8 qr[6];
    { const size_t tq = rowbase + q0 + wid * 32 + r32; const bf16* Qrow = qmla + tq * 768 + h * 96 + 8 * hi;
      v4u raw[6];
#pragma unroll
      for (int d0 = 0; d0 < 6; ++d0) raw[d0] = *(const GAS v4u*)(Qrow + 16 * d0);
      const GAS f32x4* csp = (const GAS f32x4*)(cs32 + tq * 16 + 8 * hi);
      f32x4 cs[4];
#pragma unroll
      for (int i = 0; i < 4; ++i) cs[i] = csp[i];
#pragma unroll
      for (int d0 = 0; d0 < 4; ++d0) { v4u o;
#pragma unroll
          for (int w = 0; w < 4; ++w) o[w] = cvtpk(bflo(raw[d0][w]) * QSCALE, bfhi(raw[d0][w]) * QSCALE);
          qr[d0] = __builtin_bit_cast(bf16x8, o); }
      v4u o4, o5;
#pragma unroll
      for (int w = 0; w < 4; ++w) {
          const float a0 = bflo(raw[4][w]), a1 = bfhi(raw[4][w]), b0 = bflo(raw[5][w]), b1 = bfhi(raw[5][w]);
          const float c0 = cs[w][0], s0 = cs[w][1], c1 = cs[w][2], s1 = cs[w][3];
          o4[w] = cvtpk((a0 * c0 - b0 * s0) * QSCALE, (a1 * c1 - b1 * s1) * QSCALE);
          o5[w] = cvtpk((b0 * c0 + a0 * s0) * QSCALE, (b1 * c1 + a1 * s1) * QSCALE); }
      qr[4] = __builtin_bit_cast(bf16x8, o4); qr[5] = __builtin_bit_cast(bf16x8, o5); }
    const bf16* kn_src = kv + (rowbase + (tid >> 3)) * 1024 + h * 128 + (tid & 7) * 8;
    const bf16* vv_src = kn_src + 64;
    const bf16* kr_src = kpe + (rowbase + ((tid & 255) >> 2)) * 32 + (tid & 3) * 8;
    const int kn_dst = (tid >> 3) * KPITCH + (tid & 7) * 16, kr_dst = ((tid & 255) >> 2) * KPITCH + 128 + (tid & 3) * 16;
    const int vv_dst = ((tid & 7) >> 2) * 4096 + (tid >> 3) * 64 + (tid & 3) * 16;
    const bool has_kr = tid < 256;
    v4u sk[2], sr[2] = {{0u, 0u, 0u, 0u}, {0u, 0u, 0u, 0u}}, sv[2];
#define MLA_LOAD(st) do { _Pragma("unroll") for (int u_ = 0; u_ < 2; ++u_) { const size_t t_ = (size_t)(2 * (st) + u_); sk[u_] = *(const GAS v4u*)(kn_src + t_ * 64 * 1024); sv[u_] = *(const GAS v4u*)(vv_src + t_ * 64 * 1024); if (has_kr) sr[u_] = *(const GAS v4u*)(kr_src + t_ * 64 * 32); } } while (0)
#define MLA_WRITE(buf) do { LAS unsigned char* B_ = shm + (buf) * BUFB; _Pragma("unroll") for (int u_ = 0; u_ < 2; ++u_) { *(LAS v4u*)(B_ + u_ * KBUF + kn_dst) = sk[u_]; *(LAS v4u*)(B_ + 2 * KBUF + u_ * VBUF + vv_dst) = sv[u_]; if (has_kr) *(LAS v4u*)(B_ + u_ * KBUF + kr_dst) = sr[u_]; } } while (0)
    const int NT = 4 * (qb + 1);
    float m_run = 0.f, l_run = 0.f; f32x16 o[2]; o[0] = f32x16{}; o[1] = f32x16{}; f32x16 minit = f32x16{};
    const int kread = r32 * KPITCH + hi * 16;
    const int vread = ((lane >> 4) & 1) * 32 + (lane & 3) * 8 + (4 * hi + ((lane & 15) >> 2)) * 64;
#define MLA_BAR() do { LDS_WAIT(); __builtin_amdgcn_s_barrier(); asm volatile("" ::: "memory"); } while (0)
#define MLA_QK(cur, u, P0, P1) do { const LAS unsigned char* Kb_ = shm + (cur) * BUFB + (u) * KBUF; P0 = f32x16{}; P1 = f32x16{}; \
            _Pragma("unroll") for (int d0 = 0; d0 < 6; ++d0) { \
                const bf16x8 k0f = *(const LAS bf16x8*)(Kb_ + kread + d0 * 32), k1f = *(const LAS bf16x8*)(Kb_ + kread + 32 * KPITCH + d0 * 32); \
                P0 = __builtin_amdgcn_mfma_f32_32x32x16_bf16(k0f, qr[d0], P0, 0, 0, 0); \
                P1 = __builtin_amdgcn_mfma_f32_32x32x16_bf16(k1f, qr[d0], P1, 0, 0, 0); } } while (0)
#define MLA_MX2(a, b) __builtin_amdgcn_fmed3f((a), (b), pinf)
#define MLA_HALFMAX(X) mla_halfmax(X, pinf)
#define MLA_MAX(P0, P1, MX) do { _Pragma("unroll") for (int r = 0; r < 16; ++r) MX = MLA_MX2(MX, MLA_MX2(P0[r], P1[r])); } while (0)
#define MLA_EXP0(P0, P1, LS) do { _Pragma("unroll") for (int r = 0; r < 16; ++r) { P0[r] = __builtin_amdgcn_exp2f(P0[r]); P1[r] = __builtin_amdgcn_exp2f(P1[r]); LS += P0[r] + P1[r]; } } while (0)
#define MLA_EXP(P0, P1, MN, LS) do { _Pragma("unroll") for (int r = 0; r < 16; ++r) { P0[r] = __builtin_amdgcn_exp2f(P0[r] - MN); P1[r] = __builtin_amdgcn_exp2f(P1[r] - MN); LS += P0[r] + P1[r]; } } while (0)
#define MLA_RESCALE(ALPHA) do { if (__any(ALPHA != 1.f)) { if (hi == 0) wsf[r32] = ALPHA; LDS_WAIT(); \
            _Pragma("unroll") for (int g = 0; g < 4; ++g) { const f32x4 f = *(const LAS f32x4*)(wsf + 8 * g + 4 * hi); \
                _Pragma("unroll") for (int i = 0; i < 4; ++i) { o[0][4 * g + i] *= f[i]; o[1][4 * g + i] *= f[i]; } } } } while (0)
#define MLA_LDV(i) do { vq[i][0] = vtr(Vb_ + vread + ((i) & 1) * 4096 + ((i) >> 1) * 1024); vq[i][1] = vtr(Vb_ + vread + ((i) & 1) * 4096 + ((i) >> 1) * 1024 + 512); } while (0)
#define MLA_PV(cur, u, P0, P1) do { const LAS unsigned char* Vb_ = shm + (cur) * BUFB + 2 * KBUF + (u) * VBUF; v4u pw[4]; s16x4 vq[8][2];        \
            MLA_LDV(0); MLA_LDV(1); MLA_LDV(2); MLA_LDV(3); \
            _Pragma("unroll") for (int w = 0; w < 4; ++w) { pw[0][w] = cvtpk(P0[2 * w], P0[2 * w + 1]); pw[1][w] = cvtpk(P0[8 + 2 * w], P0[9 + 2 * w]); pw[2][w] = cvtpk(P1[2 * w], P1[2 * w + 1]); pw[3][w] = cvtpk(P1[8 + 2 * w], P1[9 + 2 * w]); } \
            _Pragma("unroll") for (int i = 0; i < 8; ++i) { \
                const bf16x8 vf = {vq[i][0][0], vq[i][0][1], vq[i][0][2], vq[i][0][3], vq[i][1][0], vq[i][1][1], vq[i][1][2], vq[i][1][3]}; \
                o[i & 1] = __builtin_amdgcn_mfma_f32_32x32x16_bf16(__builtin_bit_cast(bf16x8, pw[i >> 1]), vf, o[i & 1], 0, 0, 0); \
                if (i + 4 < 8) MLA_LDV(i + 4); } \
            __builtin_amdgcn_sched_group_barrier(0x100, 8, 0); \
            _Pragma("unroll") for (int i_ = 0; i_ < 4; ++i_) { __builtin_amdgcn_sched_group_barrier(0x008, 1, 0); __builtin_amdgcn_sched_group_barrier(0x100, 2, 0); } \
            __builtin_amdgcn_sched_group_barrier(0x008, 4, 0); } while (0)
#define MLA_LDK(d) do { kq[d][0] = *(const LAS bf16x8*)(Kb_ + kread + (d) * 32); kq[d][1] = *(const LAS bf16x8*)(Kb_ + kread + 32 * KPITCH + (d) * 32); \
            kq[d][2] = *(const LAS bf16x8*)(Kb_ + KBUF + kread + (d) * 32); kq[d][3] = *(const LAS bf16x8*)(Kb_ + KBUF + kread + 32 * KPITCH + (d) * 32); } while (0)
#define MLA_QK4(cur) do { const LAS unsigned char* Kb_ = shm + (cur) * BUFB; bf16x8 kq[6][4];        \
            MLA_LDK(0); MLA_LDK(1); \
            _Pragma("unroll") for (int d0 = 0; d0 < 6; ++d0) { \
                a0 = __builtin_amdgcn_mfma_f32_32x32x16_bf16(kq[d0][0], qr[d0], d0 ? a0 : minit, 0, 0, 0); a1 = __builtin_amdgcn_mfma_f32_32x32x16_bf16(kq[d0][1], qr[d0], d0 ? a1 : minit, 0, 0, 0); \
                b0 = __builtin_amdgcn_mfma_f32_32x32x16_bf16(kq[d0][2], qr[d0], d0 ? b0 : minit, 0, 0, 0); b1 = __builtin_amdgcn_mfma_f32_32x32x16_bf16(kq[d0][3], qr[d0], d0 ? b1 : minit, 0, 0, 0); \
                if (d0 + 2 < 6) MLA_LDK(d0 + 2); } \
            __builtin_amdgcn_sched_group_barrier(0x100, 8, 0); \
            _Pragma("unroll") for (int i_ = 0; i_ < 4; ++i_) { __builtin_amdgcn_sched_group_barrier(0x008, 4, 0); __builtin_amdgcn_sched_group_barrier(0x100, 4, 0); } \
            __builtin_amdgcn_sched_group_barrier(0x008, 8, 0); } while (0)
#define MLA_QKPART(P_) do { const int cur_ = (P_) & 1; if (VAR & 1) { a0 = a1 = b0 = b1 = f32x16{}; } else { MLA_QK4(cur_); } \
            if (2 * (P_) + 1 >= NT - 4) { const int qq0 = wid * 32 + r32 - (2 * (P_) - (NT - 4)) * 64, qq1 = qq0 - 64;        \
                _Pragma("unroll") for (int r = 0; r < 16; ++r) { const int kr_ = crow(r, hi); \
                    if (kr_ > qq0) a0[r] = -INFINITY; if (kr_ + 32 > qq0) a1[r] = -INFINITY; if (kr_ > qq1) b0[r] = -INFINITY; if (kr_ + 32 > qq1) b1[r] = -INFINITY; } } \
            float mx = -INFINITY; MLA_MAX(a0, a1, mx); MLA_MAX(b0, b1, mx); mx = MLA_HALFMAX(mx); \
              \
            const bool up_ = ((P_) == 0) || mx > 8.f; alpha = 1.f; \
            if (__any(up_)) { const float d_ = up_ ? mx : 0.f; \
                _Pragma("unroll") for (int r = 0; r < 16; ++r) { a0[r] -= d_; a1[r] -= d_; b0[r] -= d_; b1[r] -= d_; } \
                alpha = ((P_) == 0) ? 1.f : __builtin_amdgcn_exp2f(-d_); m_run += d_; \
                _Pragma("unroll") for (int r = 0; r < 16; ++r) minit[r] = -m_run; } } while (0)
#define MLA_EXPPV(P_) do { const int cur_ = (P_) & 1; float ls = 0.f; if (!(VAR & 2)) { MLA_EXP0(a0, a1, ls); MLA_EXP0(b0, b1, ls); } l_run = l_run * alpha + ls; \
            MLA_RESCALE(alpha); if (!(VAR & 4)) { MLA_PV(cur_, 0, a0, a1); MLA_PV(cur_, 1, b0, b1); } } while (0)
    const int NS = NT / 2; const bool grpB = wid >= 4;
    float alpha = 1.f; f32x16 a0, a1, b0, b1;
    MLA_LOAD(0); MLA_WRITE(0);
    MLA_BAR();
    if (grpB) { if (1 < NS) MLA_LOAD(1); MLA_BAR(); }
#pragma unroll 1
    for (int p = 0; p < NS; ++p) {
        const bool more = p + 1 < NS;
        if (!grpB && more) MLA_LOAD(p + 1);
#ifdef MLA_PRIO
        __builtin_amdgcn_s_setprio(MLA_PRIO);
#endif
        MLA_QKPART(p);
#ifdef MLA_PRIO
        __builtin_amdgcn_s_setprio(0);
#endif
        if (grpB && more) MLA_WRITE((p + 1) & 1);
        MLA_BAR();
        if (grpB && p + 2 < NS) MLA_LOAD(p + 2);
#ifdef MLA_PRIO_E
        __builtin_amdgcn_s_setprio(MLA_PRIO_E);
#endif
        MLA_EXPPV(p);
#ifdef MLA_PRIO_E
        __builtin_amdgcn_s_setprio(0);
#endif
        if (!grpB && more) MLA_WRITE((p + 1) & 1);
        MLA_BAR();
    }
    if (!grpB) MLA_BAR();
#undef MLA_QKPART
#undef MLA_QK4
#undef MLA_LDK
#undef MLA_EXPPV
#undef MLA_BAR
#undef MLA_LOAD
#undef MLA_WRITE
#undef MLA_QK
#undef MLA_MAX
#undef MLA_HALFMAX
#undef MLA_MX2
#undef MLA_EXP
#undef MLA_EXP0
#undef MLA_RESCALE
#undef MLA_PV
#undef MLA_LDV
    l_run += __shfl_xor(l_run, 32);
    if (hi == 0) wsf[32 + r32] = 1.f / l_run;
    LDS_WAIT();
    { LAS unsigned short* stg = (LAS unsigned short*)(shm + LDS_OST) + wid * 2048;
#pragma unroll
      for (int g = 0; g < 4; ++g) { const f32x4 f = *(const LAS f32x4*)(wsf + 32 + 8 * g + 4 * hi);
#pragma unroll
          for (int i = 0; i < 4; ++i) { const int r = 4 * g + i; LAS unsigned short* sp = stg + crow(r, hi) * 64 + r32;
              sp[0] = (unsigned short)f2bf(o[0][r] * f[i]); sp[32] = (unsigned short)f2bf(o[1][r] * f[i]); } }
      LDS_WAIT();
      bf16* Ow = ya + (rowbase + q0 + wid * 32) * 512 + h * 64;
#pragma unroll
      for (int i = 0; i < 4; ++i) { const int row = i * 8 + (lane >> 3), ch = lane & 7;
          { const v4u w_ = *(const LAS v4u*)(stg + row * 64 + ch * 8); CHKW_S(2, w_.x + w_.y + w_.z + w_.w); *(GAS v4u*)(Ow + (size_t)row * 512 + ch * 8) = w_; } } }
    LDS_WAIT();
    __syncthreads();
}
template <int VAR> __device__ __forceinline__ void phase(int zb, int vcu, const bf16* qmla, const bf16* kv, const bf16* kpe, const f32x2* cs32, bf16* ya, LAS unsigned char* shm) {
    const int bh = vcu >> 2, s = vcu & 3;
#pragma unroll 1
    for (int i = 0; i < 8; ++i) { const int qb = (i & 1) ? (8 * (i >> 1) + 7 - s) : (8 * (i >> 1) + s);
        unit<VAR>(zb, bh >> 3, bh & 7, qb, qmla, kv, kpe, cs32, ya, shm); }
}
}

namespace dsa {
#ifndef DSA_CAP
#define DSA_CAP 512
#endif
constexpr int CAP = DSA_CAP;
constexpr int L_SC = 0, L_HIST = 131072, L_MM = L_HIST + 4096, L_BITMAP = L_MM + 256, L_SEL = L_BITMAP + 4096, L_CAND = L_SEL + 2048, LDS_BYTES_USED = L_CAND + 4 * CAP * 8;
constexpr int L_BIG = 0, VW_BYTES = 10240, L_COMB = 8 * VW_BYTES;
static_assert(L_COMB + 4 * 64 * 20 * 4 <= L_HIST, "attention scratch inside the score region");
typedef short v4i16_t __attribute__((ext_vector_type(4)));
__device__ __forceinline__ s16x4 vtr(const LAS unsigned char* p) { return __builtin_bit_cast(s16x4, __builtin_amdgcn_ds_read_tr16_b64_v4i16((LAS v4i16_t*)p)); }
__device__ __forceinline__ unsigned ordk(float f) { const unsigned u = __builtin_bit_cast(unsigned, f); return u ^ ((u >> 31) ? 0xFFFFFFFFu : 0x80000000u); }
__device__ __forceinline__ float unordk(unsigned k) { return __builtin_bit_cast(float, (k & 0x80000000u) ? (k ^ 0x80000000u) : ~k); }
constexpr unsigned SC_MASKED = 0x7FC00000u;
__device__ __forceinline__ unsigned key_or0(unsigned raw) { return raw == SC_MASKED ? 0u : ordk(__builtin_bit_cast(float, raw)); }
__device__ __forceinline__ unsigned cvtpk(float lo, float hi) { typedef float f2 __attribute__((ext_vector_type(2))); typedef __bf16 b2 __attribute__((ext_vector_type(2)));
    f2 v = {lo, hi}; b2 b = __builtin_convertvector(v, b2); return __builtin_bit_cast(unsigned, b); }
__device__ __forceinline__ unsigned wave_incl_scan(unsigned x) { int v = (int)x;
    v += __builtin_amdgcn_update_dpp(0, v, 0x111, 0xf, 0xf, false); v += __builtin_amdgcn_update_dpp(0, v, 0x112, 0xf, 0xf, false);
    v += __builtin_amdgcn_update_dpp(0, v, 0x114, 0xf, 0xf, false); v += __builtin_amdgcn_update_dpp(0, v, 0x118, 0xf, 0xf, false);
    v += __builtin_amdgcn_update_dpp(0, v, 0x142, 0xa, 0xf, false); v += __builtin_amdgcn_update_dpp(0, v, 0x143, 0xc, 0xf, false);
    return (unsigned)v; }
#define DSA_BAR() do { LDS_WAIT(); __builtin_amdgcn_s_barrier(); asm volatile("" ::: "memory"); } while (0)
#ifndef DSA_REP_D
#define DSA_REP_D 1
#endif

__device__ __forceinline__ void quad(int zb, int b, int p0, int nb, int np0, const bf16* qidx, const bf16* kidx, const float* widx, const bf16* qb, const bf16* kb, const bf16* vb, bf16* yb, LAS unsigned char* shm) {
    int tid = zb; asm volatile("" : "+v"(tid));
    const int lane = tid & 63, c = lane & 31, hi = lane >> 5; const int wid = __builtin_amdgcn_readfirstlane(tid >> 6);
    const size_t tokbase = (size_t)b * SEQ;
    LAS unsigned* sc = (LAS unsigned*)(shm + L_SC); LAS unsigned* hist = (LAS unsigned*)(shm + L_HIST); LAS unsigned* mm = (LAS unsigned*)(shm + L_MM); LAS unsigned* bitmap = (LAS unsigned*)(shm + L_BITMAP);
    LAS unsigned short* sel = (LAS unsigned short*)(shm + L_SEL); LAS v2u* cand = (LAS v2u*)(shm + L_CAND);
    const int ntile = (p0 + 4 + 31) >> 5, nk32 = ntile * 32;
    for (int i = tid; i < 1024; i += 512) { hist[i] = 0u; bitmap[i] = 0u; }
    if (tid < 64) mm[tid] = ((tid >= 4 && tid < 8) || (tid >= 36 && tid < 40)) ? 0xFFFFFFFFu : 0u;
    {
        const int qi_a = 2 * ((c >> 2) & 1) + (c >> 4), head_a = (c & 3) | (((c >> 3) & 1) << 2);
        const bf16* qsrc = qidx + (tokbase + p0 + qi_a) * 512 + head_a * 64 + 8 * hi;
        bf16x8 aq[4];
#pragma unroll
        for (int d0 = 0; d0 < 4; ++d0) aq[d0] = __builtin_bit_cast(bf16x8, *(const GAS v4u*)(qsrc + 16 * d0));
        float wf[16];
#pragma unroll
        for (int j = 0; j < 2; ++j) { const GAS f32x4* wp = (const GAS f32x4*)(widx + (tokbase + p0 + 2 * hi + j) * 8);
            const f32x4 a = wp[0], bb = wp[1];
#pragma unroll
            for (int i = 0; i < 4; ++i) { wf[8 * j + i] = a[i] * (0.35355339059327373f * 0.125f); wf[8 * j + 4 + i] = bb[i] * (0.35355339059327373f * 0.125f); } }
        const GAS unsigned char* kb0 = (const GAS unsigned char*)(kidx + (size_t)b * 4 * 8192 * 16);
        const unsigned hoff = 16u * (unsigned)hi;
        const GAS unsigned char* kb1 = kb0 + 262144, *kb2 = kb0 + 2 * 262144, *kb3 = kb0 + 3 * 262144;
        asm volatile("" : "+s"(kb0), "+s"(kb1), "+s"(kb2), "+s"(kb3));
        float pinf = INFINITY, ninf = -INFINITY; asm volatile("" : "+s"(pinf), "+s"(ninf));
        float mxf0 = -INFINITY, mxf1 = -INFINITY, mnf0 = INFINITY, mnf1 = INFINITY;
        v4u kf[3][4];
#define DSA_KLOAD(S, T) do { int key_ = (T) * 32 + c; key_ = key_ < SEQ ? key_ : SEQ - 1; const unsigned off_ = (unsigned)key_ * 32u + hoff; \
            kf[S][0] = *(const GAS v4u*)(kb0 + off_); kf[S][1] = *(const GAS v4u*)(kb1 + off_); kf[S][2] = *(const GAS v4u*)(kb2 + off_); kf[S][3] = *(const GAS v4u*)(kb3 + off_); } while (0)
#define DSA_RELU(x) __builtin_amdgcn_fmed3f((x), 0.f, pinf)
#define DSA_KCOMP(S, T) do { if ((T) < ntile) { const int key = (T) * 32 + c; f32x16 acc = f32x16{}; \
            _Pragma("unroll") for (int d0 = 0; d0 < 4; ++d0) acc = __builtin_amdgcn_mfma_f32_32x32x16_bf16(aq[d0], __builtin_bit_cast(bf16x8, kf[S][d0]), acc, 0, 0, 0); \
            float s0a = wf[0] * DSA_RELU(acc[0]), s0b = wf[4] * DSA_RELU(acc[4]), s1a = wf[8] * DSA_RELU(acc[8]), s1b = wf[12] * DSA_RELU(acc[12]); \
            _Pragma("unroll") for (int r = 1; r < 4; ++r) { s0a += wf[r] * DSA_RELU(acc[r]); s0b += wf[4 + r] * DSA_RELU(acc[4 + r]); s1a += wf[8 + r] * DSA_RELU(acc[8 + r]); s1b += wf[12 + r] * DSA_RELU(acc[12 + r]); } \
            const float s0 = (s0a + s0b) + 0.f, s1 = (s1a + s1b) + 0.f;        \
            const bool v0_ = key <= p0 + 2 * hi, v1_ = key <= p0 + 2 * hi + 1; \
            sc[(2 * hi) * 8192 + key] = v0_ ? __builtin_bit_cast(unsigned, s0) : SC_MASKED; sc[(2 * hi + 1) * 8192 + key] = v1_ ? __builtin_bit_cast(unsigned, s1) : SC_MASKED; \
            mxf0 = __builtin_amdgcn_fmed3f(mxf0, v0_ ? s0 : -INFINITY, pinf); mnf0 = __builtin_amdgcn_fmed3f(mnf0, v0_ ? s0 : INFINITY, ninf); \
            mxf1 = __builtin_amdgcn_fmed3f(mxf1, v1_ ? s1 : -INFINITY, pinf); mnf1 = __builtin_amdgcn_fmed3f(mnf1, v1_ ? s1 : INFINITY, ninf); } } while (0)
#ifndef DSA_REP_A
#define DSA_REP_A 1
#endif
        _Pragma("unroll") for (int repA = 0; repA < DSA_REP_A; ++repA) {
        DSA_KLOAD(0, wid); DSA_KLOAD(1, wid + 8); DSA_KLOAD(2, wid + 16);
#pragma unroll 1
        for (int t = wid; t < ntile; t += 24) {
            DSA_KCOMP(0, t);      DSA_KLOAD(0, t + 24);
            DSA_KCOMP(1, t + 8);  DSA_KLOAD(1, t + 32);
            DSA_KCOMP(2, t + 16); DSA_KLOAD(2, t + 40);
        }
        }
#undef DSA_KLOAD
#undef DSA_KCOMP
#undef DSA_RELU
        const unsigned mx0 = mxf0 == -INFINITY ? 0u : ordk(mxf0), mx1 = mxf1 == -INFINITY ? 0u : ordk(mxf1), mn0 = mnf0 == INFINITY ? 0xFFFFFFFFu : ordk(mnf0), mn1 = mnf1 == INFINITY ? 0xFFFFFFFFu : ordk(mnf1);
        DSA_BAR();
        if (mx0) { __hip_atomic_fetch_max(&mm[2 * hi], mx0, __ATOMIC_RELAXED, __HIP_MEMORY_SCOPE_WORKGROUP); __hip_atomic_fetch_min(&mm[4 + 2 * hi], mn0, __ATOMIC_RELAXED, __HIP_MEMORY_SCOPE_WORKGROUP); }
        if (mx1) { __hip_atomic_fetch_max(&mm[2 * hi + 1], mx1, __ATOMIC_RELAXED, __HIP_MEMORY_SCOPE_WORKGROUP); __hip_atomic_fetch_min(&mm[5 + 2 * hi], mn1, __ATOMIC_RELAXED, __HIP_MEMORY_SCOPE_WORKGROUP); }
        __hip_atomic_fetch_min(&mm[36 + 2 * hi], mx0, __ATOMIC_RELAXED, __HIP_MEMORY_SCOPE_WORKGROUP); __hip_atomic_fetch_min(&mm[37 + 2 * hi], mx1, __ATOMIC_RELAXED, __HIP_MEMORY_SCOPE_WORKGROUP);
    }
    DSA_BAR();
    v4u pf_ = {0u, 0u, 0u, 0u}, pf2_ = {0u, 0u, 0u, 0u};
    if (nb >= 0) { const size_t ntok = (size_t)nb * SEQ + np0;
        pf_ = *(const GAS v4u*)((tid < 256 ? qidx : qb) + ntok * 512 + (size_t)(tid & 255) * 8);
        if (tid < 8) pf2_ = *(const GAS v4u*)(widx + ntok * 8 + tid * 4); }
    float basef[4], scl[4];
#pragma unroll
    for (int q = 0; q < 4; ++q) { const unsigned mxk = mm[q], lm = mm[36 + q]; unsigned mnk = mm[4 + q]; const unsigned l0 = lm > 1u ? lm : 1u; mnk = mnk > l0 ? mnk : l0;
        const float a = unordk(mxk), bq_ = unordk(mnk);
        basef[q] = (mxk && mnk != 0xFFFFFFFFu) ? bq_ : 0.f; scl[q] = (mxk && a > bq_) ? 255.99f / (a - bq_) : 1.f; }
#ifndef DSA_REP_SEL
#define DSA_REP_SEL 1
#endif
    for (int repS = 0; repS < DSA_REP_SEL; ++repS) {
    if (repS > 0) { DSA_BAR(); for (int i = tid; i < 1024; i += 512) { hist[i] = 0u; bitmap[i] = 0u; } if (tid < 4) mm[8 + tid] = 0u; DSA_BAR(); }
#ifndef DSA_REP_S2
#define DSA_REP_S2 1
#endif
#ifndef DSA_REP_S4
#define DSA_REP_S4 1
#endif
    v4u vva_[4][4];
    _Pragma("unroll") for (int rp2 = DSA_REP_S2 - 1; rp2 >= 0; --rp2) { LAS unsigned* hist_ = rp2 ? (LAS unsigned*)cand : hist;
    LAS unsigned char* hq_[4];
    LAS unsigned* dummy_ = (LAS unsigned*)(shm + 158208) + tid;
#pragma unroll
    for (int q = 0; q < 4; ++q) { hq_[q] = (LAS unsigned char*)(hist_ + q * 256); asm volatile("" : "+s"(hq_[q])); }
#pragma unroll
    for (int q = 0; q < 4; ++q)
#pragma unroll
        for (int it_ = 0; it_ < 4; ++it_) vva_[q][it_] = *(const LAS v4u*)(sc + q * 8192 + 4 * tid + 2048 * it_);
#pragma unroll
    for (int q = 0; q < 4; ++q) {
#pragma unroll
        for (int it_ = 0; it_ < 4; ++it_) { const int idx = 4 * tid + 2048 * it_; if (idx >= nk32) break; const v4u v = vva_[q][it_];
#pragma unroll
            for (int e = 0; e < 4; ++e) { const unsigned raw = v[e]; const float d = __builtin_bit_cast(float, raw) - basef[q], xb_ = d * scl[q];
                vva_[q][it_][e] = __builtin_bit_cast(unsigned, xb_);
                { const unsigned bn = (unsigned)(int)xb_;
                  LAS unsigned* tgt_ = d >= 0.f ? (LAS unsigned*)(hq_[q] + 4u * bn) : dummy_;
                  __hip_atomic_fetch_add(tgt_, 1u, __ATOMIC_RELAXED, __HIP_MEMORY_SCOPE_WORKGROUP); } } } }
    }
    DSA_BAR();
    int bsq[4]; unsigned cgq[4], fbq[4];
#pragma unroll
    for (int q = 0; q < 4; ++q) {
        const v4u h4 = *(const LAS v4u*)(hist + q * 256 + 4 * lane);
        const unsigned t4 = h4.x + h4.y + h4.z + h4.w; const unsigned incl = wave_incl_scan(t4); const unsigned tot = (unsigned)__builtin_amdgcn_readlane((int)incl, 63);
        const unsigned S = tot - incl + t4;
        const unsigned excl = S - t4, s3 = excl + h4.w, s2 = s3 + h4.z, s1 = s2 + h4.y;
        const unsigned long long mask = __ballot(S >= 256u);
        if (mask == 0ull) { bsq[q] = -1; cgq[q] = tot; fbq[q] = 0u; }
        else { const int L = 63 - __builtin_clzll(mask);
            const int bb = s3 >= 256u ? 3 : s2 >= 256u ? 2 : s1 >= 256u ? 1 : 0; const unsigned nc = bb == 3 ? s3 : bb == 2 ? s2 : bb == 1 ? s1 : S;
            const unsigned hb = bb == 3 ? h4.w : bb == 2 ? h4.z : bb == 1 ? h4.y : h4.x;
            bsq[q] = __builtin_amdgcn_readlane(4 * lane + bb, L); cgq[q] = (unsigned)__builtin_amdgcn_readlane((int)(nc - hb), L); fbq[q] = (unsigned)__builtin_amdgcn_readlane(hb > (unsigned)CAP ? 1 : 0, L); }
    }
    const unsigned fb_any = fbq[0] | fbq[1] | fbq[2] | fbq[3];
    _Pragma("unroll") for (int rp4 = DSA_REP_S4 - 1; rp4 >= 0; --rp4) { LAS unsigned* cnt_ = mm + (rp4 ? 44 : 8);
#pragma unroll
    for (int q = 0; q < 4; ++q) { const int bs = bsq[q];
        if (!fbq[q]) { const float tlo = bs < 0 ? 0.f : (float)bs, thi = bs < 0 ? 0.f : bs >= 255 ? INFINITY : (float)(bs + 1);
          {
#pragma unroll
            for (int it_ = 0; it_ < 4; ++it_) { const int idx = 4 * tid + 2048 * it_; if (idx >= nk32) break; const v4u v = vva_[q][it_];
                float xe_[4]; unsigned m_ = 0u; bool inb_ = false;
#pragma unroll
                for (int e = 0; e < 4; ++e) { const unsigned raw = v[e]; xe_[e] = __builtin_bit_cast(float, raw);
                    const bool ab_ = xe_[e] >= thi; m_ |= ab_ ? (1u << e) : 0u; inb_ = inb_ || (xe_[e] >= tlo && !ab_); }
                __hip_atomic_fetch_or(&bitmap[q * 256 + (idx >> 5)], m_ << (idx & 31), __ATOMIC_RELAXED, __HIP_MEMORY_SCOPE_WORKGROUP);
                if (inb_) {
#pragma unroll
                    for (int e = 0; e < 4; ++e) if (xe_[e] >= tlo && !(xe_[e] >= thi)) { const unsigned ix = (unsigned)(idx + e);
                        const unsigned pos = __hip_atomic_fetch_add(&cnt_[q], 1u, __ATOMIC_RELAXED, __HIP_MEMORY_SCOPE_WORKGROUP);
                        if (pos < (unsigned)CAP) cand[q * CAP + pos] = (v2u){ordk(__builtin_bit_cast(float, sc[q * 8192 + ix])), ix}; } } } } } }
    if (rp4) DSA_BAR(); }
    DSA_BAR();
    const int bs_w = wid == 0 ? bsq[0] : wid == 1 ? bsq[1] : wid == 2 ? bsq[2] : bsq[3]; const unsigned cg_w = wid == 0 ? cgq[0] : wid == 1 ? cgq[1] : wid == 2 ? cgq[2] : cgq[3], fb_w = wid == 0 ? fbq[0] : wid == 1 ? fbq[1] : wid == 2 ? fbq[2] : fbq[3];
    if (wid < 4 && !fb_w && bs_w >= 0) {
        const int n = (int)mm[8 + wid], r = 256 - (int)cg_w;
        const LAS v2u* cl = cand + wid * CAP; LAS unsigned* bm = bitmap + wid * 256;
#ifndef DSA_RANKMAX
#define DSA_RANKMAX 64
#endif
        if (n <= DSA_RANKMAX) {
            const v2u me = cl[lane < n ? lane : 0]; int rank = 0;
            for (int jx = 0; jx < n; ++jx) { const v2u o = cl[jx]; rank += (o.x > me.x || (o.x == me.x && o.y < me.y)) ? 1 : 0; }
            if (lane < n && rank < r) __hip_atomic_fetch_or(&bm[me.y >> 5], 1u << (me.y & 31), __ATOMIC_RELAXED, __HIP_MEMORY_SCOPE_WORKGROUP);
        } else {
            unsigned Tk = 0u;
            for (int bit = 31; bit >= 0; --bit) { const unsigned ct = Tk | (1u << bit); int cnt = 0;
                for (int e0 = 0; e0 < n; e0 += 64) { const int e = e0 + lane; const bool pr = (e < n) && (cl[e < n ? e : 0].x >= ct); cnt += __popcll(__ballot(pr)); }
                if (cnt >= r) Tk = ct; }
            int ngt = 0, neq = 0;
            for (int e0 = 0; e0 < n; e0 += 64) { const int e = e0 + lane; const unsigned x = cl[e < n ? e : 0].x; ngt += __popcll(__ballot(e < n && x > Tk)); neq += __popcll(__ballot(e < n && x == Tk)); }
            const int r2 = r - ngt; unsigned X = 0u;
            if (neq > r2) { for (int bit = 12; bit >= 0; --bit) { const unsigned cx = X | (1u << bit); int cnt = 0;
                    for (int e0 = 0; e0 < n; e0 += 64) { const int e = e0 + lane; const v2u ce = cl[e < n ? e : 0]; cnt += __popcll(__ballot(e < n && ce.x == Tk && (8191u - ce.y) >= cx)); }
                    if (cnt >= r2) X = cx; } }
            for (int e = lane; e < n; e += 64) { const v2u ce = cl[e]; if (ce.x > Tk || (ce.x == Tk && (8191u - ce.y) >= X)) __hip_atomic_fetch_or(&bm[ce.y >> 5], 1u << (ce.y & 31), __ATOMIC_RELAXED, __HIP_MEMORY_SCOPE_WORKGROUP); }
        }
    }
    if (fb_any) {
        int step = 0;
        DSA_BAR();
        for (int q = 0; q < 4; ++q) { if (!(q == 0 ? fbq[0] : q == 1 ? fbq[1] : q == 2 ? fbq[2] : fbq[3])) continue;
            const LAS unsigned* sq = sc + q * 8192;
#define DSA_COUNT(PRED, OUT) do { int loc_ = 0; for (int idx = tid; idx < nk32; idx += 512) { const unsigned k = key_or0(sq[idx]); const unsigned inv = 8191u - (unsigned)idx; (void)inv; loc_ += (k && (PRED)) ? 1 : 0; } \
            if (tid == 0) mm[32 + (step + 1) % 3] = 0u; if (loc_) __hip_atomic_fetch_add(&mm[32 + step % 3], (unsigned)loc_, __ATOMIC_RELAXED, __HIP_MEMORY_SCOPE_WORKGROUP); \
            DSA_BAR(); OUT = (int)mm[32 + step % 3]; ++step; } while (0)
            unsigned Tk = 0u; int cnt;
            for (int bit = 31; bit >= 0; --bit) { const unsigned ct = Tk | (1u << bit); DSA_COUNT(k >= ct, cnt); if (cnt >= 256) Tk = ct; }
            int ngt, neq; DSA_COUNT(k > Tk, ngt); DSA_COUNT(k == Tk, neq);
            const int r = 256 - ngt; unsigned X = 0u;
            if (neq > r) { for (int bit = 12; bit >= 0; --bit) { const unsigned cx = X | (1u << bit); DSA_COUNT(k == Tk && inv >= cx, cnt); if (cnt >= r) X = cx; } }
            for (int idx = tid; idx < nk32; idx += 512) { const unsigned k = key_or0(sq[idx]);
                if (k && (k > Tk || (k == Tk && (8191u - (unsigned)idx) >= X))) __hip_atomic_fetch_or(&bitmap[q * 256 + (idx >> 5)], 1u << (idx & 31), __ATOMIC_RELAXED, __HIP_MEMORY_SCOPE_WORKGROUP); }
#undef DSA_COUNT
        }
        DSA_BAR();
    }
    LDS_WAIT(); asm volatile("" ::: "memory");
    if (wid < 4) {
        const v4u w4 = *(const LAS v4u*)(bitmap + wid * 256 + 4 * lane);
        const int cl_ = __popc(w4.x) + __popc(w4.y) + __popc(w4.z) + __popc(w4.w); const int incl = (int)wave_incl_scan((unsigned)cl_);
        int pos = incl - cl_; LAS unsigned short* sl = sel + wid * 256;
#pragma unroll
        for (int wi = 0; wi < 4; ++wi) { unsigned word = w4[wi]; while (word) { const int bit = __builtin_ctz(word); if (pos < 256) sl[pos] = (unsigned short)((4 * lane + wi) * 32 + bit); ++pos; word &= word - 1u; } }
        const int total = __builtin_amdgcn_readlane(incl, 63); const int ns = total < 256 ? total : 256;
        for (int e = ns + lane; e < 256; e += 64) sl[e] = 0;
        if (lane == 0) mm[24 + wid] = (unsigned)ns;
    }
    }
    DSA_BAR();
    _Pragma("unroll") for (int repD = 0; repD < DSA_REP_D; ++repD) {
        const int q = wid & 3, part = wid >> 2, hc = lane & 15, g = lane >> 4, head = hc & 7; const int nsel = (int)mm[24 + q];
        const size_t tok = tokbase + p0 + q; const LAS unsigned short* sl = sel + q * 256 + 128 * part;
        LAS unsigned char* Vw = shm + L_BIG + wid * VW_BYTES;
        bf16x8 bq[2];
#pragma unroll
        for (int s = 0; s < 2; ++s) bq[s] = __builtin_bit_cast(bf16x8, *(const GAS v4u*)(qb + tok * 512 + head * 64 + 32 * s + 8 * g));
        v4u kf[8][2], vg[2][8];
#pragma unroll
#ifndef DSA_DVAR
#define DSA_DVAR 0
#endif
#define DSA_DV(bit) ((DSA_DVAR & (bit)) && repD + 1 < DSA_REP_D)
        for (int kt = 0; kt < 8; ++kt) { const int key = sl[16 * kt + hc]; const bf16* ksrc = kb + (tokbase + key) * 64 + 8 * g;
            if (DSA_DV(1)) { kf[kt][0] = (v4u){0u, 0u, 0u, 0u}; kf[kt][1] = (v4u){0u, 0u, 0u, 0u}; } else {
            kf[kt][0] = *(const GAS v4u*)(ksrc); kf[kt][1] = *(const GAS v4u*)(ksrc + 32); } }
#define DSA_VLOAD(hf) _Pragma("unroll") for (int it = 0; it < 8; ++it) { const int id = it * 64 + lane, kl = id >> 3, ch = id & 7; const int key = sl[64 * (hf) + kl]; \
                if (DSA_DV(2)) vg[hf][it] = (v4u){0u, 0u, 0u, 0u}; else vg[hf][it] = *(const GAS v4u*)(vb + (tokbase + key) * 64 + ch * 8); }
        DSA_VLOAD(0)
        float st[8][4];
#pragma unroll
        for (int kt = 0; kt < 8; ++kt) {
            f32x4 a4 = {0.f, 0.f, 0.f, 0.f};
            a4 = __builtin_amdgcn_mfma_f32_16x16x32_bf16(__builtin_bit_cast(bf16x8, kf[kt][0]), bq[0], a4, 0, 0, 0);
            a4 = __builtin_amdgcn_mfma_f32_16x16x32_bf16(__builtin_bit_cast(bf16x8, kf[kt][1]), bq[1], a4, 0, 0, 0);
#pragma unroll
            for (int r = 0; r < 4; ++r) st[kt][r] = (128 * part + 16 * kt + 4 * g + r < nsel) ? a4[r] : -INFINITY; }
        DSA_VLOAD(1)
#undef DSA_VLOAD
        constexpr float SC = 0.125f * 1.4426950408889634f;
        float m = -1e30f;
#pragma unroll
        for (int kt = 0; kt < 8; ++kt)
#pragma unroll
            for (int r = 0; r < 4; ++r) m = fmaxf(m, st[kt][r]);
        m = fmaxf(m, __shfl_xor(m, 16)); m = fmaxf(m, __shfl_xor(m, 32));
        float l = 0.f;
#pragma unroll
        for (int kt = 0; kt < 8; ++kt)
#pragma unroll
            for (int r = 0; r < 4; ++r) { st[kt][r] = __builtin_amdgcn_exp2f((st[kt][r] - m) * SC); l += st[kt][r]; }
        l += __shfl_xor(l, 16); l += __shfl_xor(l, 32);
        f32x4 ot[4]; ot[0] = ot[1] = ot[2] = ot[3] = (f32x4){0.f, 0.f, 0.f, 0.f};
        const int vrd = (4 * g + ((lane & 15) >> 2)) * 160 + (lane & 3) * 8;
#pragma unroll
        for (int hf = 0; hf < 2; ++hf) { if (DSA_DV(4)) continue;
            asm volatile("" ::: "memory");
#pragma unroll
            for (int it = 0; it < 8; ++it) { const int id = it * 64 + lane, kl = id >> 3, ch = id & 7;
                *(LAS v4u*)(Vw + kl * 160 + ch * 16) = vg[hf][it]; }
            LDS_WAIT();
#pragma unroll
            for (int s2 = 0; s2 < 2; ++s2) { const int ta = 4 * hf + 2 * s2;
                v4u pw; pw.x = cvtpk(st[ta][0], st[ta][1]); pw.y = cvtpk(st[ta][2], st[ta][3]); pw.z = cvtpk(st[ta + 1][0], st[ta + 1][1]); pw.w = cvtpk(st[ta + 1][2], st[ta + 1][3]);
#pragma unroll
                for (int mt = 0; mt < 4; ++mt) { const LAS unsigned char* vp = Vw + vrd + (32 * s2) * 160 + mt * 32;
                    const s16x4 lo = vtr(vp), hh = vtr(vp + 16 * 160);
                    const bf16x8 vf = {lo[0], lo[1], lo[2], lo[3], hh[0], hh[1], hh[2], hh[3]};
                    ot[mt] = __builtin_amdgcn_mfma_f32_16x16x32_bf16(vf, __builtin_bit_cast(bf16x8, pw), ot[mt], 0, 0, 0); } }
            LDS_WAIT();
        }
        LAS float* cb = (LAS float*)(shm + L_COMB) + (q * 64 + lane) * 20;
        if (part == 1) { cb[0] = m; cb[1] = l;
#pragma unroll
            for (int mt = 0; mt < 4; ++mt) *(LAS f32x4*)(cb + 4 + 4 * mt) = ot[mt]; }
        DSA_BAR();
        if (part == 0) { const float m1 = cb[0], l1 = cb[1]; const float M = fmaxf(m, m1), f0 = __builtin_amdgcn_exp2f((m - M) * SC), f1 = __builtin_amdgcn_exp2f((m1 - M) * SC);
            const float inv = 1.f / (l * f0 + l1 * f1);
            if (hc < 8) {
#pragma unroll
                for (int mt = 0; mt < 4; ++mt) { const f32x4 o1 = *(const LAS f32x4*)(cb + 4 + 4 * mt); const f32x4 o = (ot[mt] * f0 + o1 * f1) * inv;
                    v2u w; w.x = cvtpk(o[0], o[1]); w.y = cvtpk(o[2], o[3]); CHKW_S(3, w.x + w.y); *(GAS v2u*)(yb + tok * 512 + head * 64 + 16 * mt + 4 * g) = w; } } }
    }
    DSA_BAR();
    asm volatile("" :: "v"(pf_), "v"(pf2_));
}
__device__ __forceinline__ void phase(int zb, int vcu, const bf16* qidx, const bf16* kidx, const float* widx, const bf16* qb, const bf16* kb, const bf16* vb, bf16* yb, LAS unsigned char* shm) {
#pragma unroll 1
    for (int j = 0; j < 64; ++j) { const int Qi = ((j & 1) ? 255 - vcu : vcu) + 256 * j, Qn = (((j + 1) & 1) ? 255 - vcu : vcu) + 256 * (j + 1);
        quad(zb, Qi >> 11, 4 * (Qi & 2047), j + 1 < 64 ? (Qn >> 11) : -1, 4 * (Qn & 2047), qidx, kidx, widx, qb, kb, vb, yb, shm); }
}
}

__device__ __forceinline__ void p8_router(Frame& F) {
    { const int gw = F.vcu * NWAVES + F.wave;
      if (gw == 0) { GAS unsigned long long* o8 = (GAS unsigned long long*)(WSP(bf16, WS_XN2) + (size_t)T * D) + F.lane;
#pragma unroll
          for (int j = 0; j < 4; ++j) o8[64 * j] = 0ull; } }
    LAS float* Wl = (LAS float*)F.lds;
    for (int i = F.tid; i < 1024 * 32; i += NWAVES * 64) Wl[i] = F.r_w[i] * F.ffn_g[i >> 5];
    __syncthreads();
    const int lane = F.lane, i32 = lane & 31, kk = lane >> 5;
    int* tok_e = WSP(int, WS_TOKE); float* tok_g = WSP(float, WS_TOKG); int* tok_r = WSP(int, WS_TOKR); unsigned* cnt = WSP(unsigned, WS_CNT);
    for (int task = F.vcu * NWAVES + F.wave; task < NTASK; task += F.G * NWAVES) {
        const int t0 = task * 32;
        f32x16 acc = f32x16{}; float ss = 0.f;
        const float* xr = F.out + (size_t)(t0 + i32) * 1024 + 4 * kk;
#pragma unroll 4
        for (int m = 0; m < 128; ++m) { const f32x4 xv = *(const GAS f32x4*)(xr + 8 * m);
            ss += (xv[0] * xv[0] + xv[1] * xv[1]) + (xv[2] * xv[2] + xv[3] * xv[3]);
            const LAS float* wp = Wl + (8 * m + 4 * kk) * 32 + i32;
#pragma unroll
            for (int j = 0; j < 4; ++j) acc = __builtin_amdgcn_mfma_f32_32x32x2f32(xv[j], wp[32 * j], acc, 0, 0, 0); }
        ss += __shfl_xor(ss, 32);
        const float rstd = 1.f / sqrtf(ss * (1.f / 1024.f) + EPS);
        if (kk == 0) WSP(float, WS_RSTOK)[t0 + i32] = rstd;
        const float bias = F.r_b[i32];
        unsigned pickmask = 0u, kcode = 0u; int cnt_e = 0;
#pragma unroll
        for (int r = 0; r < 16; ++r) {
            const int tl_ = (r & 3) + 8 * (r >> 2) + 4 * kk;
            float v = acc[r] * __shfl(rstd, tl_) + bias;
            float tl[4]; int te[4];
#pragma unroll
            for (int k = 0; k < 4; ++k) { float bv = v; int be = i32;
#pragma unroll
                for (int o = 1; o < 32; o <<= 1) { const float ov = __shfl_xor(bv, o); const int oe = __shfl_xor(be, o); if (ov > bv || (ov == bv && oe < be)) { bv = ov; be = oe; } }
                tl[k] = bv; te[k] = be;
                if (be == i32) { v = -INFINITY; pickmask |= 1u << r; kcode |= (unsigned)k << (2 * r); ++cnt_e; } }
            const float e1 = __expf(tl[1] - tl[0]), e2 = __expf(tl[2] - tl[0]), e3 = __expf(tl[3] - tl[0]); const float inv = 1.f / (1.f + e1 + e2 + e3);
            if (i32 < 4) { const int k = i32; const int ee = k == 0 ? te[0] : k == 1 ? te[1] : k == 2 ? te[2] : te[3]; const float gg = (k == 0 ? 1.f : k == 1 ? e1 : k == 2 ? e2 : e3) * inv;
                CHKW_S(6, (unsigned)ee + __builtin_bit_cast(unsigned, gg)); tok_e[(size_t)(t0 + tl_) * 4 + k] = ee; tok_g[(size_t)(t0 + tl_) * 4 + k] = gg; }
        }
        const int c_other = __shfl_xor(cnt_e, 32);
        const int base = kk ? c_other : 0;
#pragma unroll
        for (int r = 0; r < 16; ++r) if ((pickmask >> r) & 1u) { const int tl_ = (r & 3) + 8 * (r >> 2) + 4 * kk; const int k = (kcode >> (2 * r)) & 3;
            tok_r[(size_t)(t0 + tl_) * 4 + k] = base + __popc(pickmask & ((1u << r) - 1u)); }
        if (kk == 0) cnt[(size_t)task * 32 + i32] = (unsigned)(cnt_e + c_other);
    }
}

__device__ __forceinline__ void p9_slots(Frame& F) {
    const unsigned* cnt = WSP(unsigned, WS_CNT); const int* tok_e = WSP(int, WS_TOKE); const int* tok_r = WSP(int, WS_TOKR); int* rowtok = WSP(int, WS_ROWTOK); int* blke = WSP(int, WS_BLKE); int* rowsrc = WSP(int, WS_ROWSRC); float* rowrs = WSP(float, WS_ROWRS); const float* rs_tok = WSP(float, WS_RSTOK);
    LAS int* sm_tot = (LAS int*)F.lds; LAS int* sm_pre = sm_tot + 512; LAS int* s_total = sm_pre + 512; LAS int* s_pad = s_total + 32; LAS int* s_base = s_pad + 40;
    const int e = F.tid & 31, grp = F.tid >> 5, first = F.vcu * NWAVES;
    { int tot = 0, pre = 0;
      for (int tk = grp * 128; tk < grp * 128 + 128; ++tk) { const int c = (int)cnt[(size_t)tk * 32 + e]; tot += c; pre += (tk < first) ? c : 0; }
      sm_tot[grp * 32 + e] = tot; sm_pre[grp * 32 + e] = pre; }
    __syncthreads();
    if (F.tid < 32) { int tot = 0, pre = 0;
        for (int g = 0; g < 16; ++g) { tot += sm_tot[g * 32 + e]; pre += sm_pre[g * 32 + e]; }
        s_total[e] = tot;
        for (int w = 0; w < 8; ++w) { s_base[w * 32 + e] = pre; pre += (int)cnt[(size_t)(first + w) * 32 + e]; } }
    __syncthreads();
    if (F.tid == 0) { int ps = 0; for (int q = 0; q < 32; ++q) { s_pad[q] = ps; ps += ((s_total[q] + 255) >> 8) << 8; } s_pad[32] = ps; }
    __syncthreads();
    { const int t0 = (first + F.wave) * 32;
#pragma unroll
      for (int u = 0; u < 2; ++u) { const int p = 2 * F.lane + u; const size_t q = (size_t)(t0 + (p >> 2)) * 4 + (p & 3); const int ee = tok_e[q];
          { const int sl_ = s_pad[ee] + s_base[F.wave * 32 + ee] + tok_r[q]; CHKW_S(6, (unsigned)sl_ * 2654435761u + (unsigned)q); rowtok[sl_] = (int)q; rowsrc[sl_] = (int)(q >> 2); rowrs[sl_] = rs_tok[q >> 2]; } } }
    if (F.vcu < 32) { const int q = F.vcu; for (int s = s_pad[q] + s_total[q] + F.tid; s < s_pad[q + 1]; s += NWAVES * 64) { rowtok[s] = -1; rowsrc[s] = T; rowrs[s] = 0.f; } }
    if (F.vcu == 32) { const int nblk = s_pad[32] >> 8;
        for (int bq = F.tid; bq < nblk; bq += NWAVES * 64) { int ee = 0; for (int q = 1; q < 32; ++q) ee += (bq * 256 >= s_pad[q]) ? 1 : 0; blke[bq] = ee; }
        if (F.tid == 0) blke[MAXBLK] = nblk; }
}

__device__ __forceinline__ void p10_moe(Frame& F, int probe_skip) {
    const int* rowtok = WSP(int, WS_ROWTOK); const int* rowsrc = WSP(int, WS_ROWSRC); const int* blke = WSP(int, WS_BLKE);
    bf16* act = WSP(bf16, WS_SCR) + (size_t)F.vcu * (256 * 1024);
    const int nblk = blke[MAXBLK], nfull = (nblk / F.G) * F.G;
#pragma unroll 1
    for (int bq = F.vcu; bq < nfull; bq += F.G) {
        const int e = blke[bq];
        int z1, z2; asm volatile("v_mov_b32 %0, 0" : "=v"(z1)); asm volatile("v_mov_b32 %0, 0" : "=v"(z2));
#ifndef MOE_REP_GU
#define MOE_REP_GU 1
#endif
#ifndef MOE_REP_DN
#define MOE_REP_DN 1
#endif
        int nrg_ = MOE_REP_GU, nrd_ = MOE_REP_DN; if (MOE_REP_GU > 1 || MOE_REP_DN > 1) asm volatile("" : "+s"(nrg_), "+s"(nrd_));
        if (!(probe_skip & 1))
        _Pragma("unroll 1") for (int rg_ = 0; rg_ < nrg_; ++rg_)
        { pg8::Gemm g{WSP(bf16, WS_XN2), WSP(bf16, WS_WGU), 256, 2048 * 32, 1024}; pg8::ListOrderT<true> S{8, e * 8, F.tid + z1, rowsrc + bq * 256}; pg8::EpiGU E{act, F.b_gu + (size_t)e * 2048, WSP(float, WS_ROWRS) + bq * 256};
          pg8::gemm_phase<pg8::EpiGU, pg8::ListOrderT<true>, true, true>(F.lds, g, S, E); if (rg_ + 1 < nrg_) { VM_WAIT(); __syncthreads(); } }
        VM_WAIT(); __syncthreads();
        if (F.tid == 0) __builtin_amdgcn_fence(__ATOMIC_ACQUIRE, "agent");
        VM_WAIT(); __syncthreads();
        if (!(probe_skip & 2))
        _Pragma("unroll 1") for (int rd_ = 0; rd_ < nrd_; ++rd_)
        { pg8::Gemm g{act, WSP(bf16, WS_WD), 256, 1024 * 32, 1024}; pg8::ListOrderT<false> S{4, e * 4, F.tid + z2, nullptr}; pg8::EpiDown E{WSP(bf16, WS_YBUF), F.b_d + (size_t)e * 1024, rowtok + bq * 256};
          pg8::gemm_phase<pg8::EpiDown, pg8::ListOrderT<false>, true, true>(F.lds, g, S, E); if (rd_ + 1 < nrd_) { VM_WAIT(); __syncthreads(); } }
        __syncthreads();
    }
}
#ifndef MOE_PAIR
#define MOE_PAIR 0
#endif
__device__ __forceinline__ void p10_moe_pair(Frame& F) {
    const int* rowtok = WSP(int, WS_ROWTOK); const int* rowsrc = WSP(int, WS_ROWSRC); const int* blke = WSP(int, WS_BLKE);
    const int nblk = blke[MAXBLK], nfull = (nblk / F.G) * F.G, R = nfull / F.G;
    const int j = F.vcu & 31, xg = F.vcu >> 5, half = (j >> 4) & 1, k = j & 15, pr = xg * 16 + k;
    bf16* actb[2] = {WSP(bf16, WS_SCR) + (size_t)(xg * 32 + k) * (256 * 1024), WSP(bf16, WS_SCR) + (size_t)(xg * 32 + 16 + k) * (256 * 1024)};
    gu32* flags = F.ctl + 12288 + pr * 16;
#pragma unroll 1
    for (int st = 0; st < 2 * R; ++st) {
        const int bq = (st >> 1) * F.G + xg * 32 + 16 * (st & 1) + k, e = blke[bq];
        bf16* act = actb[st & 1];
        int z1, z2; asm volatile("v_mov_b32 %0, 0" : "=v"(z1)); asm volatile("v_mov_b32 %0, 0" : "=v"(z2));
        { pg8::Gemm g{WSP(bf16, WS_XN2), WSP(bf16, WS_WGU), 256, 2048 * 32, 1024}; pg8::ListOrderT<true> S{4, e * 8 + 4 * half, F.tid + z1, rowsrc + bq * 256}; pg8::EpiGU E{act, F.b_gu + (size_t)e * 2048, WSP(float, WS_ROWRS) + bq * 256};
          pg8::gemm_phase<pg8::EpiGU, pg8::ListOrderT<true>, true, true>(F.lds, g, S, E); }
        VM_WAIT(); __syncthreads();
        if (F.tid == 0) { __builtin_amdgcn_fence(__ATOMIC_RELEASE, "agent"); __hip_atomic_fetch_add(flags + st, 1u, __ATOMIC_RELAXED, __HIP_MEMORY_SCOPE_AGENT);
            while (__hip_atomic_load(flags + st, __ATOMIC_RELAXED, __HIP_MEMORY_SCOPE_AGENT) < 2u) __builtin_amdgcn_s_sleep(2);
            __builtin_amdgcn_fence(__ATOMIC_ACQUIRE, "agent"); }
        VM_WAIT(); __syncthreads();
        { pg8::Gemm g{act, WSP(bf16, WS_WD), 256, 1024 * 32, 1024}; pg8::ListOrderT<false> S{2, e * 4 + 2 * half, F.tid + z2, nullptr}; pg8::EpiDown E{WSP(bf16, WS_YBUF), F.b_d + (size_t)e * 1024, rowtok + bq * 256};
          pg8::gemm_phase<pg8::EpiDown, pg8::ListOrderT<false>, true, true>(F.lds, g, S, E); }
        __syncthreads();
    }
}
__device__ __forceinline__ void p10b_moe_tail_gu(Frame& F) {
    const int* rowsrc = WSP(int, WS_ROWSRC); const int* blke = WSP(int, WS_BLKE);
    const int nblk = blke[MAXBLK], nfull = (nblk / F.G) * F.G, nu = (nblk - nfull) * 8;
#pragma unroll 1
    for (int u = F.vcu; u < nu; u += F.G) {
        const int bl = u >> 3, bq = nfull + bl, e = blke[bq];
        int z1; asm volatile("v_mov_b32 %0, 0" : "=v"(z1));
        pg8::Gemm g{WSP(bf16, WS_XN2), WSP(bf16, WS_WGU), 256, 2048 * 32, 1024}; pg8::ListOrderT<true> S{1, e * 8 + (u & 7), F.tid + z1, rowsrc + bq * 256}; pg8::EpiGU E{WSP(bf16, WS_TAILACT) + (size_t)bl * (256 * 1024), F.b_gu + (size_t)e * 2048, WSP(float, WS_ROWRS) + bq * 256};
        pg8::gemm_phase<pg8::EpiGU, pg8::ListOrderT<true>, true, true>(F.lds, g, S, E);
        __syncthreads();
    }
}
__device__ __forceinline__ void p10c_moe_tail_down(Frame& F) {
    const int* rowtok = WSP(int, WS_ROWTOK); const int* blke = WSP(int, WS_BLKE);
    const int nblk = blke[MAXBLK], nfull = (nblk / F.G) * F.G, nu = (nblk - nfull) * 4;
#pragma unroll 1
    for (int u = F.vcu; u < nu; u += F.G) {
        const int bl = u >> 2, bq = nfull + bl, e = blke[bq];
        int z1; asm volatile("v_mov_b32 %0, 0" : "=v"(z1));
        pg8::Gemm g{WSP(bf16, WS_TAILACT) + (size_t)bl * (256 * 1024), WSP(bf16, WS_WD), 256, 1024 * 32, 1024}; pg8::ListOrderT<false> S{1, e * 4 + (u & 3), F.tid + z1, nullptr}; pg8::EpiDown E{WSP(bf16, WS_YBUF), F.b_d + (size_t)e * 1024, rowtok + bq * 256};
        pg8::gemm_phase<pg8::EpiDown, pg8::ListOrderT<false>, true, true>(F.lds, g, S, E);
        __syncthreads();
    }
}

__device__ __forceinline__ void p11_final(Frame& F) {
    const int gw = F.vcu * NWAVES + F.wave, NGW = F.G * NWAVES, lane = F.lane;
    const float* tok_g = WSP(float, WS_TOKG); const bf16* ybuf = WSP(bf16, WS_YBUF);
    for (int t = gw; t < T; t += NGW) {
        GAS f32x4* xr = (GAS f32x4*)(F.out + (size_t)t * D) + lane; const GAS f32x4* gr = (const GAS f32x4*)F.fin_g + lane;
        const f32x4 gt = *(const GAS f32x4*)(tok_g + (size_t)t * 4);
        f32x4 v[4];
#pragma unroll
        for (int j = 0; j < 4; ++j) v[j] = xr[64 * j];
#pragma unroll
        for (int k = 0; k < 4; ++k) { const GAS v2u* yr = (const GAS v2u*)(ybuf + ((size_t)t * 4 + k) * D) + lane; const float gk = gt[k];
#pragma unroll
            for (int j = 0; j < 4; ++j) { const v2u w = yr[64 * j]; v[j].x += gk * bflo(w.x); v[j].y += gk * bfhi(w.x); v[j].z += gk * bflo(w.y); v[j].w += gk * bfhi(w.y); } }
        float s = 0.f;
#pragma unroll
        for (int j = 0; j < 4; ++j) s += (v[j].x * v[j].x + v[j].y * v[j].y) + (v[j].z * v[j].z + v[j].w * v[j].w);
        const float rstd = 1.f / sqrtf(wave_sum(s) * (1.f / 1024.f) + EPS);
#pragma unroll
        for (int j = 0; j < 4; ++j) { const f32x4 gg = gr[64 * j]; const f32x4 r_ = v[j] * rstd * gg; CHKW_S(6, __builtin_bit_cast(unsigned, r_[0]) + __builtin_bit_cast(unsigned, r_[1]) + __builtin_bit_cast(unsigned, r_[2]) + __builtin_bit_cast(unsigned, r_[3])); xr[64 * j] = r_; }
    }
}

struct Args { const void* in[19]; float* out; unsigned char* ws; int ph_lo, ph_hi, li, pad; };
__global__ void __launch_bounds__(NWAVES * 64, 2) mk_fwd(Args args) {
    extern __shared__ __attribute__((aligned(16))) unsigned char lds[];
    Frame F;
    F.lds = (LAS unsigned char*)lds;
    F.MISC = (volatile LAS unsigned*)(F.lds + MISC_OFF);
    F.tid = threadIdx.x; F.lane = F.tid & 63; F.wave = __builtin_amdgcn_readfirstlane(F.tid >> 6);
    F.G = gridDim.x; { const int bx = blockIdx.x; F.vcu = (bx % 8) * (F.G / 8) + bx / 8; }
    F.ws = args.ws; F.ctl = (gu32*)(args.ws + WS_CTL);
    F.x = (const float*)args.in[0]; F.pos = (const int*)args.in[1]; F.out = args.out;
    F.attn_g = (const float*)args.in[2]; F.w_in = (const float*)args.in[3]; F.qn_g = (const float*)args.in[4]; F.w_uq = (const float*)args.in[5]; F.kvn_g = (const float*)args.in[6];
    F.w_ukv = (const float*)args.in[7]; F.w_ba = (const float*)args.in[8]; F.w_bb = (const float*)args.in[9]; F.w_out = (const float*)args.in[10]; F.ffn_g = (const float*)args.in[11];
    F.r_w = (const float*)args.in[12]; F.r_b = (const float*)args.in[13]; F.w_gu = (const float*)args.in[14]; F.b_gu = (const float*)args.in[15]; F.w_d = (const float*)args.in[16];
    F.b_d = (const float*)args.in[17]; F.fin_g = (const float*)args.in[18];
    if (F.tid < 16) F.MISC[F.tid] = 0u;
#if defined(SELFCHK2)
    if (F.tid < 64) ((LAS unsigned*)(F.lds + 163072))[F.tid] = 0u;
#endif
    __syncthreads();
    XcdBarrier bar; bar.bar = (unsigned*)(F.ctl + CW_BAR); bar.x = 0; bar.st = nullptr;
    if (N_LAUNCHES == 1) bar = xcd_barrier_post((unsigned*)(F.ctl + CW_BAR) + args.li * 4096, F.MISC + 0);
#if defined(DBL_BAR)
#define GRID_BAR() do { if (N_LAUNCHES == 1) { xcd_barrier(bar); xcd_barrier(bar); } } while (0)
#elif defined(SYS_ACQ)
#define GRID_BAR() do { if (N_LAUNCHES == 1) { xcd_barrier(bar); if (F.tid == 0) __builtin_amdgcn_fence(__ATOMIC_ACQUIRE, ""); asm volatile("s_waitcnt vmcnt(0)" ::: "memory"); __syncthreads(); } } while (0)
#else
#define GRID_BAR() do { if (N_LAUNCHES == 1) { xcd_barrier(bar); } } while (0)
#endif
    const int lo = args.ph_lo, hi = args.ph_hi;
#ifndef DBG_MASK
#define DBG_MASK 0x1FFF
#endif
#define IN(k) ((((DBG_MASK) >> (k)) & 1) && lo <= (k) && (k) < hi)
#define BOTH(k) (IN(k) && IN((k) + 1))
#ifndef MOE_PROBE
#define MOE_PROBE 0
#endif
#ifndef DBG_DOUBLE
#define DBG_DOUBLE 0
#endif
#define REP(k) _Pragma("unroll") for (int rep_ = 0; rep_ < ((((DBG_DOUBLE) >> (k)) & 1) ? 2 : 1); ++rep_)
#define PHASE_BEGIN() int zz_; asm volatile("v_mbcnt_lo_u32_b32 %0, -1, 0\n\tv_mbcnt_hi_u32_b32 %0, -1, %0" : "=v"(zz_)); F.lane = zz_; F.tid = F.wave * 64 + F.lane; zz_ = F.tid

#if defined(PROBE_L2)
    {
        unsigned* R = (unsigned*)(F.ws + 1000 * MiB); const int G_ = F.G, w = (int)blockIdx.x, nb = (w + 1) % G_;
        unsigned bad = 0u;
        for (int round = 0; round < 3; ++round) {
            const unsigned v1 = 0x1000000u * (unsigned)(round + 1), v2 = v1 + 0x800000u;
            for (int i = F.tid; i < 8192; i += 512) R[(size_t)w * 8192 + i] = v1 + (unsigned)i;
            GRID_BAR();
            { unsigned x = 0; for (int i = F.tid; i < 8192; i += 512) x |= R[(size_t)nb * 8192 + i] ^ (v1 + (unsigned)i); if (x) bad |= 1u; }
            GRID_BAR();
            for (int i = F.tid; i < 8192; i += 512) R[(size_t)w * 8192 + i] = v2 + (unsigned)i;
            GRID_BAR();
            { unsigned x = 0; for (int i = F.tid; i < 8192; i += 512) x |= R[(size_t)nb * 8192 + i] ^ (v2 + (unsigned)i); if (x) bad |= 1u; }
            unsigned* S = R + (size_t)G_ * 8192;
            for (int i = F.tid; i < 256; i += 512) S[(size_t)i * 256 + w] = v1 + (unsigned)(i * 256 + w);
            GRID_BAR();
            { unsigned x = 0; for (int i = F.tid; i < 65536; i += 512) x |= S[i] ^ (v1 + (unsigned)i); if (x) bad |= 2u; }
            GRID_BAR();
        }
        if (bad) __hip_atomic_fetch_or((unsigned*)(F.ctl + 9), bad, RLX_AGENT);
        GRID_BAR();
    }
#endif
#if defined(SELFCHK)
#define CHK(k, off, bytes) do { int ln_; asm volatile("v_mbcnt_lo_u32_b32 %0, -1, 0\n\tv_mbcnt_hi_u32_b32 %0, -1, %0" : "=v"(ln_)); const unsigned* P_ = (const unsigned*)(F.ws + (off)); const size_t n_ = (size_t)(bytes) / 4; unsigned acc_ = 0; \
        for (size_t i_ = (size_t)F.vcu * 512 + F.wave * 64 + ln_; i_ < n_; i_ += (size_t)F.G * 512) acc_ += P_[i_]; \
        for (int o_ = 1; o_ < 64; o_ <<= 1) acc_ += __shfl_xor(acc_, o_); \
        if (ln_ == 0) __hip_atomic_fetch_add((unsigned*)(F.ctl + 64 + 32 * args.pad + (k)), acc_, RLX_AGENT); } while (0)
#define CHKOUT(k) do { int ln_; asm volatile("v_mbcnt_lo_u32_b32 %0, -1, 0\n\tv_mbcnt_hi_u32_b32 %0, -1, %0" : "=v"(ln_)); const unsigned* P_ = (const unsigned*)F.out; const size_t n_ = (size_t)T * D; unsigned acc_ = 0; \
        for (size_t i_ = (size_t)F.vcu * 512 + F.wave * 64 + ln_; i_ < n_; i_ += (size_t)F.G * 512) acc_ += P_[i_]; \
        for (int o_ = 1; o_ < 64; o_ <<= 1) acc_ += __shfl_xor(acc_, o_); \
        if (ln_ == 0) __hip_atomic_fetch_add((unsigned*)(F.ctl + 64 + 32 * args.pad + (k)), acc_, RLX_AGENT); } while (0)
#elif defined(SELFCHK2)
#define FLUSHK(k) do { LDS_WAIT(); __syncthreads(); if (F.wave == 0) { int ln_; asm volatile("v_mbcnt_lo_u32_b32 %0, -1, 0\n\tv_mbcnt_hi_u32_b32 %0, -1, %0" : "=v"(ln_)); LAS unsigned* sl_ = (LAS unsigned*)(F.lds + 163072) + ln_; \
        unsigned acc_ = *sl_; *sl_ = 0u; for (int o_ = 1; o_ < 64; o_ <<= 1) acc_ += __shfl_xor(acc_, o_); \
        if (ln_ == 0) __hip_atomic_fetch_add((unsigned*)(F.ctl + 64 + 32 * args.pad + (k)), acc_, RLX_AGENT); } LDS_WAIT(); __syncthreads(); } while (0)
#define CHK(k, off, bytes) FLUSHK(k)
#define CHKOUT(k) FLUSHK(k)
#else
#define CHK(k, off, bytes) do {} while (0)
#define CHKOUT(k) do {} while (0)
#endif
    if (IN(0)) { PHASE_BEGIN(); REP(0) p0_prologue(F); if (BOTH(0)) GRID_BAR(); CHK(0, WS_WIN, 14 * MiB); CHK(0, WS_WGU, 192 * MiB); CHK(0, WS_H, 128 * MiB); CHK(0, WS_CS16, 12 * MiB); }

    if (IN(1)) {
        PHASE_BEGIN();
        REP(1) {
        pg8::Gemm g{WSP(bf16, WS_H), WSP(bf16, WS_WIN), T, 1792, 1024}; pg8::StaticOrder S; S.init(T, 1792, F.G, (int)blockIdx.x); S.z = zz_;
        pg8::EpiZ E{WSP(bf16, WS_CQ), WSP(bf16, WS_CKV), WSP(bf16, WS_KPE), WSP(bf16, WS_KB), WSP(bf16, WS_VB), WSP(bf16, WS_KIDX), WSP(bf16, WS_QB), WSP(bf16, WS_QIDX), WSP(float, WS_WIDX)};
        pg8::gemm_phase<pg8::EpiZ, pg8::StaticOrder, true, true>(F.lds, g, S, E);
        }
        if (BOTH(1)) GRID_BAR(); CHK(1, WS_CQ, 78 * MiB); CHK(1, WS_QB, 128 * MiB);
    }

    if (IN(2)) { PHASE_BEGIN(); p2_token_pass(F); if (BOTH(2)) GRID_BAR(); CHK(2, WS_CQ, 78 * MiB); CHK(2, WS_QB, 128 * MiB); }

    if (IN(3)) {
        PHASE_BEGIN();
        REP(3) {
        { pg8::Gemm g{WSP(bf16, WS_CQ), WSP(bf16, WS_WUQ), T, 768, 256}; pg8::StaticOrder S; S.init(T, 768, F.G, (int)blockIdx.x); S.z = zz_;
          pg8::EpiStore E{WSP(bf16, WS_QMLA), 768};
          pg8::gemm_phase<pg8::EpiStore, pg8::StaticOrder, true, true>(F.lds, g, S, E); }
        __syncthreads();
        { int z2_; asm volatile("v_mbcnt_lo_u32_b32 %0, -1, 0\n\tv_mbcnt_hi_u32_b32 %0, -1, %0" : "=v"(z2_)); z2_ += F.wave * 64;
          pg8::Gemm g{WSP(bf16, WS_CKV), WSP(bf16, WS_WUKV), T, 1024, 128}; pg8::StaticOrder S; S.init(T, 1024, F.G, (int)blockIdx.x); S.z = z2_;
          pg8::EpiStore E{WSP(bf16, WS_KV), 1024};
          pg8::gemm_phase<pg8::EpiStore, pg8::StaticOrder, true, true>(F.lds, g, S, E); }
        }
        if (BOTH(3)) GRID_BAR(); CHK(3, WS_QMLA, 224 * MiB);
    }

    if (IN(4)) {
        PHASE_BEGIN();
#if defined(PROBE_T5)
        mla::phase<PROBE_T5>(zz_, F.vcu, WSP(bf16, WS_QMLA), WSP(bf16, WS_KV), WSP(bf16, WS_KPE), WSP(f32x2, WS_CS32), WSP(bf16, WS_YB), F.lds);
#endif
#ifndef P4_ALT_SHIFT
#define P4_ALT_SHIFT 0
#endif
#if !SPLIT_MIXERS && defined(P4_ALT)
        _Pragma("unroll 1") for (int ph_ = 0; ph_ < 2; ++ph_) {
            if ((ph_ == 0) != (((F.vcu >> P4_ALT_SHIFT) & 1) != 0)) mla::phase<0>(zz_, F.vcu, WSP(bf16, WS_QMLA), WSP(bf16, WS_KV), WSP(bf16, WS_KPE), WSP(f32x2, WS_CS32), WSP(bf16, WS_YA), F.lds);
            else dsa::phase(zz_, F.vcu, WSP(bf16, WS_QIDX), WSP(bf16, WS_KIDX), WSP(float, WS_WIDX), WSP(bf16, WS_QB), WSP(bf16, WS_KB), WSP(bf16, WS_VB), WSP(bf16, WS_YB), F.lds);
            __syncthreads(); }
#else
        mla::phase<0>(zz_, F.vcu, WSP(bf16, WS_QMLA), WSP(bf16, WS_KV), WSP(bf16, WS_KPE), WSP(f32x2, WS_CS32), WSP(bf16, WS_YA), F.lds);
#endif
#if defined(PROBE_T1)
        VM_WAIT(); __syncthreads();
        mla::phase<0>(zz_, F.vcu, WSP(bf16, WS_QMLA), WSP(bf16, WS_KV), WSP(bf16, WS_KPE), WSP(f32x2, WS_CS32), WSP(bf16, WS_YA), F.lds);
#elif defined(PROBE_T3)
        mla::phase<0>(zz_, F.vcu, WSP(bf16, WS_QMLA), WSP(bf16, WS_KV), WSP(bf16, WS_KPE), WSP(f32x2, WS_CS32), WSP(bf16, WS_YB), F.lds);
#endif
        __syncthreads();
#if SPLIT_MIXERS
        if (BOTH(4)) GRID_BAR(); CHK(4, WS_YA, 64 * MiB);
#if defined(PROBE_T8)
        { const v4u* A = WSP(v4u, WS_YA); const v4u* B = WSP(v4u, WS_YB); unsigned bad = 0;
          for (size_t i = (size_t)F.vcu * 512 + F.tid; i < (size_t)T * 512 * 2 / 16; i += (size_t)F.G * 512) { const v4u a = A[i], b = B[i]; bad |= (a.x ^ b.x) | (a.y ^ b.y) | (a.z ^ b.z) | (a.w ^ b.w); }
          if (bad) __hip_atomic_store(F.ctl + 8, 1u, RLX_AGENT);
          GRID_BAR(); }
#endif
    }
    if (IN(12)) {
        PHASE_BEGIN();
#endif
#if !(!SPLIT_MIXERS && defined(P4_ALT))
        REP(12) dsa::phase(zz_, F.vcu, WSP(bf16, WS_QIDX), WSP(bf16, WS_KIDX), WSP(float, WS_WIDX), WSP(bf16, WS_QB), WSP(bf16, WS_KB), WSP(bf16, WS_VB), WSP(bf16, WS_YB), F.lds);
#endif
        if (BOTH(4)) GRID_BAR(); CHK(12, WS_YB, 64 * MiB);
    }

    if (IN(5)) {
        PHASE_BEGIN();
        REP(5) {
        pg8::Gemm g{WSP(bf16, WS_H), WSP(bf16, WS_WG), T, 2048, 1024}; pg8::StaticOrder S; S.init(T, 2048, F.G, (int)blockIdx.x); S.z = zz_;
        pg8::EpiGate E{WSP(bf16, WS_G)};
        pg8::gemm_phase<pg8::EpiGate, pg8::StaticOrder, true, true>(F.lds, g, S, E);
        }
        if (BOTH(5)) GRID_BAR(); CHK(5, WS_G, 256 * MiB);
    }

    if (IN(6)) {
        PHASE_BEGIN();
        REP(6) {
        { pg8::Gemm g{WSP(bf16, WS_YA), WSP(bf16, WS_WBA), T, 1024, 512}; pg8::StaticOrder S; S.init(T, 1024, F.G, (int)blockIdx.x); S.z = zz_;
          pg8::EpiMerge<0> E{WSP(bf16, WS_G), WSP(bf16, WS_M)};
          pg8::gemm_phase<pg8::EpiMerge<0>, pg8::StaticOrder, true, true>(F.lds, g, S, E); }
        VM_WAIT(); __syncthreads();
        { int z2_; asm volatile("v_mbcnt_lo_u32_b32 %0, -1, 0\n\tv_mbcnt_hi_u32_b32 %0, -1, %0" : "=v"(z2_)); z2_ += F.wave * 64;
          pg8::Gemm g{WSP(bf16, WS_YB), WSP(bf16, WS_WBB), T, 1024, 512}; pg8::StaticOrder S; S.init(T, 1024, F.G, (int)blockIdx.x); S.z = z2_;
          pg8::EpiMerge<1> E{WSP(bf16, WS_G), WSP(bf16, WS_M)};
          pg8::gemm_phase<pg8::EpiMerge<1>, pg8::StaticOrder, true, true>(F.lds, g, S, E); }
        }
        if (BOTH(6)) GRID_BAR(); CHK(6, WS_M, 128 * MiB);
    }

    if (IN(7)) {
        PHASE_BEGIN();
        REP(7) {
        pg8::Gemm g{WSP(bf16, WS_M), WSP(bf16, WS_WOUT), T, 1024, 1024}; pg8::StaticOrder S; S.init(T, 1024, F.G, (int)blockIdx.x); S.z = zz_;
        pg8::EpiX1 E{F.x, F.out, F.ffn_g, WSP(bf16, WS_XN2)};
        pg8::gemm_phase<pg8::EpiX1, pg8::StaticOrder, true, true>(F.lds, g, S, E);
        }
        if (BOTH(7)) GRID_BAR(); CHKOUT(7);
    }

    if (IN(8)) { PHASE_BEGIN(); REP(8) p8_router(F); if (BOTH(8)) GRID_BAR(); CHK(8, WS_TOKE, 3 * MiB + 256 * 1024); }
    if (IN(9)) { PHASE_BEGIN(); p9_slots(F); if (BOTH(9)) GRID_BAR(); CHK(9, WS_ROWTOK, 1024 * 256 * 4); CHK(9, WS_BLKE, 1024 * 4); }
    if (IN(10)) { PHASE_BEGIN(); if (MOE_PAIR && F.G == 256) p10_moe_pair(F); else { REP(10) p10_moe(F, (MOE_PROBE) && rep_ == 0 ? (MOE_PROBE) : 0); } GRID_BAR(); }
    if (IN(10)) { PHASE_BEGIN(); p10b_moe_tail_gu(F); GRID_BAR(); }
    if (IN(10)) { PHASE_BEGIN(); p10c_moe_tail_down(F); if (BOTH(10)) GRID_BAR(); CHK(10, WS_YBUF, 512 * MiB); }
    if (IN(11)) { PHASE_BEGIN(); p11_final(F);
#if defined(SELFCHK) || defined(SELFCHK2)
        GRID_BAR(); CHKOUT(11); GRID_BAR();
        if (args.pad == 1) {
            if (blockIdx.x == 0 && F.tid == 0) { unsigned code = 0u;
                for (int k = 0; k < 16; ++k) { const unsigned a_ = __hip_atomic_load(F.ctl + 64 + k, RLX_AGENT), b_ = __hip_atomic_load(F.ctl + 96 + k, RLX_AGENT); if (a_ != b_ && code == 0u) code = (unsigned)(k + 1); }
                __hip_atomic_store(F.ctl + 10, code, RLX_AGENT); }
            GRID_BAR();
            const unsigned code = __hip_atomic_load(F.ctl + 10, RLX_AGENT);
            if (code) { const float sc = 1.f + 0.02f * (float)code; for (size_t i = (size_t)F.vcu * 512 + F.tid; i < (size_t)T * D; i += (size_t)F.G * 512) F.out[i] *= sc; }
        }
#endif
#if defined(PROBE_T8) || defined(PROBE_L2)
        GRID_BAR();
        { const unsigned c9 = __hip_atomic_load(F.ctl + 9, RLX_AGENT); if (__hip_atomic_load(F.ctl + 8, RLX_AGENT) != 0u) { for (size_t i = (size_t)F.vcu * 512 + F.tid; i < (size_t)T * D; i += (size_t)F.G * 512) F.out[i] = __builtin_nanf(""); }
          else if (c9) { const float sc = 1.f + 0.05f * (float)c9; for (size_t i = (size_t)F.vcu * 512 + F.tid; i < (size_t)T * D; i += (size_t)F.G * 512) F.out[i] *= sc; } }
#endif
    }
#undef IN
#undef BOTH
}

extern "C" void kernel_launch(void* const* d_in, const int* in_sizes, int n_in, void* d_out, int out_size, void* d_ws, size_t ws_size, hipStream_t stream) {
    static int grid = 0;
    if (grid == 0) {
        if (n_in != 19 || in_sizes[0] != T * D || out_size != T * D || ws_size < WS_END) { fprintf(stderr, "kernel_launch: unexpected shapes (n_in %d, in0 %d, out %d, ws %zu)\n", n_in, n_in > 0 ? in_sizes[0] : -1, out_size, ws_size); grid = -1; return; }
        int dev = 0, cus = 0;
        if (hipGetDevice(&dev) != hipSuccess || hipDeviceGetAttribute(&cus, hipDeviceAttributeMultiprocessorCount, dev) != hipSuccess) { grid = -1; return; }
        if (hipFuncSetAttribute((const void*)mk_fwd, hipFuncAttributeMaxDynamicSharedMemorySize, LDS_BYTES) != hipSuccess) { fprintf(stderr, "kernel_launch: hipFuncSetAttribute failed\n"); grid = -1; return; }
        int per_cu = 0;
        if (hipOccupancyMaxActiveBlocksPerMultiprocessor(&per_cu, (const void*)mk_fwd, NWAVES * 64, LDS_BYTES) != hipSuccess || per_cu < 1) fprintf(stderr, "kernel_launch: occupancy query says %d\n", per_cu);
        (void)hipGetLastError();
        if (cus != 256) { fprintf(stderr, "kernel_launch: built for 256 CUs, device has %d\n", cus); grid = -1; return; }
        grid = 256;
    }
    if (grid < 0) return;
#if defined(DIAG_ZERO_WS)
    if (hipMemsetAsync((char*)d_ws, 0, WS_END, stream) != hipSuccess) return;
    (void)hipMemsetAsync(d_out, 0, (size_t)out_size * 4, stream);
#else
    if (hipMemsetAsync((char*)d_ws + WS_CTL, 0, CTL_ZERO_BYTES, stream) != hipSuccess) return;
#endif
    Args a{};
    for (int i = 0; i < 19; ++i) a.in[i] = d_in[i];
    a.out = (float*)d_out; a.ws = (unsigned char*)d_ws;
#if defined(SELFCHK) || defined(SELFCHK2)
    for (int pass = 0; pass < 2; ++pass) { a.ph_lo = 0; a.ph_hi = 13; a.li = pass; a.pad = pass; hipLaunchKernelGGL(mk_fwd, dim3(grid), dim3(NWAVES * 64), LDS_BYTES, stream, a); }
    if (true) return;
#endif
    for (int li = 0; li < N_LAUNCHES; ++li) {
        int ph = li;
#if SPLIT_MIXERS
        ph = li <= 4 ? li : li == 5 ? 12 : li - 1;
#endif
        a.ph_lo = (N_LAUNCHES != 1) ? ph : 0; a.ph_hi = (N_LAUNCHES != 1) ? ph + 1 : 13; a.li = 0;
        hipLaunchKernelGGL(mk_fwd, dim3(grid), dim3(NWAVES * 64), LDS_BYTES, stream, a);
        if (hipPeekAtLastError() != hipSuccess) { fprintf(stderr, "kernel_launch: launch %d failed\n", li); break; }
    }
}
```
